# Optimizing an MI355X kernel written in HIP

```python
import jax, jax.numpy as jnp
from jax import lax
import numpy as np

D_MODEL = 2048
BATCH = 8
SEQ = 4096
DEPTH = 2
DEC_BATCH = 8
DEC_SEQ = 16
PAST_LEN = 1024

CHUNK = 64
N_MIXERS = 2
H_A = 16
DH_A = D_MODEL // H_A
N_PREV_A = 8
REL_CLIP = 128
DH_B = 64
H_B = D_MODEL // DH_B
KV_B = H_B // 4
G_B = H_B // KV_B
WINDOW_B = 128
N_PREV_B = WINDOW_B // CHUNK
ROT_DIM = DH_B // 4
ROPE_THETA = 500000.0
D_FF = 4 * D_MODEL
ALPHA = (2 * DEPTH) ** 0.25
BETA = (8 * DEPTH) ** -0.25
LN_EPS = 1e-5
NEG_INF = -1e30

kernel_name = 'hybrid_streaming_encoder_step'


def layer_norm(x, g, b):
    xf = x.astype(jnp.float32)
    mu = xf.mean(-1, keepdims=True)
    var = jnp.square(xf - mu).mean(-1, keepdims=True)
    return ((xf - mu) * lax.rsqrt(var + LN_EPS)).astype(x.dtype) * g + b


def ada_modulation(c, w, b):
    mod = jax.nn.silu(c) @ w + b
    shift, scale, gate = jnp.split(mod, 3, axis=-1)
    return shift[:, None], scale[:, None], gate[:, None]


def pad_to_chunks(x):
    s = x.shape[1]
    s_pad = -(-s // CHUNK) * CHUNK
    return jnp.pad(x, ((0, 0), (0, s_pad - s)) + ((0, 0),) * (x.ndim - 2))


def extend_with_history(new, hist, n_prev):
    s = new.shape[1]
    s_pad = -(-s // CHUNK) * CHUNK
    hist_len = 0 if hist is None else hist.shape[1]
    body = new if hist is None else jnp.concatenate([hist, new], axis=1)
    front = n_prev * CHUNK - hist_len
    ext = jnp.pad(body, ((0, 0), (front, s_pad - s), (0, 0), (0, 0)))
    r = jnp.arange(ext.shape[1])
    valid = (r >= front) & (r < front + hist_len + s)
    return ext, valid


def rel_position_bias(table, n_prev):
    i = jnp.arange(CHUNK)[:, None]
    j = jnp.arange((n_prev + 1) * CHUNK)[None, :]
    idx = jnp.clip(n_prev * CHUNK + i - j, -REL_CLIP, REL_CLIP) + REL_CLIP
    return table[:, idx]


def band_attention(q, k_ext, v_ext, valid, n_prev, bias=None, sink=None):
    b, s_pad, hkv, g, dh = q.shape
    nc = s_pad // CHUNK
    band = (n_prev + 1) * CHUNK
    scale = dh ** -0.5
    qc = q.reshape(b, nc, CHUNK, hkv, g, dh).transpose(1, 0, 2, 3, 4, 5)

    def one_chunk(args):
        c, qb = args
        start = c * CHUNK
        kb = lax.dynamic_slice_in_dim(k_ext, start, band, axis=1)
        vb = lax.dynamic_slice_in_dim(v_ext, start, band, axis=1)
        ok = lax.dynamic_slice_in_dim(valid, start, band, axis=0)
        s = jnp.einsum('bqkgd,bjkd->bkgqj', qb, kb).astype(jnp.float32) * scale
        if bias is not None:
            s = s + bias.astype(jnp.float32)
        s = jnp.where(ok[None, None, None, None, :], s, NEG_INF)
        if sink is None:
            p = jax.nn.softmax(s, axis=-1)
        else:
            sk = sink.astype(jnp.float32)[None, :, :, None, None]
            m = jnp.maximum(s.max(-1, keepdims=True), sk)
            e = jnp.exp(s - m)
            p = e / (e.sum(-1, keepdims=True) + jnp.exp(sk - m))
        return jnp.einsum('bkgqj,bjkd->bqkgd', p.astype(vb.dtype), vb)

    out = lax.map(one_chunk, (jnp.arange(nc), qc))
    return out.transpose(1, 0, 2, 3, 4, 5).reshape(b, s_pad, hkv * g * dh)


def partial_rope(x, pos):
    half = ROT_DIM // 2
    freqs = ROPE_THETA ** (-jnp.arange(0, ROT_DIM, 2, dtype=jnp.float32) / ROT_DIM)
    ang = pos.astype(jnp.float32)[:, None] * freqs[None, :]
    cos = jnp.cos(ang)[None, :, None, :]
    sin = jnp.sin(ang)[None, :, None, :]
    xr = x[..., :ROT_DIM].astype(jnp.float32)
    x1, x2 = xr[..., :half], xr[..., half:]
    rot = jnp.concatenate([x1 * cos - x2 * sin, x2 * cos + x1 * sin], axis=-1).astype(x.dtype)
    return jnp.concatenate([rot, x[..., ROT_DIM:]], axis=-1)


def mixer_a(h, hist_k, hist_v, w_qkv, w_o, rel_table):
    b, s, _ = h.shape
    q, k, v = jnp.split(h @ w_qkv, 3, axis=-1)
    q = q.reshape(b, s, H_A, DH_A)
    k = k.reshape(b, s, H_A, DH_A)
    v = v.reshape(b, s, H_A, DH_A)
    k_ext, valid = extend_with_history(k, hist_k, N_PREV_A)
    v_ext, _ = extend_with_history(v, hist_v, N_PREV_A)
    bias = rel_position_bias(rel_table, N_PREV_A)[:, None]
    o = band_attention(pad_to_chunks(q)[:, :, :, None, :], k_ext, v_ext, valid, N_PREV_A, bias=bias)
    return o[:, :s] @ w_o, k, v


def mixer_b(h, pos0, hist_k, hist_v, w_qkv, w_o, sink):
    b, s, _ = h.shape
    q, k, v = jnp.split(h @ w_qkv, [H_B * DH_B, H_B * DH_B + KV_B * DH_B], axis=-1)
    pos = pos0 + jnp.arange(s)
    q = partial_rope(q.reshape(b, s, H_B, DH_B), pos)
    k = partial_rope(k.reshape(b, s, KV_B, DH_B), pos)
    v = v.reshape(b, s, KV_B, DH_B)
    k_ext, valid = extend_with_history(k, hist_k, N_PREV_B)
    v_ext, _ = extend_with_history(v, hist_v, N_PREV_B)
    qg = pad_to_chunks(q).reshape(b, -1, KV_B, G_B, DH_B)
    o = band_attention(qg, k_ext, v_ext, valid, N_PREV_B, sink=sink.reshape(KV_B, G_B))
    return o[:, :s] @ w_o, k, v


def trunk(x, c, pos0, hist_a_k, hist_a_v, hist_b_k, hist_b_v,
          w_ada, b_ada, ln_g, ln_b, w_qkv_a, w_o_a, rel_bias_a,
          w_qkv_b, w_o_b, sink_b, w_up, w_down):
    new_a_k, new_a_v, new_b_k, new_b_v = [], [], [], []
    for i in range(DEPTH):
        l = i // N_MIXERS
        shift, scale, gate = ada_modulation(c, w_ada[i, 0], b_ada[i, 0])
        h = x * (1 + scale) + shift
        if i % N_MIXERS == 0:
            hk = None if hist_a_k is None else hist_a_k[l]
            hv = None if hist_a_v is None else hist_a_v[l]
            y, k, v = mixer_a(h, hk, hv, w_qkv_a[l], w_o_a[l], rel_bias_a[l])
            new_a_k.append(k[:, -N_PREV_A * CHUNK:])
            new_a_v.append(v[:, -N_PREV_A * CHUNK:])
        else:
            hk = None if hist_b_k is None else hist_b_k[l]
            hv = None if hist_b_v is None else hist_b_v[l]
            y, k, v = mixer_b(h, pos0, hk, hv, w_qkv_b[l], w_o_b[l], sink_b[l])
            new_b_k.append(k[:, -N_PREV_B * CHUNK:])
            new_b_v.append(v[:, -N_PREV_B * CHUNK:])
        x = layer_norm(ALPHA * x + gate * y, ln_g[i, 0], ln_b[i, 0])
        shift, scale, gate = ada_modulation(c, w_ada[i, 1], b_ada[i, 1])
        h = x * (1 + scale) + shift
        f = jnp.square(jax.nn.relu(h @ w_up[i])) @ w_down[i]
        x = layer_norm(ALPHA * x + gate * f, ln_g[i, 1], ln_b[i, 1])
    return x, jnp.stack(new_a_k), jnp.stack(new_a_v), jnp.stack(new_b_k), jnp.stack(new_b_v)


def setup_inputs(seed: int = 0) -> dict:
    key = jax.random.key(seed)
    ks = jax.random.split(key, 20)
    n_a = (DEPTH + 1) // 2
    n_b = DEPTH // 2
    la = min(N_PREV_A * CHUNK, PAST_LEN)
    lb = min(N_PREV_B * CHUNK, PAST_LEN)
    d = D_MODEL

    def nrm(k, shape, s):
        return jax.random.normal(k, shape, jnp.float32) * s

    return {
        'x_prompt': nrm(ks[0], (BATCH, SEQ, d), 1.0),
        'x_sample': nrm(ks[1], (DEC_BATCH, DEC_SEQ, d), 1.0),
        'cache_a_k': nrm(ks[2], (n_a, DEC_BATCH, la, H_A, DH_A), 1.0),
        'cache_a_v': nrm(ks[3], (n_a, DEC_BATCH, la, H_A, DH_A), 1.0),
        'cache_b_k': nrm(ks[4], (n_b, DEC_BATCH, lb, KV_B, DH_B), 1.0),
        'cache_b_v': nrm(ks[5], (n_b, DEC_BATCH, lb, KV_B, DH_B), 1.0),
        'c_prompt': nrm(ks[6], (BATCH, d), 1.0),
        'c_sample': nrm(ks[7], (DEC_BATCH, d), 1.0),
        'w_ada': nrm(ks[8], (DEPTH, 2, d, 3 * d), 0.5 * d ** -0.5),
        'b_ada': nrm(ks[9], (DEPTH, 2, 3 * d), 0.02),
        'ln_g': 1.0 + nrm(ks[10], (DEPTH, 2, d), 0.05),
        'ln_b': nrm(ks[11], (DEPTH, 2, d), 0.02),
        'w_qkv_a': nrm(ks[12], (n_a, d, 3 * H_A * DH_A), d ** -0.5),
        'w_o_a': nrm(ks[13], (n_a, H_A * DH_A, d), BETA * (H_A * DH_A) ** -0.5),
        'rel_bias_a': nrm(ks[14], (n_a, H_A, 2 * REL_CLIP + 1), 0.5),
        'w_qkv_b': nrm(ks[15], (n_b, d, H_B * DH_B + 2 * KV_B * DH_B), d ** -0.5),
        'w_o_b': nrm(ks[16], (n_b, H_B * DH_B, d), BETA * (H_B * DH_B) ** -0.5),
        'sink_b': nrm(ks[17], (n_b, H_B), 0.5),
        'w_up': nrm(ks[18], (DEPTH, d, D_FF), d ** -0.5),
        'w_down': nrm(ks[19], (DEPTH, D_FF, d), BETA * D_FF ** -0.5),
    }


def reference(x_prompt, x_sample, cache_a_k, cache_a_v, cache_b_k, cache_b_v, c_prompt, c_sample,
              w_ada, b_ada, ln_g, ln_b, w_qkv_a, w_o_a, rel_bias_a, w_qkv_b, w_o_b, sink_b, w_up, w_down):
    y_prompt, ak_p, av_p, bk_p, bv_p = trunk(
        x_prompt, c_prompt, 0, None, None, None, None,
        w_ada, b_ada, ln_g, ln_b, w_qkv_a, w_o_a, rel_bias_a, w_qkv_b, w_o_b, sink_b, w_up, w_down)
    y_sample, ak_s, av_s, bk_s, bv_s = trunk(
        x_sample, c_sample, PAST_LEN, cache_a_k, cache_a_v, cache_b_k, cache_b_v,
        w_ada, b_ada, ln_g, ln_b, w_qkv_a, w_o_a, rel_bias_a, w_qkv_b, w_o_b, sink_b, w_up, w_down)
    return (y_prompt, y_sample, ak_p, av_p, bk_p, bv_p, ak_s, av_s, bk_s, bv_s)
```

```cpp
#include <hip/hip_runtime.h>
#include <hip/hip_cooperative_groups.h>
#include <cstdio>
namespace cg = cooperative_groups;

#define LAS __attribute__((address_space(3)))
typedef unsigned short bf16_t;
typedef short bf16x8 __attribute__((ext_vector_type(8)));
typedef short bf16x4 __attribute__((ext_vector_type(4)));
typedef float f32x4 __attribute__((ext_vector_type(4)));
typedef unsigned u32x4 __attribute__((ext_vector_type(4)));
typedef unsigned u32x2 __attribute__((ext_vector_type(2)));

constexpr int DM = 2048;
constexpr int NP = 32768;
constexpr int NREAL = 32896;
constexpr int MP = 33024;
constexpr float ALPHA = 1.41421356237309515f;
constexpr float LOG2E = 1.44269504088896341f;

constexpr size_t WS_WQKVA = 0;
constexpr size_t WS_WOA   = WS_WQKVA + (size_t)6144 * 2048 * 2;
constexpr size_t WS_WQKVB = WS_WOA + (size_t)2048 * 2048 * 2;
constexpr size_t WS_WOB   = WS_WQKVB + (size_t)3072 * 2048 * 2;
constexpr size_t WS_WUP   = WS_WOB + (size_t)2048 * 2048 * 2;
constexpr size_t WS_WDN   = WS_WUP + (size_t)2 * 8192 * 2048 * 2;
constexpr size_t WS_BIG   = WS_WDN + (size_t)2 * 8192 * 2048 * 2;
constexpr size_t WS_H     = WS_BIG + (size_t)MP * 8192 * 2;
constexpr size_t WS_KEA   = WS_H + (size_t)MP * 2048 * 2;
constexpr size_t WS_VEA   = WS_KEA + (size_t)8 * 576 * 2048 * 2;
constexpr size_t WS_KEB   = WS_VEA + (size_t)8 * 576 * 2048 * 2;
constexpr size_t WS_VEB   = WS_KEB + (size_t)8 * 192 * 512 * 2;
constexpr size_t WS_MOD   = WS_VEB + (size_t)8 * 192 * 512 * 2;
constexpr size_t WS_ROPE  = WS_MOD + (size_t)4 * 16 * 6144 * 4;
constexpr size_t WS_END   = WS_ROPE + (size_t)4112 * 16 * 4;

constexpr size_t O_Y    = 0;
constexpr size_t O_AKP  = (size_t)NREAL * 2048;
constexpr size_t O_AVP  = O_AKP + (size_t)8 * 512 * 2048;
constexpr size_t O_BKP  = O_AVP + (size_t)8 * 512 * 2048;
constexpr size_t O_BVP  = O_BKP + (size_t)8 * 128 * 512;
constexpr size_t O_AKS  = O_BVP + (size_t)8 * 128 * 512;
constexpr size_t O_AVS  = O_AKS + (size_t)128 * 2048;
constexpr size_t O_BKS  = O_AVS + (size_t)128 * 2048;
constexpr size_t O_BVS  = O_BKS + (size_t)128 * 512;

struct Params {
    const float* x_prompt; const float* x_sample;
    const float* cache_a_k; const float* cache_a_v; const float* cache_b_k; const float* cache_b_v;
    const float* c_prompt; const float* c_sample;
    const float* w_ada; const float* b_ada; const float* ln_g; const float* ln_b;
    const float* w_qkv_a; const float* w_o_a; const float* rel_bias_a;
    const float* w_qkv_b; const float* w_o_b; const float* sink_b;
    const float* w_up; const float* w_down;
    float* out; unsigned char* ws;
};

typedef const __attribute__((address_space(4))) struct Params* KParamPtr;
__device__ __forceinline__ Params load_params() {
#if defined(__HIP_DEVICE_COMPILE__)
    auto k = __builtin_amdgcn_kernarg_segment_ptr();
    asm volatile("" : "+s"(k));
    return *(KParamPtr)k;
#else
    return Params{};
#endif
}
__device__ __forceinline__ int opaque_tid() { int t = threadIdx.x; asm volatile("" : "+v"(t)); return t; }
__device__ __forceinline__ unsigned pk2(float lo, float hi) { unsigned r; asm("v_cvt_pk_bf16_f32 %0, %1, %2" : "=v"(r) : "v"(lo), "v"(hi)); return r; }

namespace pg8 {
constexpr int BM = 256, BK = 64, HALF = 128, HTB = HALF * BK * 2, STAGE_BYTES = 8 * HTB, NXCD = 8, WGM = 8;
__device__ __forceinline__ int lds_byte(int r, int c) { const int st = (r >> 4) * 2 + (c >> 5), rr = r & 15, cc = c & 31, ob = rr * 64 + cc * 2; return st * 1024 + (ob ^ (((ob >> 9) & 1) << 5)); }
__device__ __forceinline__ void stage_rc(int b, int& R, int& C) { const int st = b / 1024, sb = b % 1024, swz = sb ^ (((sb >> 9) & 1) << 5); R = (st >> 1) * 16 + swz / 64; C = (st & 1) * 32 + (swz % 64) / 2; }
__device__ __forceinline__ int perm32(int rho) { const int n = rho >> 4, i = rho & 15; return 8 * (i >> 2) + 4 * n + (i & 3); }
struct Unit { int pm, pn; };
struct Gemm { const bf16_t* A; const bf16_t* Bt; int M, N, K; };
struct StaticOrder {
    int nM, nN, nwg, G, c;
    __device__ void init(int M, int N, int G_, int c_) { nM = M / BM; nN = N / BM; nwg = nM * nN; G = G_; c = c_; }
    __device__ bool next(int i, Unit& u) const {
        const long L = (long)i * G + c; if (L >= nwg) return false;
        int wgid = (int)L; { const int q = nwg / NXCD, r = nwg % NXCD, xcd = wgid % NXCD, off = wgid / NXCD; wgid = (xcd < r ? xcd * (q + 1) : r * (q + 1) + (xcd - r) * q) + off; }
        const int nig = WGM * nN, gid = wgid / nig, fm = gid * WGM, gsz = (nM - fm) < WGM ? (nM - fm) : WGM;
        u.pm = fm + ((wgid % nig) % gsz); u.pn = (wgid % nig) / gsz; return true;
    }
};

template <class Epi>
__device__ __forceinline__ void gemm_phase(LAS unsigned char* lds, const Gemm g, const StaticOrder& S, const Epi& E) {
    const int tid = opaque_tid(), wid = __builtin_amdgcn_readfirstlane(tid >> 6), lane = tid & 63, wr = wid >> 2, wc = wid & 3, fr = lane & 15, fq = lane >> 4;
    const int K = g.K, nt = K / BK;
    unsigned voffA[2], voffB[2];
#pragma unroll
    for (int i = 0; i < 2; ++i) { int R, C; stage_rc(tid * 16 + i * 8192, R, C); const int Rb = Epi::PERM ? ((R & ~31) + perm32(R & 31)) : R;
        voffA[i] = (unsigned)(R * K + C) * 2u; voffB[i] = (unsigned)(Rb * K + C) * 2u; }
    const size_t kstep = (size_t)(BK * 2);
    const size_t hstep = (size_t)HALF * K * 2;
    const size_t tstep = 2 * hstep;
    const unsigned ldsw = (unsigned)wid * 1024u;
    const int aoff = lds_byte(wr * 64 + fr, fq * 8), boff = lds_byte(wc * 32 + fr, fq * 8);
#define PG8_SA(b, h) (((b) * 2 + (h)) * HTB)
#define PG8_SB(b, h) ((4 + (b) * 2 + (h)) * HTB)
#define PG8_STAGE(bufoff, gbase, voff) do { _Pragma("unroll") for (int _i = 0; _i < 2; ++_i) \
        __builtin_amdgcn_global_load_lds((const unsigned*)((const char*)(gbase) + (voff)[_i]), (LAS unsigned*)(lds + (bufoff) + ldsw + _i * 8192), 16, 0, 0); } while (0)
#define PG8_LDA(dst, b, h) do { _Pragma("unroll") for (int m = 0; m < 4; ++m) _Pragma("unroll") for (int k = 0; k < 2; ++k) dst[m][k] = *(const LAS bf16x8*)(lds + PG8_SA(b, h) + aoff + m * 2048 + k * 1024); } while (0)
#define PG8_LDB(dst, b, h) do { _Pragma("unroll") for (int n = 0; n < 2; ++n) _Pragma("unroll") for (int k = 0; k < 2; ++k) dst[n][k] = *(const LAS bf16x8*)(lds + PG8_SB(b, h) + boff + n * 2048 + k * 1024); } while (0)
#define PG8_MMA(ai, bj, At, Bt) do { __builtin_amdgcn_s_setprio(1); _Pragma("unroll") for (int m = 0; m < 4; ++m) _Pragma("unroll") for (int n = 0; n < 2; ++n) _Pragma("unroll") for (int k = 0; k < 2; ++k) \
        acc[ai][bj][m][n] = __builtin_amdgcn_mfma_f32_16x16x32_bf16(Bt[n][k], At[m][k], acc[ai][bj][m][n], 0, 0, 0); __builtin_amdgcn_s_setprio(0); } while (0)
#define PG8_WAIT_V(n) asm volatile("s_waitcnt vmcnt(" #n ")" ::: "memory")
#define PG8_WAIT_L(n) asm volatile("s_waitcnt lgkmcnt(" #n ")" ::: "memory")
#define PG8_BAR __builtin_amdgcn_s_barrier()
#define PG8_SCHED __builtin_amdgcn_sched_barrier(0)
    Unit cur, nxt; int ui = 0;
    if (!S.next(0, cur)) return;
    f32x4 acc[2][2][4][2];
#pragma unroll
    for (int a = 0; a < 2; ++a)
#pragma unroll
        for (int b = 0; b < 2; ++b)
#pragma unroll
            for (int m = 0; m < 4; ++m)
#pragma unroll
                for (int n = 0; n < 2; ++n) acc[a][b][m][n] = (f32x4){0.f, 0.f, 0.f, 0.f};
    bf16x8 At[4][2], B0[2][2], B1[2][2];
    const char* cA = (const char*)g.A + (size_t)cur.pm * tstep; const char* cB = (const char*)g.Bt + (size_t)cur.pn * tstep;
    PG8_STAGE(PG8_SB(0, 0), cB, voffB); PG8_STAGE(PG8_SA(0, 0), cA, voffA); PG8_STAGE(PG8_SB(0, 1), cB + hstep, voffB); PG8_STAGE(PG8_SA(0, 1), cA + hstep, voffA);
    if (wr == 1) PG8_BAR;
    PG8_WAIT_V(4); PG8_BAR;
    PG8_STAGE(PG8_SB(1, 0), cB + kstep, voffB); PG8_STAGE(PG8_SA(1, 0), cA + kstep, voffA); PG8_STAGE(PG8_SB(1, 1), cB + hstep + kstep, voffB);
    PG8_WAIT_V(6); PG8_BAR;
    for (;;) {
        const bool has_next = S.next(ui + 1, nxt);
        const char* nA = has_next ? (const char*)g.A + (size_t)nxt.pm * tstep : cA; const char* nB = has_next ? (const char*)g.Bt + (size_t)nxt.pn * tstep : cB;
        for (int t = 0; t < nt; t += 2) {
            const bool last = (t == nt - 2);
            const char* a1 = cA + (size_t)(t + 1) * kstep;
            const char* a2 = last ? nA : cA + (size_t)(t + 2) * kstep; const char* b2 = last ? nB : cB + (size_t)(t + 2) * kstep;
            const char* a3 = a2 + kstep; const char* b3 = b2 + kstep;
            PG8_LDB(B0, 0, 0); PG8_SCHED; PG8_LDA(At, 0, 0); PG8_STAGE(PG8_SA(1, 1), a1 + hstep, voffA);
            PG8_WAIT_L(8); PG8_BAR; PG8_WAIT_L(0); PG8_MMA(0, 0, At, B0); PG8_BAR; PG8_SCHED;
            PG8_LDB(B1, 0, 1); PG8_STAGE(PG8_SB(0, 0), b2, voffB);
            PG8_BAR; PG8_WAIT_L(0); PG8_MMA(0, 1, At, B1); PG8_BAR;
            PG8_LDA(At, 0, 1); PG8_STAGE(PG8_SA(0, 0), a2, voffA);
            PG8_BAR; PG8_WAIT_L(0); PG8_MMA(1, 0, At, B0); PG8_BAR; PG8_SCHED;
            PG8_STAGE(PG8_SB(0, 1), b2 + hstep, voffB);
            PG8_WAIT_V(6); PG8_BAR; PG8_MMA(1, 1, At, B1); PG8_BAR;
            PG8_LDB(B0, 1, 0); PG8_SCHED; PG8_LDA(At, 1, 0); PG8_STAGE(PG8_SA(0, 1), a2 + hstep, voffA);
            PG8_WAIT_L(8); PG8_BAR; PG8_WAIT_L(0); PG8_MMA(0, 0, At, B0); PG8_BAR; PG8_SCHED;
            PG8_LDB(B1, 1, 1); PG8_STAGE(PG8_SB(1, 0), b3, voffB);
            PG8_BAR; PG8_WAIT_L(0); PG8_MMA(0, 1, At, B1); PG8_BAR;
            PG8_LDA(At, 1, 1); PG8_STAGE(PG8_SA(1, 0), a3, voffA);
            PG8_BAR; PG8_WAIT_L(0); PG8_MMA(1, 0, At, B0); PG8_BAR; PG8_SCHED;
            PG8_STAGE(PG8_SB(1, 1), b3 + hstep, voffB);
            PG8_WAIT_V(6); PG8_BAR; PG8_MMA(1, 1, At, B1); PG8_BAR;
        }
        E(acc, cur, wr, wc, fr, fq);
        if (!has_next) break;
#pragma unroll
        for (int a = 0; a < 2; ++a)
#pragma unroll
            for (int b = 0; b < 2; ++b)
#pragma unroll
                for (int m = 0; m < 4; ++m)
#pragma unroll
                    for (int n = 0; n < 2; ++n) acc[a][b][m][n] = (f32x4){0.f, 0.f, 0.f, 0.f};
        cur = nxt; cA = nA; cB = nB; ++ui;
    }
    PG8_WAIT_V(0);
    if (wr == 0) PG8_BAR;
    PG8_BAR;
#undef PG8_SA
#undef PG8_SB
#undef PG8_STAGE
#undef PG8_LDA
#undef PG8_LDB
#undef PG8_MMA
#undef PG8_WAIT_V
#undef PG8_WAIT_L
#undef PG8_BAR
#undef PG8_SCHED
}
}
using pg8::Unit;

struct EpiQkvA {
    static constexpr bool PERM = true;
    unsigned char* ws; float* out;
    __device__ __forceinline__ void operator()(const f32x4 (&acc)[2][2][4][2], const Unit& u, int wr, int wc, int fr, int fq) const {
        const int which = u.pn >> 3, colt = (u.pn & 7) * 256;
        const int row0 = u.pm * 256 + wr * 64 + fr, col0 = colt + wc * 32 + 8 * fq;
        bf16_t* base = (bf16_t*)(ws + WS_BIG) + (size_t)which * MP * 2048;
        bf16_t* ext = (bf16_t*)(ws + (which == 1 ? WS_KEA : WS_VEA));
        float* oP = out + (which == 1 ? O_AKP : O_AVP);
        float* oS = out + (which == 1 ? O_AKS : O_AVS);
        const bool prompt = u.pm < 128, cache_tile = prompt && ((u.pm & 15) >= 14) && which > 0;
#pragma unroll
        for (int ai = 0; ai < 2; ++ai)
#pragma unroll
            for (int m = 0; m < 4; ++m) {
                const int row = row0 + ai * 128 + m * 16;
#pragma unroll
                for (int bj = 0; bj < 2; ++bj) {
                    const f32x4 v0 = acc[ai][bj][m][0], v1 = acc[ai][bj][m][1];
                    const int col = col0 + bj * 128;
                    u32x4 pk; pk[0] = pk2(v0[0], v0[1]); pk[1] = pk2(v0[2], v0[3]); pk[2] = pk2(v1[0], v1[1]); pk[3] = pk2(v1[2], v1[3]);
                    if (prompt || which == 0) *(u32x4*)(base + (size_t)row * 2048 + col) = pk;
                    if (cache_tile) { const int b = row >> 12, t = (row & 4095) - 3584; float* o = oP + ((size_t)(b * 512 + t)) * 2048 + col; *(f32x4*)o = v0; *(f32x4*)(o + 4) = v1; }
                    if (!prompt && which > 0 && row < NREAL) { const int sr = row - NP, b = sr >> 4, t = sr & 15;
                        *(u32x4*)(ext + ((size_t)(b * 576 + 512 + t)) * 2048 + col) = pk;
                        float* o = oS + (size_t)sr * 2048 + col; *(f32x4*)o = v0; *(f32x4*)(o + 4) = v1; }
                }
            }
    }
};

struct EpiQkvB {
    static constexpr bool PERM = true;
    unsigned char* ws; float* out;
    __device__ __forceinline__ void operator()(const f32x4 (&acc)[2][2][4][2], const Unit& u, int wr, int wc, int fr, int fq) const {
        const float* rope = (const float*)(ws + WS_ROPE);
        const int which = u.pn < 8 ? 0 : (u.pn < 10 ? 1 : 2);
        const int colt = which == 0 ? u.pn * 256 : (which == 1 ? (u.pn - 8) * 256 : (u.pn - 10) * 256);
        const int ld = which == 0 ? 2048 : 512;
        const int row0 = u.pm * 256 + wr * 64 + fr, col0 = colt + wc * 32 + 8 * fq;
        bf16_t* base = (bf16_t*)(ws + WS_BIG) + (which == 0 ? (size_t)0 : (which == 1 ? (size_t)MP * 2048 : (size_t)MP * 2048 + (size_t)MP * 512));
        bf16_t* ext = (bf16_t*)(ws + (which == 1 ? WS_KEB : WS_VEB));
        float* oP = out + (which == 1 ? O_BKP : O_BVP);
        float* oS = out + (which == 1 ? O_BKS : O_BVS);
        const bool prompt = u.pm < 128, last_tile = prompt && ((u.pm & 15) == 15) && which > 0;
        const bool do_rope = (which < 2) && ((wc & 1) == 0);
#pragma unroll
        for (int ai = 0; ai < 2; ++ai)
#pragma unroll
            for (int m = 0; m < 4; ++m) {
                const int row = row0 + ai * 128 + m * 16;
                f32x4 cs0 = {1.f, 1.f, 1.f, 1.f}, cs1 = cs0, sn0 = {0.f, 0.f, 0.f, 0.f}, sn1 = sn0;
                if (do_rope) { const int pi = prompt ? (row & 4095) : 4096 + ((row - NP) & 15); const float* rp = rope + (size_t)pi * 16;
                    cs0 = *(const f32x4*)rp; cs1 = *(const f32x4*)(rp + 4); sn0 = *(const f32x4*)(rp + 8); sn1 = *(const f32x4*)(rp + 12); }
#pragma unroll
                for (int bj = 0; bj < 2; ++bj) {
                    f32x4 v0 = acc[ai][bj][m][0], v1 = acc[ai][bj][m][1];
                    if (do_rope) {
                        f32x4 p0, p1;
#pragma unroll
                        for (int j = 0; j < 4; ++j) { p0[j] = __shfl_xor(v0[j], 16); p1[j] = __shfl_xor(v1[j], 16); }
                        if (fq == 0) { v0 = v0 * cs0 - p0 * sn0; v1 = v1 * cs1 - p1 * sn1; }
                        else if (fq == 1) { v0 = v0 * cs0 + p0 * sn0; v1 = v1 * cs1 + p1 * sn1; }
                    }
                    const int col = col0 + bj * 128;
                    u32x4 pk; pk[0] = pk2(v0[0], v0[1]); pk[1] = pk2(v0[2], v0[3]); pk[2] = pk2(v1[0], v1[1]); pk[3] = pk2(v1[2], v1[3]);
                    if (prompt || which == 0) *(u32x4*)(base + (size_t)row * ld + col) = pk;
                    if (last_tile && ai == 1) { const int b = row >> 12, t = (row & 4095) - 3968; float* o = oP + ((size_t)(b * 128 + t)) * 512 + col; *(f32x4*)o = v0; *(f32x4*)(o + 4) = v1; }
                    if (!prompt && which > 0 && row < NREAL) { const int sr = row - NP, b = sr >> 4, t = sr & 15;
                        *(u32x4*)(ext + ((size_t)(b * 192 + 128 + t)) * 512 + col) = pk;
                        float* o = oS + (size_t)sr * 512 + col; *(f32x4*)o = v0; *(f32x4*)(o + 4) = v1; }
                }
            }
    }
};

struct EpiUp {
    static constexpr bool PERM = true;
    bf16_t* U;
    __device__ __forceinline__ void operator()(const f32x4 (&acc)[2][2][4][2], const Unit& u, int wr, int wc, int fr, int fq) const {
        const int row0 = u.pm * 256 + wr * 64 + fr, col0 = u.pn * 256 + wc * 32 + 8 * fq;
#pragma unroll
        for (int ai = 0; ai < 2; ++ai)
#pragma unroll
            for (int m = 0; m < 4; ++m) {
                bf16_t* rowp = U + (size_t)(row0 + ai * 128 + m * 16) * 8192 + col0;
#pragma unroll
                for (int bj = 0; bj < 2; ++bj) {
                    f32x4 v0 = acc[ai][bj][m][0], v1 = acc[ai][bj][m][1];
#pragma unroll
                    for (int j = 0; j < 4; ++j) { const float a = fmaxf(v0[j], 0.f), b = fmaxf(v1[j], 0.f); v0[j] = a * a; v1[j] = b * b; }
                    u32x4 pk; pk[0] = pk2(v0[0], v0[1]); pk[1] = pk2(v0[2], v0[3]); pk[2] = pk2(v1[0], v1[1]); pk[3] = pk2(v1[2], v1[3]);
                    *(u32x4*)(rowp + bj * 128) = pk;
                }
            }
    }
};

struct EpiRes {
    static constexpr bool PERM = false;
    const float* xp; const float* xs; const float* gate  ; float* Y;
    __device__ __forceinline__ void operator()(const f32x4 (&acc)[2][2][4][2], const Unit& u, int wr, int wc, int fr, int fq) const {
        const int row0 = u.pm * 256 + wr * 64 + fr, col0 = u.pn * 256 + wc * 32 + 4 * fq;
#pragma unroll
        for (int ai = 0; ai < 2; ++ai)
#pragma unroll
            for (int m = 0; m < 4; ++m) {
                const int row = row0 + ai * 128 + m * 16;
                if (row < NREAL) {
                    const float* xr = row < NP ? xp + (size_t)row * 2048 : xs + (size_t)(row - NP) * 2048;
                    const int r16 = row < NP ? (row >> 12) : 8 + ((row - NP) >> 4);
                    const float* gr = gate + (size_t)r16 * 6144;
                    float* yr = Y + (size_t)row * 2048;
#pragma unroll
                    for (int bj = 0; bj < 2; ++bj)
#pragma unroll
                        for (int n = 0; n < 2; ++n) {
                            const int col = col0 + bj * 128 + n * 16;
                            const f32x4 xv = *(const f32x4*)(xr + col), gv = *(const f32x4*)(gr + col);
                            *(f32x4*)(yr + col) = xv * ALPHA + gv * acc[ai][bj][m][n];
                        }
                }
            }
    }
};

__device__ __forceinline__ void ada_item(const Params& p, int item, LAS float* lds) {
    const int tid = opaque_tid(), wid = tid >> 6, lane = tid & 63;
    const int combo = item / 24, cb = item % 24, col0 = cb * 256;
    const float* W = p.w_ada + (size_t)combo * 2048 * 6144;
    __syncthreads();
    for (int idx = tid; idx < 16 * 2048; idx += 512) { const int r = idx >> 11, k = idx & 2047;
        const float c = r < 8 ? p.c_prompt[r * 2048 + k] : p.c_sample[(r - 8) * 2048 + k];
        lds[k * 16 + r] = c / (1.f + __expf(-c)); }
    __syncthreads();
    f32x4 acc[16];
#pragma unroll
    for (int r = 0; r < 16; ++r) acc[r] = (f32x4){0.f, 0.f, 0.f, 0.f};
    const float* wp = W + (size_t)(wid * 256) * 6144 + col0 + lane * 4;
    for (int kk = 0; kk < 256; kk += 4) {
        f32x4 w[4];
#pragma unroll
        for (int q = 0; q < 4; ++q) w[q] = *(const f32x4*)(wp + (size_t)(kk + q) * 6144);
#pragma unroll
        for (int q = 0; q < 4; ++q) {
            const LAS f32x4* sp = (const LAS f32x4*)(lds + (wid * 256 + kk + q) * 16);
#pragma unroll
            for (int r4 = 0; r4 < 4; ++r4) { const f32x4 s = sp[r4];
#pragma unroll
                for (int j = 0; j < 4; ++j) acc[r4 * 4 + j] += w[q] * s[j]; }
        }
    }
    __syncthreads();
#pragma unroll
    for (int r = 0; r < 16; ++r) *(LAS f32x4*)(lds + (wid * 16 + r) * 256 + lane * 4) = acc[r];
    __syncthreads();
    float* mod = (float*)(p.ws + WS_MOD);
#pragma unroll
    for (int i = 0; i < 8; ++i) { const int idx = tid + 512 * i, r = idx >> 8, c = idx & 255; float s = 0.f;
#pragma unroll
        for (int w = 0; w < 8; ++w) s += lds[(w * 16 + r) * 256 + c];
        mod[((size_t)combo * 16 + r) * 6144 + col0 + c] = s + p.b_ada[combo * 6144 + col0 + c]; }
}

__device__ __forceinline__ void transpose_tile(const float* src, bf16_t* dst, int K, int N, int k0, int n0, LAS unsigned* lds) {
    const int t = opaque_tid(), c4 = t & 31, rp = t >> 5;
    f32x4 a[4], b[4];
#pragma unroll
    for (int ps = 0; ps < 4; ++ps) { const int r = 2 * (rp + 16 * ps);
        a[ps] = *(const f32x4*)(src + (size_t)(k0 + r) * N + n0 + c4 * 4); b[ps] = *(const f32x4*)(src + (size_t)(k0 + r + 1) * N + n0 + c4 * 4); }
    __syncthreads();
#pragma unroll
    for (int ps = 0; ps < 4; ++ps) { const int kp = rp + 16 * ps;
#pragma unroll
        for (int j = 0; j < 4; ++j) { const int n = c4 * 4 + j; lds[n * 64 + (kp ^ (((n >> 2) & 7) << 2))] = pk2(a[ps][j], b[ps][j]); } }
    __syncthreads();
#pragma unroll
    for (int i = 0; i < 4; ++i) { const int n = (t >> 4) + 32 * i, ch = t & 15;
        const u32x4 v = *(const LAS u32x4*)(lds + n * 64 + ((4 * ch) ^ (((n >> 2) & 7) << 2)));
        *(u32x4*)(dst + (size_t)(n0 + n) * K + k0 + ch * 8) = v; }
}

__device__ __forceinline__ void phase0(const Params& p, LAS unsigned char* lds) {
    const int tid = opaque_tid();
    constexpr int T0 = 768, T1 = T0 + 256, T2 = T1 + 384, T3 = T2 + 256, T4 = T3 + 2048, T5 = T4 + 2048, NIT = T5 + 96;
    for (int it = blockIdx.x; it < NIT; it += gridDim.x) {
        if (it >= T5) { ada_item(p, it - T5, (LAS float*)lds); continue; }
        const float* src; bf16_t* dst; int K, N, tl;
        if (it < T0)      { src = p.w_qkv_a; dst = (bf16_t*)(p.ws + WS_WQKVA); K = 2048; N = 6144; tl = it; }
        else if (it < T1) { src = p.w_o_a;   dst = (bf16_t*)(p.ws + WS_WOA);   K = 2048; N = 2048; tl = it - T0; }
        else if (it < T2) { src = p.w_qkv_b; dst = (bf16_t*)(p.ws + WS_WQKVB); K = 2048; N = 3072; tl = it - T1; }
        else if (it < T3) { src = p.w_o_b;   dst = (bf16_t*)(p.ws + WS_WOB);   K = 2048; N = 2048; tl = it - T2; }
        else if (it < T4) { const int l = (it - T3) >> 10; src = p.w_up + (size_t)l * 2048 * 8192; dst = (bf16_t*)(p.ws + WS_WUP) + (size_t)l * 2048 * 8192; K = 2048; N = 8192; tl = (it - T3) & 1023; }
        else              { const int l = (it - T4) >> 10; src = p.w_down + (size_t)l * 2048 * 8192; dst = (bf16_t*)(p.ws + WS_WDN) + (size_t)l * 2048 * 8192; K = 8192; N = 2048; tl = (it - T4) & 1023; }
        const int ntn = N >> 7, tk = tl / ntn, tn = tl % ntn;
        transpose_tile(src, dst, K, N, tk * 128, tn * 128, (LAS unsigned*)lds);
    }
    const size_t gtid = (size_t)blockIdx.x * 512 + tid, gstride = (size_t)gridDim.x * 512;
    {
        bf16_t* KE = (bf16_t*)(p.ws + WS_KEA); bf16_t* VE = (bf16_t*)(p.ws + WS_VEA);
        for (size_t i = gtid; i < (size_t)8 * 576 * 512; i += gstride) { const int c4 = (int)(i & 511); const int r = (int)((i >> 9) % 576), b = (int)((i >> 9) / 576);
            u32x2 k = {0u, 0u}, v = {0u, 0u};
            if (r < 512) { const size_t s = ((size_t)(b * 512 + r)) * 2048 + c4 * 4; const f32x4 a = *(const f32x4*)(p.cache_a_k + s), c = *(const f32x4*)(p.cache_a_v + s);
                k[0] = pk2(a[0], a[1]); k[1] = pk2(a[2], a[3]); v[0] = pk2(c[0], c[1]); v[1] = pk2(c[2], c[3]); }
            *(u32x2*)(KE + i * 4) = k; *(u32x2*)(VE + i * 4) = v; }
    }
    {
        bf16_t* KE = (bf16_t*)(p.ws + WS_KEB); bf16_t* VE = (bf16_t*)(p.ws + WS_VEB);
        for (size_t i = gtid; i < (size_t)8 * 192 * 128; i += gstride) { const int c4 = (int)(i & 127); const int r = (int)((i >> 7) % 192), b = (int)((i >> 7) / 192);
            u32x2 k = {0u, 0u}, v = {0u, 0u};
            if (r < 128) { const size_t s = ((size_t)(b * 128 + r)) * 512 + c4 * 4; const f32x4 a = *(const f32x4*)(p.cache_b_k + s), c = *(const f32x4*)(p.cache_b_v + s);
                k[0] = pk2(a[0], a[1]); k[1] = pk2(a[2], a[3]); v[0] = pk2(c[0], c[1]); v[1] = pk2(c[2], c[3]); }
            *(u32x2*)(KE + i * 4) = k; *(u32x2*)(VE + i * 4) = v; }
    }
    {
        float* rope = (float*)(p.ws + WS_ROPE);
        for (size_t i = gtid; i < (size_t)4112 * 8; i += gstride) { const int f = (int)(i & 7), pi = (int)(i >> 3); const int pos = pi < 4096 ? pi : 1024 + (pi - 4096);
            const double fr = f == 0 ? 1.0 : f == 1 ? 0.19392274474868576 : f == 2 ? 0.03760603093086393 : f == 3 ? 0.007292664737217109 : f == 4 ? 0.001414213562373095 : f == 5 ? 0.0002742481756762073 : f == 6 ? 5.318295896944988e-05 : 1.031338537721246e-05;
            double rev = (double)pos * fr * 0.15915494309189535; rev -= __builtin_rint(rev);
            const float rf = (float)rev;
            rope[(size_t)pi * 16 + f] = __builtin_amdgcn_cosf(rf); rope[(size_t)pi * 16 + 8 + f] = __builtin_amdgcn_sinf(rf); }
    }
}

__device__ __forceinline__ void modulate0(const Params& p) {
    const float* mod = (const float*)(p.ws + WS_MOD); bf16_t* H = (bf16_t*)(p.ws + WS_H);
    const size_t gtid = (size_t)blockIdx.x * 512 + opaque_tid(), gstride = (size_t)gridDim.x * 512;
    for (size_t i = gtid; i < (size_t)NREAL * 512; i += gstride) { const int row = (int)(i >> 9), c = (int)(i & 511) * 4;
        const float* xr = row < NP ? p.x_prompt + (size_t)row * 2048 : p.x_sample + (size_t)(row - NP) * 2048;
        const int r16 = row < NP ? (row >> 12) : 8 + ((row - NP) >> 4);
        const f32x4 x = *(const f32x4*)(xr + c), sh = *(const f32x4*)(mod + (size_t)r16 * 6144 + c), sc = *(const f32x4*)(mod + (size_t)r16 * 6144 + 2048 + c);
        const f32x4 h = x * (sc + 1.f) + sh;
        u32x2 o; o[0] = pk2(h[0], h[1]); o[1] = pk2(h[2], h[3]);
        *(u32x2*)(H + (size_t)row * 2048 + c) = o; }
}

__device__ __forceinline__ void ln_phase(const Params& p, const float* g, const float* bta, const float* mod_next) {
    float* Y = p.out; bf16_t* H = (bf16_t*)(p.ws + WS_H);
    const int tid = opaque_tid(), wid = tid >> 6, lane = tid & 63;
    for (int row = blockIdx.x * 8 + wid; row < NREAL; row += gridDim.x * 8) {
        float* yr = Y + (size_t)row * 2048;
        f32x4 v[8]; float s = 0.f;
#pragma unroll
        for (int i = 0; i < 8; ++i) { v[i] = *(const f32x4*)(yr + (i * 64 + lane) * 4); s += v[i][0] + v[i][1] + v[i][2] + v[i][3]; }
#pragma unroll
        for (int o = 32; o >= 1; o >>= 1) s += __shfl_xor(s, o);
        const float mu = s * (1.f / 2048.f); float q = 0.f;
#pragma unroll
        for (int i = 0; i < 8; ++i) { v[i] = v[i] - mu; q += v[i][0] * v[i][0] + v[i][1] * v[i][1] + v[i][2] * v[i][2] + v[i][3] * v[i][3]; }
#pragma unroll
        for (int o = 32; o >= 1; o >>= 1) q += __shfl_xor(q, o);
        const float rstd = __builtin_amdgcn_rsqf(q * (1.f / 2048.f) + 1e-5f);
        const int r16 = row < NP ? (row >> 12) : 8 + ((row - NP) >> 4);
#pragma unroll
        for (int i = 0; i < 8; ++i) { const int c = (i * 64 + lane) * 4;
            const f32x4 y = v[i] * rstd * *(const f32x4*)(g + c) + *(const f32x4*)(bta + c);
            *(f32x4*)(yr + c) = y;
            if (mod_next) { const f32x4 sh = *(const f32x4*)(mod_next + (size_t)r16 * 6144 + c), sc = *(const f32x4*)(mod_next + (size_t)r16 * 6144 + 2048 + c);
                const f32x4 h = y * (sc + 1.f) + sh; u32x2 o; o[0] = pk2(h[0], h[1]); o[1] = pk2(h[2], h[3]);
                *(u32x2*)(H + (size_t)row * 2048 + c) = o; } }
    }
}

template <int D, int KS, int VS, bool BIAS>
__device__ __forceinline__ void attn_tile(const LAS unsigned char* Kl, const LAS unsigned char* Vl, const bf16x8 (&qf)[D / 32], f32x4 (&o)[D / 16], float& m, float& l,
                                          float sc2, int jbase, int jhi, int qi, const LAS float* btab, int lane) {
    const int g = lane >> 4, l15 = lane & 15;
    f32x4 s[4];
#pragma unroll
    for (int sub = 0; sub < 4; ++sub) { s[sub] = (f32x4){0.f, 0.f, 0.f, 0.f};
#pragma unroll
        for (int ks = 0; ks < D / 32; ++ks) { const bf16x8 kf = *(const LAS bf16x8*)(Kl + (sub * 16 + l15) * KS + ks * 64 + g * 16);
            s[sub] = __builtin_amdgcn_mfma_f32_16x16x32_bf16(kf, qf[ks], s[sub], 0, 0, 0); } }
    float mx = -1e30f;
#pragma unroll
    for (int sub = 0; sub < 4; ++sub)
#pragma unroll
        for (int j = 0; j < 4; ++j) { const int jb = jbase + sub * 16 + g * 4 + j; float v = s[sub][j] * sc2;
            if (BIAS) { int d = 512 + qi - jb; d = d > 128 ? 128 : d; v += btab[d + 128]; }
            if (jb >= jhi) v = -1e30f;
            s[sub][j] = v; mx = fmaxf(mx, v); }
    mx = fmaxf(mx, __shfl_xor(mx, 16)); mx = fmaxf(mx, __shfl_xor(mx, 32));
    const float mn = fmaxf(m, mx), alpha = __builtin_amdgcn_exp2f(m - mn); m = mn;
    float ls = 0.f;
#pragma unroll
    for (int sub = 0; sub < 4; ++sub)
#pragma unroll
        for (int j = 0; j < 4; ++j) { const float pv = __builtin_amdgcn_exp2f(s[sub][j] - mn); s[sub][j] = pv; ls += pv; }
    l = l * alpha + ls;
    bf16x8 pf[2];
#pragma unroll
    for (int t = 0; t < 2; ++t) { u32x4 w; w[0] = pk2(s[2 * t][0], s[2 * t][1]); w[1] = pk2(s[2 * t][2], s[2 * t][3]); w[2] = pk2(s[2 * t + 1][0], s[2 * t + 1][1]); w[3] = pk2(s[2 * t + 1][2], s[2 * t + 1][3]);
        pf[t] = __builtin_bit_cast(bf16x8, w); }
    const int q4 = (lane >> 2) & 3, p4 = lane & 3;
    const LAS unsigned char* vb = Vl + (g * 4 + q4) * VS + p4 * 8;
#pragma unroll
    for (int ds = 0; ds < D / 16; ++ds) { o[ds] = o[ds] * alpha;
#pragma unroll
        for (int t = 0; t < 2; ++t) {
            const bf16x4 a1 = __builtin_amdgcn_ds_read_tr16_b64_v4i16((LAS bf16x4*)(vb + (t * 32) * VS + ds * 32));
            const bf16x4 a2 = __builtin_amdgcn_ds_read_tr16_b64_v4i16((LAS bf16x4*)(vb + (t * 32 + 16) * VS + ds * 32));
            const bf16x8 vf = __builtin_shufflevector(a1, a2, 0, 1, 2, 3, 4, 5, 6, 7);
            o[ds] = __builtin_amdgcn_mfma_f32_16x16x32_bf16(vf, pf[t], o[ds], 0, 0, 0); } }
}

__device__ __forceinline__ void attn_a_phase(const Params& p, LAS unsigned char* lds) {
    constexpr int KS = 528, VS = 544;
    const int tid = opaque_tid(), wid = tid >> 6, lane = tid & 63, g = lane >> 4, l15 = lane & 15, hh = wid >> 2, rg = wid & 3;
    LAS unsigned char* Kl = lds; LAS unsigned char* Vl = lds + 64 * KS; LAS float* btab = (LAS float*)(lds + 64 * KS + 64 * VS);
    const bf16_t* Q = (const bf16_t*)(p.ws + WS_BIG); const bf16_t* Kg = Q + (size_t)MP * 2048; const bf16_t* Vg = Kg + (size_t)MP * 2048;
    bf16_t* O = (bf16_t*)(p.ws + WS_H);
    const float sc2 = 0.08838834764831845f * LOG2E;
    for (int unit = blockIdx.x; unit < 4160; unit += gridDim.x) {
        int hp, jt0, jhi, qvalid; long qrow0; const bf16_t* kb; const bf16_t* vb;
        if (unit < 4096) { hp = unit & 7; const int b = (unit >> 3) & 7, c = unit >> 6; qrow0 = (long)b * 4096 + c * 64; kb = Kg + (qrow0 - 512) * 2048; vb = Vg + (qrow0 - 512) * 2048; jt0 = c < 8 ? 8 - c : 0; jhi = 576; qvalid = 64; }
        else { const int su = unit - 4096; hp = su & 7; const int b = su >> 3; qrow0 = NP + b * 16; kb = (const bf16_t*)(p.ws + WS_KEA) + (size_t)b * 576 * 2048; vb = (const bf16_t*)(p.ws + WS_VEA) + (size_t)b * 576 * 2048; jt0 = 0; jhi = 528; qvalid = 16; }
        const int h = hp * 2 + hh;
        __syncthreads();
        for (int i = tid; i < 2 * 257; i += 512) { const int h2 = i >= 257 ? 1 : 0, ii = i - h2 * 257; btab[h2 * 260 + ii] = p.rel_bias_a[(hp * 2 + h2) * 257 + ii] * LOG2E; }
        bf16x8 qf[4];
        { const bf16_t* qp = Q + (size_t)(qrow0 + rg * 16 + l15) * 2048 + h * 128 + g * 8;
#pragma unroll
          for (int ks = 0; ks < 4; ++ks) qf[ks] = *(const bf16x8*)(qp + ks * 32); }
        f32x4 o[8];
#pragma unroll
        for (int i = 0; i < 8; ++i) o[i] = (f32x4){0.f, 0.f, 0.f, 0.f};
        float m = -1e30f, l = 0.f;
        u32x4 kr[4], vr[4];
        const int skey = tid >> 5, sch = tid & 31;
#pragma unroll
        for (int i = 0; i < 4; ++i) { const size_t off = (size_t)(jt0 * 64 + skey + 16 * i) * 2048 + hp * 256 + sch * 8; kr[i] = *(const u32x4*)(kb + off); vr[i] = *(const u32x4*)(vb + off); }
        for (int jt = jt0; jt < 9; ++jt) {
            __syncthreads();
#pragma unroll
            for (int i = 0; i < 4; ++i) { *(LAS u32x4*)(Kl + (skey + 16 * i) * KS + sch * 16) = kr[i]; *(LAS u32x4*)(Vl + (skey + 16 * i) * VS + sch * 16) = vr[i]; }
            __syncthreads();
            if (jt + 1 < 9) {
#pragma unroll
                for (int i = 0; i < 4; ++i) { const size_t off = (size_t)((jt + 1) * 64 + skey + 16 * i) * 2048 + hp * 256 + sch * 8; kr[i] = *(const u32x4*)(kb + off); vr[i] = *(const u32x4*)(vb + off); }
            }
            attn_tile<128, KS, VS, true>(Kl + hh * 256, Vl + hh * 256, qf, o, m, l, sc2, jt * 64, jhi, rg * 16 + l15, btab + hh * 260, lane);
        }
        l += __shfl_xor(l, 16); l += __shfl_xor(l, 32);
        const float inv = 1.f / l;
        if (rg * 16 + l15 < qvalid) { bf16_t* op = O + (size_t)(qrow0 + rg * 16 + l15) * 2048 + h * 128 + g * 4;
#pragma unroll
            for (int ds = 0; ds < 8; ++ds) { u32x2 w; w[0] = pk2(o[ds][0] * inv, o[ds][1] * inv); w[1] = pk2(o[ds][2] * inv, o[ds][3] * inv); *(u32x2*)(op + ds * 16) = w; } }
    }
}

__device__ __forceinline__ void attn_b_phase(const Params& p, LAS unsigned char* lds) {
    constexpr int KS = 144, VS = 160;
    const int tid = opaque_tid(), wid = tid >> 6, lane = tid & 63, g = lane >> 4, l15 = lane & 15;
    LAS unsigned char* Kl = lds; LAS unsigned char* Vl = lds + 192 * KS;
    const bf16_t* Q = (const bf16_t*)(p.ws + WS_BIG); const bf16_t* Kg = Q + (size_t)MP * 2048; const bf16_t* Vg = Kg + (size_t)MP * 512;
    bf16_t* O = (bf16_t*)(p.ws + WS_H);
    const float sc2 = 0.125f * LOG2E;
    for (int unit = blockIdx.x; unit < 4160; unit += gridDim.x) {
        int kvh, jt0, jhi, qvalid; long qrow0; const bf16_t* kb; const bf16_t* vb;
        if (unit < 4096) { kvh = unit & 7; const int b = (unit >> 3) & 7, c = unit >> 6; qrow0 = (long)b * 4096 + c * 64; kb = Kg + (qrow0 - 128) * 512; vb = Vg + (qrow0 - 128) * 512; jt0 = c < 2 ? 2 - c : 0; jhi = 192; qvalid = 64; }
        else { const int su = unit - 4096; kvh = su & 7; const int b = su >> 3; qrow0 = NP + b * 16; kb = (const bf16_t*)(p.ws + WS_KEB) + (size_t)b * 192 * 512; vb = (const bf16_t*)(p.ws + WS_VEB) + (size_t)b * 192 * 512; jt0 = 0; jhi = 144; qvalid = 16; }
        __syncthreads();
#pragma unroll
        for (int i = 0; i < 3; ++i) { const int ci = tid + 512 * i, key = ci >> 3, ch = ci & 7;
            if (key >= jt0 * 64) { const size_t off = (size_t)key * 512 + kvh * 64 + ch * 8;
                *(LAS u32x4*)(Kl + key * KS + ch * 16) = *(const u32x4*)(kb + off); *(LAS u32x4*)(Vl + key * VS + ch * 16) = *(const u32x4*)(vb + off); } }
        __syncthreads();
        const int h = kvh * 4 + (wid >> 1);
        const float sink2 = p.sink_b[h] * LOG2E;
        for (int rs = 0; rs < 2; ++rs) {
            const int qloc = (wid & 1) * 32 + rs * 16 + l15;
            bf16x8 qf[2];
            { const bf16_t* qp = Q + (size_t)(qrow0 + qloc) * 2048 + h * 64 + g * 8; qf[0] = *(const bf16x8*)qp; qf[1] = *(const bf16x8*)(qp + 32); }
            f32x4 o[4];
#pragma unroll
            for (int i = 0; i < 4; ++i) o[i] = (f32x4){0.f, 0.f, 0.f, 0.f};
            float m = sink2, l = (g == 0) ? 1.f : 0.f;
            for (int jt = jt0; jt < 3; ++jt)
                attn_tile<64, KS, VS, false>(Kl + jt * 64 * KS, Vl + jt * 64 * VS, qf, o, m, l, sc2, jt * 64, jhi, qloc, nullptr, lane);
            l += __shfl_xor(l, 16); l += __shfl_xor(l, 32);
            const float inv = 1.f / l;
            if (qloc < qvalid) { bf16_t* op = O + (size_t)(qrow0 + qloc) * 2048 + h * 64 + g * 4;
#pragma unroll
                for (int ds = 0; ds < 4; ++ds) { u32x2 w; w[0] = pk2(o[ds][0] * inv, o[ds][1] * inv); w[1] = pk2(o[ds][2] * inv, o[ds][3] * inv); *(u32x2*)(op + ds * 16) = w; } }
        }
    }
}

constexpr int LDS_BYTES = 131072;

__global__ void __launch_bounds__(512, 2) mega_fwd(Params p_unused) {
    extern __shared__ __attribute__((aligned(16))) unsigned char shm[];
    LAS unsigned char* lds = (LAS unsigned char*)shm;
    cg::grid_group grid = cg::this_grid();

    { const Params p = load_params(); phase0(p, lds); }
    grid.sync();
    { const Params p = load_params(); modulate0(p); }
    grid.sync();
    for (int l = 0; l < 2; ++l) {
        if (l == 0) {
            { const Params p = load_params(); pg8::StaticOrder S; S.init(MP, 6144, gridDim.x, blockIdx.x);
              EpiQkvA E{p.ws, p.out};
              pg8::gemm_phase(lds, pg8::Gemm{(const bf16_t*)(p.ws + WS_H), (const bf16_t*)(p.ws + WS_WQKVA), MP, 6144, 2048}, S, E); }
            grid.sync();
            { const Params p = load_params(); attn_a_phase(p, lds); }
        } else {
            { const Params p = load_params(); pg8::StaticOrder S; S.init(MP, 3072, gridDim.x, blockIdx.x);
              EpiQkvB E{p.ws, p.out};
              pg8::gemm_phase(lds, pg8::Gemm{(const bf16_t*)(p.ws + WS_H), (const bf16_t*)(p.ws + WS_WQKVB), MP, 3072, 2048}, S, E); }
            grid.sync();
            { const Params p = load_params(); attn_b_phase(p, lds); }
        }
        grid.sync();
        {
            const Params p = load_params(); pg8::StaticOrder S; S.init(MP, 2048, gridDim.x, blockIdx.x);
            const float* mod = (const float*)(p.ws + WS_MOD);
            EpiRes E{l == 0 ? p.x_prompt : p.out, l == 0 ? p.x_sample : p.out + (size_t)NP * 2048, mod + (size_t)(2 * l) * 16 * 6144 + 4096, p.out};
            pg8::gemm_phase(lds, pg8::Gemm{(const bf16_t*)(p.ws + WS_H), (const bf16_t*)(p.ws + (l == 0 ? WS_WOA : WS_WOB)), MP, 2048, 2048}, S, E);
        }
        grid.sync();
        { const Params p = load_params(); const float* mod = (const float*)(p.ws + WS_MOD);
          ln_phase(p, p.ln_g + (2 * l) * 2048, p.ln_b + (2 * l) * 2048, mod + (size_t)(2 * l + 1) * 16 * 6144); }
        grid.sync();
        {
            const Params p = load_params(); pg8::StaticOrder S; S.init(MP, 8192, gridDim.x, blockIdx.x);
            EpiUp E{(bf16_t*)(p.ws + WS_BIG)};
            pg8::gemm_phase(lds, pg8::Gemm{(const bf16_t*)(p.ws + WS_H), (const bf16_t*)(p.ws + WS_WUP) + (size_t)l * 2048 * 8192, MP, 8192, 2048}, S, E);
        }
        grid.sync();
        {
            const Params p = load_params(); pg8::StaticOrder S; S.init(MP, 2048, gridDim.x, blockIdx.x);
            const float* mod = (const float*)(p.ws + WS_MOD);
            EpiRes E{p.out, p.out + (size_t)NP * 2048, mod + (size_t)(2 * l + 1) * 16 * 6144 + 4096, p.out};
            pg8::gemm_phase(lds, pg8::Gemm{(const bf16_t*)(p.ws + WS_BIG), (const bf16_t*)(p.ws + WS_WDN) + (size_t)l * 2048 * 8192, MP, 2048, 8192}, S, E);
        }
        grid.sync();
        { const Params p = load_params(); const float* mod = (const float*)(p.ws + WS_MOD);
          ln_phase(p, p.ln_g + (2 * l + 1) * 2048, p.ln_b + (2 * l + 1) * 2048, l == 0 ? mod + (size_t)2 * 16 * 6144 : nullptr); }
        if (l == 0) grid.sync();
    }
}

extern "C" void kernel_launch(void* const* d_in, const int* in_sizes, int n_in, void* d_out, int out_size, void* d_ws, size_t ws_size, hipStream_t stream) {
    static int grid_blocks = 0;
    if (grid_blocks == 0) {
        if (ws_size < WS_END) { fprintf(stderr, "kernel_launch: workspace too small (%zu < %zu)\n", ws_size, (size_t)WS_END); grid_blocks = -1; return; }
        int dev = 0, cus = 0, per_cu = 0;
        (void)hipGetDevice(&dev);
        (void)hipDeviceGetAttribute(&cus, hipDeviceAttributeMultiprocessorCount, dev);
        if (hipFuncSetAttribute((const void*)mega_fwd, hipFuncAttributeMaxDynamicSharedMemorySize, LDS_BYTES) != hipSuccess) { fprintf(stderr, "kernel_launch: hipFuncSetAttribute failed\n"); grid_blocks = -1; return; }
        if (hipOccupancyMaxActiveBlocksPerMultiprocessor(&per_cu, (const void*)mega_fwd, 512, LDS_BYTES) != hipSuccess || per_cu < 1) { fprintf(stderr, "kernel_launch: occupancy query says %d blocks/CU\n", per_cu); per_cu = 1; }
        (void)hipGetLastError();
        grid_blocks = cus;
    }
    if (grid_blocks < 0) return;
    Params p{};
    p.x_prompt = (const float*)d_in[0]; p.x_sample = (const float*)d_in[1];
    p.cache_a_k = (const float*)d_in[2]; p.cache_a_v = (const float*)d_in[3]; p.cache_b_k = (const float*)d_in[4]; p.cache_b_v = (const float*)d_in[5];
    p.c_prompt = (const float*)d_in[6]; p.c_sample = (const float*)d_in[7];
    p.w_ada = (const float*)d_in[8]; p.b_ada = (const float*)d_in[9]; p.ln_g = (const float*)d_in[10]; p.ln_b = (const float*)d_in[11];
    p.w_qkv_a = (const float*)d_in[12]; p.w_o_a = (const float*)d_in[13]; p.rel_bias_a = (const float*)d_in[14];
    p.w_qkv_b = (const float*)d_in[15]; p.w_o_b = (const float*)d_in[16]; p.sink_b = (const float*)d_in[17];
    p.w_up = (const float*)d_in[18]; p.w_down = (const float*)d_in[19];
    p.out = (float*)d_out; p.ws = (unsigned char*)d_ws;
    void* args[] = {&p};
    hipError_t e = hipLaunchCooperativeKernel((const void*)mega_fwd, dim3(grid_blocks), dim3(512), args, LDS_BYTES, stream);
    if (e != hipSuccess) fprintf(stderr, "cooperative launch failed: %s (grid %d)\n", hipGetErrorString(e), grid_blocks);
}
```

```cpp
#include <hip/hip_runtime.h>
#include <hip/hip_cooperative_groups.h>
#include <cstdio>
namespace cg = cooperative_groups;

#define LAS __attribute__((address_space(3)))
#ifndef PROBE_MASK
#define PROBE_MASK 0
#endif
#define PB_BEGIN(bit) do { if (PROBE_MASK & (bit)) pb_t0 = __builtin_amdgcn_s_memrealtime(); } while (0)
#define PB_END(bit)   do { if (PROBE_MASK & (bit)) pb_acc += __builtin_amdgcn_s_memrealtime() - pb_t0; } while (0)
typedef unsigned short bf16_t;
typedef short bf16x8 __attribute__((ext_vector_type(8)));
typedef short bf16x4 __attribute__((ext_vector_type(4)));
typedef float f32x4 __attribute__((ext_vector_type(4)));
typedef unsigned u32x4 __attribute__((ext_vector_type(4)));
typedef unsigned u32x2 __attribute__((ext_vector_type(2)));
typedef float f32x2 __attribute__((ext_vector_type(2)));

constexpr int DM = 2048;
constexpr int NP = 32768;
constexpr int NREAL = 32896;
constexpr int MP = 33024;
constexpr float ALPHA = 1.41421356237309515f;
constexpr float LOG2E = 1.44269504088896341f;

constexpr size_t WS_WQKVA = 0;
constexpr size_t WS_WOA   = WS_WQKVA + (size_t)6144 * 2048 * 2;
constexpr size_t WS_WQKVB = WS_WOA + (size_t)2048 * 2048 * 2;
constexpr size_t WS_WOB   = WS_WQKVB + (size_t)3072 * 2048 * 2;
constexpr size_t WS_WUP   = WS_WOB + (size_t)2048 * 2048 * 2;
constexpr size_t WS_WDN   = WS_WUP + (size_t)2 * 8192 * 2048 * 2;
constexpr size_t WS_BIG   = WS_WDN + (size_t)2 * 8192 * 2048 * 2;
constexpr size_t WS_H     = WS_BIG + (size_t)MP * 8192 * 2;
constexpr size_t WS_KEA   = WS_H + (size_t)MP * 2048 * 2;
constexpr size_t WS_VEA   = WS_KEA + (size_t)8 * 576 * 2048 * 2;
constexpr size_t WS_KEB   = WS_VEA + (size_t)8 * 576 * 2048 * 2;
constexpr size_t WS_VEB   = WS_KEB + (size_t)8 * 192 * 512 * 2;
constexpr size_t WS_MOD   = WS_VEB + (size_t)8 * 192 * 512 * 2;
constexpr size_t WS_ROPE  = WS_MOD + (size_t)4 * 16 * 6144 * 4;
constexpr size_t WS_STATS = WS_ROPE + (size_t)4112 * 16 * 4;
constexpr size_t WS_Z     = WS_STATS + (size_t)NREAL * 2 * 4;
constexpr size_t WS_BAR   = WS_Z + (size_t)NREAL * 2048 * 2;
constexpr size_t WS_END   = WS_BAR + 16384;

constexpr size_t O_Y    = 0;
constexpr size_t O_AKP  = (size_t)NREAL * 2048;
constexpr size_t O_AVP  = O_AKP + (size_t)8 * 512 * 2048;
constexpr size_t O_BKP  = O_AVP + (size_t)8 * 512 * 2048;
constexpr size_t O_BVP  = O_BKP + (size_t)8 * 128 * 512;
constexpr size_t O_AKS  = O_BVP + (size_t)8 * 128 * 512;
constexpr size_t O_AVS  = O_AKS + (size_t)128 * 2048;
constexpr size_t O_BKS  = O_AVS + (size_t)128 * 2048;
constexpr size_t O_BVS  = O_BKS + (size_t)128 * 512;

struct Params {
    const float* x_prompt; const float* x_sample;
    const float* cache_a_k; const float* cache_a_v; const float* cache_b_k; const float* cache_b_v;
    const float* c_prompt; const float* c_sample;
    const float* w_ada; const float* b_ada; const float* ln_g; const float* ln_b;
    const float* w_qkv_a; const float* w_o_a; const float* rel_bias_a;
    const float* w_qkv_b; const float* w_o_b; const float* sink_b;
    const float* w_up; const float* w_down;
    float* out; unsigned char* ws;
};

typedef const __attribute__((address_space(4))) struct Params* KParamPtr;
__device__ __forceinline__ Params load_params() {
#if defined(__HIP_DEVICE_COMPILE__)
    auto k = __builtin_amdgcn_kernarg_segment_ptr();
    asm volatile("" : "+s"(k));
    return *(KParamPtr)k;
#else
    return Params{};
#endif
}
__device__ __forceinline__ int opaque_tid(int wv) { unsigned z = 0u; asm volatile("" : "+v"(z));
    return (wv << 6) | (int)__builtin_amdgcn_mbcnt_hi(~0u, __builtin_amdgcn_mbcnt_lo(~0u, z)); }
__device__ __forceinline__ float shx(float v, int mask, int lane) { return __int_as_float(__builtin_amdgcn_ds_bpermute((lane ^ mask) << 2, __float_as_int(v))); }
template <int CTRL> __device__ __forceinline__ float dppf(float v) { return __int_as_float(__builtin_amdgcn_update_dpp(0, __float_as_int(v), CTRL, 0xf, 0xf, true)); }
__device__ __forceinline__ float xmax16(float v) { const auto r = __builtin_amdgcn_permlane16_swap(__float_as_uint(v), __float_as_uint(v), false, false); return fmaxf(__uint_as_float(r[0]), __uint_as_float(r[1])); }
__device__ __forceinline__ float xmax32(float v) { const auto r = __builtin_amdgcn_permlane32_swap(__float_as_uint(v), __float_as_uint(v), false, false); return fmaxf(__uint_as_float(r[0]), __uint_as_float(r[1])); }
__device__ __forceinline__ float xsum16(float v) { const auto r = __builtin_amdgcn_permlane16_swap(__float_as_uint(v), __float_as_uint(v), false, false); return __uint_as_float(r[0]) + __uint_as_float(r[1]); }
__device__ __forceinline__ float xsum32(float v) { const auto r = __builtin_amdgcn_permlane32_swap(__float_as_uint(v), __float_as_uint(v), false, false); return __uint_as_float(r[0]) + __uint_as_float(r[1]); }
__device__ __forceinline__ float xchg16(float v, bool odd_row) { const auto r = __builtin_amdgcn_permlane16_swap(__float_as_uint(v), __float_as_uint(v), false, false); return __uint_as_float(odd_row ? r[0] : r[1]); }
__device__ __forceinline__ float xchg32(float v, bool upper) { const auto r = __builtin_amdgcn_permlane32_swap(__float_as_uint(v), __float_as_uint(v), false, false); return __uint_as_float(upper ? r[0] : r[1]); }
__device__ __forceinline__ float wave_sum(float v) {
    v += dppf<0xB1>(v); v += dppf<0x4E>(v); v += dppf<0x141>(v); v += dppf<0x140>(v); v = xsum16(v); return xsum32(v); }
__device__ __forceinline__ float bf_lo(unsigned w) { return __uint_as_float(w << 16); }
__device__ __forceinline__ float bf_hi(unsigned w) { return __uint_as_float(w & 0xffff0000u); }
__device__ __forceinline__ unsigned pk2(float lo, float hi) { unsigned r; asm("v_cvt_pk_bf16_f32 %0, %1, %2" : "=v"(r) : "v"(lo), "v"(hi)); return r; }

namespace pg8 {
constexpr int BM = 256, BK = 64, HALF = 128, HTB = HALF * BK * 2, STAGE_BYTES = 8 * HTB, NXCD = 8, WGM = 4;
__device__ __forceinline__ int lds_byte(int r, int c) { const int st = (r >> 4) * 2 + (c >> 5), rr = r & 15, cc = c & 31, ob = rr * 64 + cc * 2; return st * 1024 + (ob ^ (((ob >> 9) & 1) << 5)); }
__device__ __forceinline__ void stage_rc(int b, int& R, int& C) { const int st = b / 1024, sb = b % 1024, swz = sb ^ (((sb >> 9) & 1) << 5); R = (st >> 1) * 16 + swz / 64; C = (st & 1) * 32 + (swz % 64) / 2; }
__device__ __forceinline__ int perm32(int rho) { const int n = rho >> 4, i = rho & 15; return 8 * (i >> 2) + 4 * n + (i & 3); }
struct Unit { int pm, pn; };
struct Gemm { const bf16_t* A; const bf16_t* Bt; int M, N, K; };
struct StaticOrder {
    int nM, nN, nwg, G, c;
    __device__ void init(int M, int N, int G_, int c_) { nM = M / BM; nN = N / BM; nwg = nM * nN; G = G_; c = c_; }
    __device__ bool next(int i, Unit& u) const {
        const long L = (long)i * G + c; if (L >= nwg) return false;
        int wgid = (int)L; { const int q = nwg / NXCD, r = nwg % NXCD, xcd = wgid % NXCD, off = wgid / NXCD; wgid = (xcd < r ? xcd * (q + 1) : r * (q + 1) + (xcd - r) * q) + off; }
        const int nig = WGM * nN, gid = wgid / nig, fm = gid * WGM, gsz = (nM - fm) < WGM ? (nM - fm) : WGM;
        u.pm = fm + ((wgid % nig) % gsz); u.pn = (wgid % nig) / gsz; return true;
    }
};

template <class Epi>
__device__ __forceinline__ void gemm_phase(LAS unsigned char* lds, const Gemm g, const StaticOrder& S, const Epi& E, int wv) {
    const int tid = opaque_tid(wv), wid = __builtin_amdgcn_readfirstlane(tid >> 6), lane = tid & 63, wr = wid >> 2, wc = wid & 3, fr = lane & 15, fq = lane >> 4;
    const int K = g.K, nt = K / BK;
    unsigned voffA[2], voffB[2];
#pragma unroll
    for (int i = 0; i < 2; ++i) { int R, C; stage_rc(tid * 16 + i * 8192, R, C); const int Rb = Epi::PERM ? ((R & ~31) + perm32(R & 31)) : R;
        voffA[i] = (unsigned)(R * K + C) * 2u; voffB[i] = (unsigned)(Rb * K + C) * 2u; }
    const size_t kstep = (size_t)(BK * 2);
    const size_t hstep = (size_t)HALF * K * 2;
    const size_t tstep = 2 * hstep;
    const unsigned ldsw = (unsigned)wid * 1024u;
    const int aoff = lds_byte(wr * 64 + fr, fq * 8), boff = lds_byte(wc * 32 + fr, fq * 8);
#define PG8_SA(b, h) (((b) * 2 + (h)) * HTB)
#define PG8_SB(b, h) ((4 + (b) * 2 + (h)) * HTB)
#define PG8_STAGE(bufoff, gbase, voff) do { _Pragma("unroll") for (int _i = 0; _i < 2; ++_i) \
        __builtin_amdgcn_global_load_lds((const unsigned*)((const char*)(gbase) + (voff)[_i]), (LAS unsigned*)(lds + (bufoff) + ldsw + _i * 8192), 16, 0, 0); } while (0)
#define PG8_LDA(dst, b, h) do { _Pragma("unroll") for (int m = 0; m < 4; ++m) _Pragma("unroll") for (int k = 0; k < 2; ++k) dst[m][k] = *(const LAS bf16x8*)(lds + PG8_SA(b, h) + aoff + m * 2048 + k * 1024); } while (0)
#define PG8_LDB(dst, b, h) do { _Pragma("unroll") for (int n = 0; n < 2; ++n) _Pragma("unroll") for (int k = 0; k < 2; ++k) dst[n][k] = *(const LAS bf16x8*)(lds + PG8_SB(b, h) + boff + n * 2048 + k * 1024); } while (0)
#define PG8_MMA(ai, bj, At, Bt) do { __builtin_amdgcn_s_setprio(1); _Pragma("unroll") for (int m = 0; m < 4; ++m) _Pragma("unroll") for (int n = 0; n < 2; ++n) _Pragma("unroll") for (int k = 0; k < 2; ++k) \
        acc[ai][bj][m][n] = __builtin_amdgcn_mfma_f32_16x16x32_bf16(Bt[n][k], At[m][k], acc[ai][bj][m][n], 0, 0, 0); __builtin_amdgcn_s_setprio(0); } while (0)
#define PG8_WAIT_V(n) asm volatile("s_waitcnt vmcnt(" #n ")" ::: "memory")
#define PG8_WAIT_L(n) asm volatile("s_waitcnt lgkmcnt(" #n ")" ::: "memory")
#define PG8_BAR __builtin_amdgcn_s_barrier()
#define PG8_SCHED __builtin_amdgcn_sched_barrier(0)
    Unit cur, nxt; int ui = 0;
    if (!S.next(0, cur)) return;
    f32x4 acc[2][2][4][2];
#pragma unroll
    for (int a = 0; a < 2; ++a)
#pragma unroll
        for (int b = 0; b < 2; ++b)
#pragma unroll
            for (int m = 0; m < 4; ++m)
#pragma unroll
                for (int n = 0; n < 2; ++n) acc[a][b][m][n] = (f32x4){0.f, 0.f, 0.f, 0.f};
    bf16x8 At[4][2], B0[2][2], B1[2][2];
    const char* cA = (const char*)g.A + (size_t)cur.pm * tstep; const char* cB = (const char*)g.Bt + (size_t)cur.pn * tstep;
    PG8_STAGE(PG8_SB(0, 0), cB, voffB); PG8_STAGE(PG8_SA(0, 0), cA, voffA); PG8_STAGE(PG8_SB(0, 1), cB + hstep, voffB); PG8_STAGE(PG8_SA(0, 1), cA + hstep, voffA);
    if (wr == 1) PG8_BAR;
    PG8_WAIT_V(4); PG8_BAR;
    PG8_STAGE(PG8_SB(1, 0), cB + kstep, voffB); PG8_STAGE(PG8_SA(1, 0), cA + kstep, voffA); PG8_STAGE(PG8_SB(1, 1), cB + hstep + kstep, voffB);
    PG8_WAIT_V(6); PG8_BAR;
    for (;;) {
        const bool has_next = S.next(ui + 1, nxt);
        const char* nA = has_next ? (const char*)g.A + (size_t)nxt.pm * tstep : cA; const char* nB = has_next ? (const char*)g.Bt + (size_t)nxt.pn * tstep : cB;
        for (int t = 0; t < nt; t += 2) {
            const bool last = (t == nt - 2);
            const char* a1 = cA + (size_t)(t + 1) * kstep;
            const char* a2 = last ? nA : cA + (size_t)(t + 2) * kstep; const char* b2 = last ? nB : cB + (size_t)(t + 2) * kstep;
            const char* a3 = a2 + kstep; const char* b3 = b2 + kstep;
            PG8_LDB(B0, 0, 0); PG8_SCHED; PG8_LDA(At, 0, 0); PG8_STAGE(PG8_SA(1, 1), a1 + hstep, voffA);
            PG8_WAIT_L(8); PG8_BAR; PG8_WAIT_L(0); PG8_MMA(0, 0, At, B0); PG8_BAR; PG8_SCHED;
            PG8_LDB(B1, 0, 1); PG8_STAGE(PG8_SB(0, 0), b2, voffB);
            PG8_BAR; PG8_WAIT_L(0); PG8_MMA(0, 1, At, B1); PG8_BAR;
            PG8_LDA(At, 0, 1); PG8_STAGE(PG8_SA(0, 0), a2, voffA);
            PG8_BAR; PG8_WAIT_L(0); PG8_MMA(1, 0, At, B0); PG8_BAR; PG8_SCHED;
            PG8_STAGE(PG8_SB(0, 1), b2 + hstep, voffB);
            PG8_WAIT_V(6); PG8_BAR; PG8_MMA(1, 1, At, B1); PG8_BAR;
            PG8_LDB(B0, 1, 0); PG8_SCHED; PG8_LDA(At, 1, 0); PG8_STAGE(PG8_SA(0, 1), a2 + hstep, voffA);
            PG8_WAIT_L(8); PG8_BAR; PG8_WAIT_L(0); PG8_MMA(0, 0, At, B0); PG8_BAR; PG8_SCHED;
            PG8_LDB(B1, 1, 1); PG8_STAGE(PG8_SB(1, 0), b3, voffB);
            PG8_BAR; PG8_WAIT_L(0); PG8_MMA(0, 1, At, B1); PG8_BAR;
            PG8_LDA(At, 1, 1); PG8_STAGE(PG8_SA(1, 0), a3, voffA);
            PG8_BAR; PG8_WAIT_L(0); PG8_MMA(1, 0, At, B0); PG8_BAR; PG8_SCHED;
            PG8_STAGE(PG8_SB(1, 1), b3 + hstep, voffB);
            PG8_WAIT_V(6); PG8_BAR; PG8_MMA(1, 1, At, B1); PG8_BAR;
        }
        E(acc, cur, wr, wc, fr, fq);
        if (!has_next) break;
#pragma unroll
        for (int a = 0; a < 2; ++a)
#pragma unroll
            for (int b = 0; b < 2; ++b)
#pragma unroll
                for (int m = 0; m < 4; ++m)
#pragma unroll
                    for (int n = 0; n < 2; ++n) acc[a][b][m][n] = (f32x4){0.f, 0.f, 0.f, 0.f};
        cur = nxt; cA = nA; cB = nB; ++ui;
    }
    PG8_WAIT_V(0);
    if (wr == 0) PG8_BAR;
    PG8_BAR;
#undef PG8_SA
#undef PG8_SB
#undef PG8_STAGE
#undef PG8_LDA
#undef PG8_LDB
#undef PG8_MMA
#undef PG8_WAIT_V
#undef PG8_WAIT_L
#undef PG8_BAR
#undef PG8_SCHED
}
}
using pg8::Unit;

struct EpiQkvA {
    static constexpr bool PERM = true;
    unsigned char* ws; float* out;
    __device__ __forceinline__ void operator()(const f32x4 (&acc)[2][2][4][2], const Unit& u, int wr, int wc, int fr, int fq) const {
        const int which = u.pn >> 3, colt = (u.pn & 7) * 256;
        const int row0 = u.pm * 256 + wr * 64 + fr, col0 = colt + wc * 32 + 8 * fq;
        bf16_t* base = (bf16_t*)(ws + WS_BIG) + (size_t)which * MP * 2048;
        bf16_t* ext = (bf16_t*)(ws + (which == 1 ? WS_KEA : WS_VEA));
        float* oP = out + (which == 1 ? O_AKP : O_AVP);
        float* oS = out + (which == 1 ? O_AKS : O_AVS);
        constexpr bool prompt = true; const bool cache_tile = ((u.pm & 15) >= 14) && which > 0;
#pragma unroll
        for (int ai = 0; ai < 2; ++ai)
#pragma unroll
            for (int m = 0; m < 4; ++m) {
                const int row = row0 + ai * 128 + m * 16;
#pragma unroll
                for (int bj = 0; bj < 2; ++bj) {
                    const f32x4 v0 = acc[ai][bj][m][0], v1 = acc[ai][bj][m][1];
                    const int col = col0 + bj * 128;
                    u32x4 pk; pk[0] = pk2(v0[0], v0[1]); pk[1] = pk2(v0[2], v0[3]); pk[2] = pk2(v1[0], v1[1]); pk[3] = pk2(v1[2], v1[3]);
                    if (prompt || which == 0) *(u32x4*)(base + (size_t)row * 2048 + col) = pk;
                    if (cache_tile) { const int b = row >> 12, t = (row & 4095) - 3584; float* o = oP + ((size_t)(b * 512 + t)) * 2048 + col; *(f32x4*)o = v0; *(f32x4*)(o + 4) = v1; }
                    if (!prompt && which > 0 && row < NREAL) { const int sr = row - NP, b = sr >> 4, t = sr & 15;
                        *(u32x4*)(ext + ((size_t)(b * 576 + 512 + t)) * 2048 + col) = pk;
                        float* o = oS + (size_t)sr * 2048 + col; *(f32x4*)o = v0; *(f32x4*)(o + 4) = v1; }
                }
            }
    }
};

struct EpiQkvB {
    static constexpr bool PERM = true;
    unsigned char* ws; float* out;
    __device__ __forceinline__ void operator()(const f32x4 (&acc)[2][2][4][2], const Unit& u, int wr, int wc, int fr, int fq) const {
        const float* rope = (const float*)(ws + WS_ROPE);
        const int which = u.pn < 8 ? 0 : (u.pn < 10 ? 1 : 2);
        const int colt = which == 0 ? u.pn * 256 : (which == 1 ? (u.pn - 8) * 256 : (u.pn - 10) * 256);
        const int ld = which == 0 ? 2048 : 512;
        const int row0 = u.pm * 256 + wr * 64 + fr, col0 = colt + wc * 32 + 8 * fq;
        bf16_t* base = (bf16_t*)(ws + WS_BIG) + (which == 0 ? (size_t)0 : (which == 1 ? (size_t)MP * 2048 : (size_t)MP * 2048 + (size_t)MP * 512));
        bf16_t* ext = (bf16_t*)(ws + (which == 1 ? WS_KEB : WS_VEB));
        float* oP = out + (which == 1 ? O_BKP : O_BVP);
        float* oS = out + (which == 1 ? O_BKS : O_BVS);
        constexpr bool prompt = true; const bool last_tile = ((u.pm & 15) == 15) && which > 0;
        const bool do_rope = (which < 2) && ((wc & 1) == 0);
#pragma unroll
        for (int ai = 0; ai < 2; ++ai) {
            f32x4 rc[4][4];
            if (do_rope) {
#pragma unroll
                for (int m = 0; m < 4; ++m) { const int row = row0 + ai * 128 + m * 16; const float* rp = rope + (size_t)(row & 4095) * 16;
#pragma unroll
                    for (int q = 0; q < 4; ++q) rc[m][q] = *(const f32x4*)(rp + q * 4); } }
#pragma unroll
            for (int m = 0; m < 4; ++m) {
                const int row = row0 + ai * 128 + m * 16;
#pragma unroll
                for (int bj = 0; bj < 2; ++bj) {
                    f32x4 v0 = acc[ai][bj][m][0], v1 = acc[ai][bj][m][1];
                    if (do_rope) {
                        f32x4 p0, p1;
#pragma unroll
                        for (int j = 0; j < 4; ++j) { p0[j] = xchg16(v0[j], (fq & 1) != 0); p1[j] = xchg16(v1[j], (fq & 1) != 0); }
                        if (fq == 0) { v0 = v0 * rc[m][0] - p0 * rc[m][2]; v1 = v1 * rc[m][1] - p1 * rc[m][3]; }
                        else if (fq == 1) { v0 = v0 * rc[m][0] + p0 * rc[m][2]; v1 = v1 * rc[m][1] + p1 * rc[m][3]; }
                    }
                    const int col = col0 + bj * 128;
                    u32x4 pk; pk[0] = pk2(v0[0], v0[1]); pk[1] = pk2(v0[2], v0[3]); pk[2] = pk2(v1[0], v1[1]); pk[3] = pk2(v1[2], v1[3]);
                    *(u32x4*)(base + (size_t)row * ld + col) = pk;
                    if (last_tile && ai == 1) { const int b = row >> 12, t = (row & 4095) - 3968; float* o = oP + ((size_t)(b * 128 + t)) * 512 + col; *(f32x4*)o = v0; *(f32x4*)(o + 4) = v1; }
                }
            }
        }
    }
};

struct EpiUp {
    static constexpr bool PERM = true;
    bf16_t* U;
    __device__ __forceinline__ void operator()(const f32x4 (&acc)[2][2][4][2], const Unit& u, int wr, int wc, int fr, int fq) const {
        const int row0 = u.pm * 256 + wr * 64 + fr, col0 = u.pn * 256 + wc * 32 + 8 * fq;
#pragma unroll
        for (int ai = 0; ai < 2; ++ai)
#pragma unroll
            for (int m = 0; m < 4; ++m) {
                bf16_t* rowp = U + (size_t)(row0 + ai * 128 + m * 16) * 8192 + col0;
#pragma unroll
                for (int bj = 0; bj < 2; ++bj) {
                    f32x4 v0 = acc[ai][bj][m][0], v1 = acc[ai][bj][m][1];
#pragma unroll
                    for (int j = 0; j < 4; ++j) { const float a = fmaxf(v0[j], 0.f), b = fmaxf(v1[j], 0.f); v0[j] = a * a; v1[j] = b * b; }
                    u32x4 pk; pk[0] = pk2(v0[0], v0[1]); pk[1] = pk2(v0[2], v0[3]); pk[2] = pk2(v1[0], v1[1]); pk[3] = pk2(v1[2], v1[3]);
                    *(u32x4*)(rowp + bj * 128) = pk;
                }
            }
    }
};

template <bool HASX>
struct EpiRes {
    static constexpr bool PERM = true;
    const float* xin; bf16_t* Z; const float* gate  ; const float* stats; const float* lng; const float* lnb;
    __device__ __forceinline__ void operator()(const f32x4 (&acc)[2][2][4][2], const Unit& u, int wr, int wc, int fr, int fq) const {
        const int row0 = u.pm * 256 + wr * 64 + fr, col0 = u.pn * 256 + wc * 32 + 8 * fq;
        const float* gr = gate + (size_t)(u.pm >> 4) * 6144 + col0;
        f32x4 gv[2][2], gw[2][2], bw[2][2];
#pragma unroll
        for (int bj = 0; bj < 2; ++bj)
#pragma unroll
            for (int n = 0; n < 2; ++n) { gv[bj][n] = *(const f32x4*)(gr + bj * 128 + n * 4);
                if (!HASX) { gw[bj][n] = *(const f32x4*)(lng + col0 + bj * 128 + n * 4); bw[bj][n] = *(const f32x4*)(lnb + col0 + bj * 128 + n * 4); } }
#pragma unroll
        for (int ai = 0; ai < 2; ++ai) {
            u32x4 zz[4][2]; f32x2 st[4]; f32x4 xx[4][2][2];
#pragma unroll
            for (int m = 0; m < 4; ++m) { const int row = row0 + ai * 128 + m * 16;
                if (HASX) {
#pragma unroll
                    for (int bj = 0; bj < 2; ++bj) { const float* xr = xin + (size_t)row * 2048 + col0 + bj * 128; xx[m][bj][0] = *(const f32x4*)xr; xx[m][bj][1] = *(const f32x4*)(xr + 4); }
                } else { st[m] = *(const f32x2*)(stats + (size_t)row * 2);
#pragma unroll
                    for (int bj = 0; bj < 2; ++bj) zz[m][bj] = *(const u32x4*)(Z + (size_t)row * 2048 + col0 + bj * 128); } }
#pragma unroll
            for (int m = 0; m < 4; ++m) { const int row = row0 + ai * 128 + m * 16;
                bf16_t* zr = Z + (size_t)row * 2048 + col0;
#pragma unroll
                for (int bj = 0; bj < 2; ++bj) {
                    f32x4 x0, x1;
                    if (HASX) { x0 = xx[m][bj][0]; x1 = xx[m][bj][1]; }
                    else { const u32x4 q = zz[m][bj];
                        x0[0] = bf_lo(q[0]); x0[1] = bf_hi(q[0]); x0[2] = bf_lo(q[1]); x0[3] = bf_hi(q[1]); x1[0] = bf_lo(q[2]); x1[1] = bf_hi(q[2]); x1[2] = bf_lo(q[3]); x1[3] = bf_hi(q[3]);
                        x0 = (x0 - st[m][0]) * st[m][1] * gw[bj][0] + bw[bj][0]; x1 = (x1 - st[m][0]) * st[m][1] * gw[bj][1] + bw[bj][1]; }
                    const f32x4 z0 = x0 * ALPHA + gv[bj][0] * acc[ai][bj][m][0], z1 = x1 * ALPHA + gv[bj][1] * acc[ai][bj][m][1];
                    u32x4 pk; pk[0] = pk2(z0[0], z0[1]); pk[1] = pk2(z0[2], z0[3]); pk[2] = pk2(z1[0], z1[1]); pk[3] = pk2(z1[2], z1[3]);
                    *(u32x4*)(zr + bj * 128) = pk;
                }
            }
        }
    }
};

template <class SEpi>
__device__ __forceinline__ void skinny_gemm(LAS unsigned char* lds, const bf16_t* A, int lda, const bf16_t* Wt, int N, int K, const SEpi& E, int wv) {
    const int tid = opaque_tid(wv), wid = tid >> 6, lane = tid & 63, g = lane >> 4, l15 = lane & 15;
    const int kw = K >> 3;
    const bf16_t* ap = A + (size_t)l15 * lda + wid * kw + g * 8;
    LAS f32x4* red = (LAS f32x4*)lds;
    for (int tile = blockIdx.x; tile < (N >> 4); tile += gridDim.x) {
        const int n0 = tile * 16;
        const bf16_t* bp = Wt + (size_t)(n0 + l15) * K + wid * kw + g * 8;
        f32x4 acc[8];
#pragma unroll
        for (int rt = 0; rt < 8; ++rt) acc[rt] = (f32x4){0.f, 0.f, 0.f, 0.f};
        for (int k0 = 0; k0 < kw; k0 += 64) {
            bf16x8 b[2], a[2][8];
#pragma unroll
            for (int i = 0; i < 2; ++i) { b[i] = *(const bf16x8*)(bp + k0 + i * 32);
#pragma unroll
                for (int rt = 0; rt < 8; ++rt) a[i][rt] = *(const bf16x8*)(ap + (size_t)rt * 16 * lda + k0 + i * 32); }
            __builtin_amdgcn_sched_barrier(0);
#pragma unroll
            for (int i = 0; i < 2; ++i)
#pragma unroll
                for (int rt = 0; rt < 8; ++rt) acc[rt] = __builtin_amdgcn_mfma_f32_16x16x32_bf16(b[i], a[i][rt], acc[rt], 0, 0, 0);
            __builtin_amdgcn_sched_barrier(0);
        }
        __syncthreads();
#pragma unroll
        for (int rt = 0; rt < 8; ++rt) red[(wid * 8 + rt) * 64 + lane] = acc[rt];
        __syncthreads();
        f32x4 s = red[wid * 64 + lane];
#pragma unroll
        for (int wv = 1; wv < 8; ++wv) s += red[(wv * 8 + wid) * 64 + lane];
        E(s, wid * 16 + l15, n0, g);
    }
}
struct SEpiQkvA {
    unsigned char* ws; float* out;
    __device__ __forceinline__ void operator()(f32x4 v, int r, int n0, int g) const {
        const int which = n0 >> 11, col = (n0 & 2047) + g * 4;
        u32x2 pk; pk[0] = pk2(v[0], v[1]); pk[1] = pk2(v[2], v[3]);
        if (which == 0) { *(u32x2*)((bf16_t*)(ws + WS_BIG) + (size_t)(NP + r) * 2048 + col) = pk; return; }
        const int b = r >> 4, t = r & 15;
        *(u32x2*)((bf16_t*)(ws + (which == 1 ? WS_KEA : WS_VEA)) + ((size_t)(b * 576 + 512 + t)) * 2048 + col) = pk;
        *(f32x4*)(out + (which == 1 ? O_AKS : O_AVS) + (size_t)r * 2048 + col) = v;
    }
};
struct SEpiQkvB {
    unsigned char* ws; float* out;
    __device__ __forceinline__ void operator()(f32x4 v, int r, int n0, int g) const {
        const int which = n0 < 2048 ? 0 : (n0 < 2560 ? 1 : 2);
        if (which < 2 && (n0 & 63) == 0) {
            const float* rp = (const float*)(ws + WS_ROPE) + (size_t)(4096 + (r & 15)) * 16 + (g & 1) * 4;
            const f32x4 cs = *(const f32x4*)rp, sn = *(const f32x4*)(rp + 8);
            f32x4 pr;
#pragma unroll
            for (int j = 0; j < 4; ++j) pr[j] = xchg32(v[j], g >= 2);
            v = g < 2 ? v * cs - pr * sn : v * cs + pr * sn;
        }
        u32x2 pk; pk[0] = pk2(v[0], v[1]); pk[1] = pk2(v[2], v[3]);
        if (which == 0) { *(u32x2*)((bf16_t*)(ws + WS_BIG) + (size_t)(NP + r) * 2048 + n0 + g * 4) = pk; return; }
        const int col = n0 - (which == 1 ? 2048 : 2560) + g * 4, b = r >> 4, t = r & 15;
        *(u32x2*)((bf16_t*)(ws + (which == 1 ? WS_KEB : WS_VEB)) + ((size_t)(b * 192 + 128 + t)) * 512 + col) = pk;
        *(f32x4*)(out + (which == 1 ? O_BKS : O_BVS) + (size_t)r * 512 + col) = v;
    }
};
struct SEpiUp {
    bf16_t* U;
    __device__ __forceinline__ void operator()(f32x4 v, int r, int n0, int g) const {
#pragma unroll
        for (int j = 0; j < 4; ++j) { const float a = fmaxf(v[j], 0.f); v[j] = a * a; }
        u32x2 pk; pk[0] = pk2(v[0], v[1]); pk[1] = pk2(v[2], v[3]);
        *(u32x2*)(U + (size_t)(NP + r) * 8192 + n0 + g * 4) = pk;
    }
};
struct SEpiRes {
    const float* xin; bf16_t* Z; const float* gate; const float* stats; const float* lng; const float* lnb;
    __device__ __forceinline__ void operator()(f32x4 v, int r, int n0, int g) const {
        const int col = n0 + g * 4;
        f32x4 xv; const f32x4 gv = *(const f32x4*)(gate + (size_t)(8 + (r >> 4)) * 6144 + col);
        if (xin) xv = *(const f32x4*)(xin + (size_t)r * 2048 + col);
        else { const u32x2 zz = *(const u32x2*)(Z + (size_t)r * 2048 + col); const f32x2 st = *(const f32x2*)(stats + (size_t)r * 2);
            xv[0] = bf_lo(zz[0]); xv[1] = bf_hi(zz[0]); xv[2] = bf_lo(zz[1]); xv[3] = bf_hi(zz[1]);
            xv = (xv - st[0]) * st[1] * *(const f32x4*)(lng + col) + *(const f32x4*)(lnb + col); }
        const f32x4 z = xv * ALPHA + gv * v;
        u32x2 pk; pk[0] = pk2(z[0], z[1]); pk[1] = pk2(z[2], z[3]);
        *(u32x2*)(Z + (size_t)r * 2048 + col) = pk;
    }
};

__device__ __forceinline__ void ada_item(const Params& p, int item, LAS float* lds, int wv) {
    const int tid = opaque_tid(wv), wid = tid >> 6, lane = tid & 63;
    const int combo = item / 24, cb = item % 24, col0 = cb * 256;
    const float* W = p.w_ada + (size_t)combo * 2048 * 6144;
    __syncthreads();
    for (int i0 = 0; i0 < 64; i0 += 16) {
        float c[16];
#pragma unroll
        for (int q = 0; q < 16; ++q) { const int idx = tid + 512 * (i0 + q), r = idx >> 11, k = idx & 2047;
            c[q] = r < 8 ? p.c_prompt[r * 2048 + k] : p.c_sample[(r - 8) * 2048 + k]; }
#pragma unroll
        for (int q = 0; q < 16; ++q) { const int idx = tid + 512 * (i0 + q), r = idx >> 11, k = idx & 2047;
            lds[k * 16 + r] = c[q] / (1.f + __expf(-c[q])); }
    }
    __syncthreads();
    f32x4 acc[16];
#pragma unroll
    for (int r = 0; r < 16; ++r) acc[r] = (f32x4){0.f, 0.f, 0.f, 0.f};
    const float* wp = W + (size_t)(wid * 256) * 6144 + col0 + lane * 4;
    for (int kk = 0; kk < 256; kk += 16) {
        f32x4 w[16];
#pragma unroll
        for (int q = 0; q < 16; ++q) w[q] = *(const f32x4*)(wp + (size_t)(kk + q) * 6144);
        __builtin_amdgcn_sched_barrier(0);
#pragma unroll
        for (int q = 0; q < 16; ++q) {
            const LAS f32x4* sp = (const LAS f32x4*)(lds + (wid * 256 + kk + q) * 16);
#pragma unroll
            for (int r4 = 0; r4 < 4; ++r4) { const f32x4 s = sp[r4];
#pragma unroll
                for (int j = 0; j < 4; ++j) acc[r4 * 4 + j] += w[q] * s[j]; }
        }
    }
    __syncthreads();
#pragma unroll
    for (int r = 0; r < 16; ++r) *(LAS f32x4*)(lds + (wid * 16 + r) * 256 + lane * 4) = acc[r];
    __syncthreads();
    float* mod = (float*)(p.ws + WS_MOD);
#pragma unroll
    for (int i = 0; i < 8; ++i) { const int idx = tid + 512 * i, r = idx >> 8, c = idx & 255; float s = 0.f;
#pragma unroll
        for (int w = 0; w < 8; ++w) s += lds[(w * 16 + r) * 256 + c];
        mod[((size_t)combo * 16 + r) * 6144 + col0 + c] = s + p.b_ada[combo * 6144 + col0 + c]; }
}

struct TTile { const float* src; bf16_t* dst; int K, N; };
__device__ __forceinline__ TTile ttile_of(const Params& p, int it) {
    constexpr int T0 = 768, T1 = T0 + 256, T2 = T1 + 384, T3 = T2 + 256, T4 = T3 + 2048;
    const float* src; bf16_t* dst; int K, N, tl;
    if (it < T0)      { src = p.w_qkv_a; dst = (bf16_t*)(p.ws + WS_WQKVA); K = 2048; N = 6144; tl = it; }
    else if (it < T1) { src = p.w_o_a;   dst = (bf16_t*)(p.ws + WS_WOA);   K = 2048; N = 2048; tl = it - T0; }
    else if (it < T2) { src = p.w_qkv_b; dst = (bf16_t*)(p.ws + WS_WQKVB); K = 2048; N = 3072; tl = it - T1; }
    else if (it < T3) { src = p.w_o_b;   dst = (bf16_t*)(p.ws + WS_WOB);   K = 2048; N = 2048; tl = it - T2; }
    else if (it < T4) { const int l = (it - T3) >> 10; src = p.w_up + (size_t)l * 2048 * 8192; dst = (bf16_t*)(p.ws + WS_WUP) + (size_t)l * 2048 * 8192; K = 2048; N = 8192; tl = (it - T3) & 1023; }
    else              { const int l = (it - T4) >> 10; src = p.w_down + (size_t)l * 2048 * 8192; dst = (bf16_t*)(p.ws + WS_WDN) + (size_t)l * 2048 * 8192; K = 8192; N = 2048; tl = (it - T4) & 1023; }
    const int ntn = N >> 7, tk = tl / ntn, tn = tl % ntn;
    TTile r; r.src = src + (size_t)tk * 128 * N + tn * 128; r.dst = dst + (size_t)tn * 128 * K + tk * 128; r.K = K; r.N = N; return r;
}
__device__ __forceinline__ int my_ttile(int j) {
    constexpr int NT = 5760;
    const int nb = gridDim.x, blk = blockIdx.x;
    int idx;
    if (nb == 256) { if (blk >= 96) idx = j < 12 ? j * 160 + (blk - 96) : 1920 + (j - 12) * 256 + blk; else idx = 1920 + j * 256 + blk; }
    else idx = j * nb + blk;
    return idx < NT ? idx : -1;
}
__device__ __forceinline__ void transpose_stream(const Params& p, LAS unsigned* lds, int wv) {
    const int t = opaque_tid(wv), c4 = t & 31, rp = t >> 5;
    f32x4 a[4], b[4];
    int j = 0, it = my_ttile(0), itl = it;
    if (it < 0) return;
    TTile cur = ttile_of(p, it), ld = cur;
#define T_LOAD() do { _Pragma("unroll") for (int ps = 0; ps < 4; ++ps) { const int r = 2 * (rp + 16 * ps); \
        a[ps] = *(const f32x4*)(ld.src + (size_t)r * ld.N + c4 * 4); b[ps] = *(const f32x4*)(ld.src + (size_t)(r + 1) * ld.N + c4 * 4); } } while (0)
#define T_WRITE(buf) do { _Pragma("unroll") for (int ps = 0; ps < 4; ++ps) { const int kp = rp + 16 * ps; \
        _Pragma("unroll") for (int jj = 0; jj < 4; ++jj) { const int n = c4 * 4 + jj; lds[(buf) * 8192 + n * 64 + (kp ^ (((n >> 2) & 7) << 2))] = pk2(a[ps][jj], b[ps][jj]); } } } while (0)
    __syncthreads();
    T_LOAD(); T_WRITE(0);
    int jl = 1; itl = my_ttile(1); if (itl >= 0) { ld = ttile_of(p, itl); T_LOAD(); }
    int bsel = 0;
    for (;;) {
        __syncthreads();
        TTile nxt = ld; const int itn = itl;
        if (itl >= 0) { T_WRITE(bsel ^ 1); ++jl; itl = my_ttile(jl); if (itl >= 0) { ld = ttile_of(p, itl); T_LOAD(); } }
#pragma unroll
        for (int i = 0; i < 4; ++i) { const int n = (t >> 4) + 32 * i, ch = t & 15;
            const u32x4 v = *(const LAS u32x4*)(lds + bsel * 8192 + n * 64 + ((4 * ch) ^ (((n >> 2) & 7) << 2)));
            *(u32x4*)(cur.dst + (size_t)n * cur.K + ch * 8) = v; }
        if (itn < 0) break;
        cur = nxt; bsel ^= 1; ++j;
    }
#undef T_LOAD
#undef T_WRITE
}

__device__ __forceinline__ void phase0(const Params& p, LAS unsigned char* lds, int wv) {
    const int tid = opaque_tid(wv);
    for (int it = blockIdx.x; it < 96; it += gridDim.x) ada_item(p, it, (LAS float*)lds, wv);
    transpose_stream(p, (LAS unsigned*)lds, wv);
    const size_t gtid = (size_t)blockIdx.x * 512 + tid, gstride = (size_t)gridDim.x * 512;
    {
        bf16_t* KE = (bf16_t*)(p.ws + WS_KEA); bf16_t* VE = (bf16_t*)(p.ws + WS_VEA);
        for (size_t i0 = gtid; i0 < (size_t)8 * 576 * 512; i0 += 2 * gstride) {
            f32x4 a[2], c[2]; bool ok[2], ld[2];
#pragma unroll
            for (int q = 0; q < 2; ++q) { const size_t i = i0 + q * gstride; ok[q] = i < (size_t)8 * 576 * 512; const int c4 = (int)(i & 511); const int r = (int)((i >> 9) % 576), b = (int)((i >> 9) / 576);
                ld[q] = ok[q] && r < 512; if (ld[q]) { const size_t sidx = ((size_t)(b * 512 + r)) * 2048 + c4 * 4; a[q] = *(const f32x4*)(p.cache_a_k + sidx); c[q] = *(const f32x4*)(p.cache_a_v + sidx); } }
#pragma unroll
            for (int q = 0; q < 2; ++q) { const size_t i = i0 + q * gstride; if (ok[q]) { u32x2 k = {0u, 0u}, v = {0u, 0u};
                if (ld[q]) { k[0] = pk2(a[q][0], a[q][1]); k[1] = pk2(a[q][2], a[q][3]); v[0] = pk2(c[q][0], c[q][1]); v[1] = pk2(c[q][2], c[q][3]); }
                *(u32x2*)(KE + i * 4) = k; *(u32x2*)(VE + i * 4) = v; } }
        }
    }
    {
        bf16_t* KE = (bf16_t*)(p.ws + WS_KEB); bf16_t* VE = (bf16_t*)(p.ws + WS_VEB);
        for (size_t i = gtid; i < (size_t)8 * 192 * 128; i += gstride) { const int c4 = (int)(i & 127); const int r = (int)((i >> 7) % 192), b = (int)((i >> 7) / 192);
            u32x2 k = {0u, 0u}, v = {0u, 0u};
            if (r < 128) { const size_t s = ((size_t)(b * 128 + r)) * 512 + c4 * 4; const f32x4 a = *(const f32x4*)(p.cache_b_k + s), c = *(const f32x4*)(p.cache_b_v + s);
                k[0] = pk2(a[0], a[1]); k[1] = pk2(a[2], a[3]); v[0] = pk2(c[0], c[1]); v[1] = pk2(c[2], c[3]); }
            *(u32x2*)(KE + i * 4) = k; *(u32x2*)(VE + i * 4) = v; }
    }
    {
        float* rope = (float*)(p.ws + WS_ROPE);
        for (size_t i = gtid; i < (size_t)4112 * 8; i += gstride) { const int f = (int)(i & 7), pi = (int)(i >> 3); const int pos = pi < 4096 ? pi : 1024 + (pi - 4096);
            const double fr = f == 0 ? 1.0 : f == 1 ? 0.19392274474868576 : f == 2 ? 0.03760603093086393 : f == 3 ? 0.007292664737217109 : f == 4 ? 0.001414213562373095 : f == 5 ? 0.0002742481756762073 : f == 6 ? 5.318295896944988e-05 : 1.031338537721246e-05;
            double rev = (double)pos * fr * 0.15915494309189535; rev -= __builtin_rint(rev);
            const float rf = (float)rev;
            rope[(size_t)pi * 16 + f] = __builtin_amdgcn_cosf(rf); rope[(size_t)pi * 16 + 8 + f] = __builtin_amdgcn_sinf(rf); }
    }
}

__device__ __forceinline__ void modulate0(const Params& p, int wv) {
    const float* mod = (const float*)(p.ws + WS_MOD); bf16_t* H = (bf16_t*)(p.ws + WS_H);
    const size_t gtid = (size_t)blockIdx.x * 512 + opaque_tid(wv), gstride = (size_t)gridDim.x * 512, n = (size_t)NREAL * 512;
    for (size_t i0 = gtid; i0 < n; i0 += 4 * gstride) {
        f32x4 x[4], sh[4], sc[4];
#pragma unroll
        for (int q = 0; q < 4; ++q) { const size_t i = i0 + q * gstride; if (i < n) { const int row = (int)(i >> 9), c = (int)(i & 511) * 4;
            const float* xr = row < NP ? p.x_prompt + (size_t)row * 2048 : p.x_sample + (size_t)(row - NP) * 2048;
            const int r16 = row < NP ? (row >> 12) : 8 + ((row - NP) >> 4);
            x[q] = *(const f32x4*)(xr + c); sh[q] = *(const f32x4*)(mod + (size_t)r16 * 6144 + c); sc[q] = *(const f32x4*)(mod + (size_t)r16 * 6144 + 2048 + c); } }
#pragma unroll
        for (int q = 0; q < 4; ++q) { const size_t i = i0 + q * gstride; if (i < n) { const int row = (int)(i >> 9), c = (int)(i & 511) * 4;
            const f32x4 h = x[q] * (sc[q] + 1.f) + sh[q];
            u32x2 o; o[0] = pk2(h[0], h[1]); o[1] = pk2(h[2], h[3]);
            *(u32x2*)(H + (size_t)row * 2048 + c) = o; } }
    }
}

#define LN_UNPACK(v, raw) do { _Pragma("unroll") for (int i = 0; i < 4; ++i) { v[2 * i][0] = bf_lo(raw[i][0]); v[2 * i][1] = bf_hi(raw[i][0]); v[2 * i][2] = bf_lo(raw[i][1]); v[2 * i][3] = bf_hi(raw[i][1]); \
        v[2 * i + 1][0] = bf_lo(raw[i][2]); v[2 * i + 1][1] = bf_hi(raw[i][2]); v[2 * i + 1][2] = bf_lo(raw[i][3]); v[2 * i + 1][3] = bf_hi(raw[i][3]); } } while (0)
#define LN_STATS(v, mu, rstd) float mu, rstd; do { float s_ = 0.f; \
        _Pragma("unroll") for (int i = 0; i < 8; ++i) s_ += (v[i][0] + v[i][1]) + (v[i][2] + v[i][3]); \
        s_ = wave_sum(s_); \
        mu = s_ * (1.f / 2048.f); float q_ = 0.f; \
        _Pragma("unroll") for (int i = 0; i < 8; ++i) { v[i] = v[i] - mu; q_ += (v[i][0] * v[i][0] + v[i][1] * v[i][1]) + (v[i][2] * v[i][2] + v[i][3] * v[i][3]); } \
        q_ = wave_sum(q_); \
        rstd = __builtin_amdgcn_rsqf(q_ * (1.f / 2048.f) + 1e-5f); } while (0)
__device__ __forceinline__ void ln_rows_generic(const Params& p, const float* g, const float* bta, const float* mod_next, int row_begin, int row_end, int wv) {
    float* Y = p.out; bf16_t* H = (bf16_t*)(p.ws + WS_H); const bf16_t* Z = (const bf16_t*)(p.ws + WS_Z); float* ST = (float*)(p.ws + WS_STATS);
    const int tid = opaque_tid(wv), wid = tid >> 6, lane = tid & 63;
    for (int row = row_begin + blockIdx.x * 8 + wid; row < row_end; row += gridDim.x * 8) {
        u32x4 raw[4];
#pragma unroll
        for (int i = 0; i < 4; ++i) raw[i] = *(const u32x4*)(Z + (size_t)row * 2048 + i * 512 + lane * 8);
        f32x4 v[8]; LN_UNPACK(v, raw);
        LN_STATS(v, mu, rstd);
        const int r16 = row < NP ? (row >> 12) : 8 + ((row - NP) >> 4);
        if (mod_next && lane == 0) { f32x2 st; st[0] = mu; st[1] = rstd; *(f32x2*)(ST + (size_t)row * 2) = st; }
        f32x4 pg[8], pb[8], psh[8], psc[8];
#pragma unroll
        for (int i = 0; i < 8; ++i) { const int c = (i >> 1) * 512 + lane * 8 + (i & 1) * 4; pg[i] = *(const f32x4*)(g + c); pb[i] = *(const f32x4*)(bta + c);
            if (mod_next) { const float* mp = mod_next + (size_t)r16 * 6144 + c; psh[i] = *(const f32x4*)mp; psc[i] = *(const f32x4*)(mp + 2048); } }
#pragma unroll
        for (int i = 0; i < 4; ++i) { const int c = i * 512 + lane * 8;
            f32x4 y0 = v[2 * i] * rstd * pg[2 * i] + pb[2 * i], y1 = v[2 * i + 1] * rstd * pg[2 * i + 1] + pb[2 * i + 1];
            if (!mod_next) { *(f32x4*)(Y + (size_t)row * 2048 + c) = y0; *(f32x4*)(Y + (size_t)row * 2048 + c + 4) = y1; }
            else { y0 = y0 * (psc[2 * i] + 1.f) + psh[2 * i]; y1 = y1 * (psc[2 * i + 1] + 1.f) + psh[2 * i + 1];
                u32x4 o; o[0] = pk2(y0[0], y0[1]); o[1] = pk2(y0[2], y0[3]); o[2] = pk2(y1[0], y1[1]); o[3] = pk2(y1[2], y1[3]);
                *(u32x4*)(H + (size_t)row * 2048 + c) = o; } }
    }
}
template <bool MOD>
__device__ __forceinline__ void ln_rows_prompt(const Params& p, const float* g, const float* bta, const float* mod_next, int wv) {
    float* Y = p.out; bf16_t* H = (bf16_t*)(p.ws + WS_H); const bf16_t* Z = (const bf16_t*)(p.ws + WS_Z); float* ST = (float*)(p.ws + WS_STATS);
    const int tid = opaque_tid(wv), wid = tid >> 6, lane = tid & 63;
    const int rpw = NP / (gridDim.x * 8);
    const int row0 = (blockIdx.x * 8 + wid) * rpw, r16 = row0 >> 12, rend = row0 + rpw;
    f32x4 G[8], B[8];
#pragma unroll
    for (int i = 0; i < 8; ++i) { const int c = (i >> 1) * 512 + lane * 8 + (i & 1) * 4; G[i] = *(const f32x4*)(g + c); B[i] = *(const f32x4*)(bta + c);
        if (MOD) { const f32x4 sh = *(const f32x4*)(mod_next + (size_t)r16 * 6144 + c), sc = *(const f32x4*)(mod_next + (size_t)r16 * 6144 + 2048 + c);
            G[i] = G[i] * (sc + 1.f); B[i] = B[i] * (sc + 1.f) + sh; } }
#pragma unroll
    for (int i = 0; i < 8; ++i) { asm volatile("" : "+v"(G[i])); asm volatile("" : "+v"(B[i])); }
    u32x4 ra[4], rb[4], rc[4];
#define LN_LOAD(raw, row) do { if ((row) < rend) { const bf16_t* _z = Z + (size_t)(row) * 2048 + lane * 8; _Pragma("unroll") for (int i = 0; i < 4; ++i) raw[i] = *(const u32x4*)(_z + i * 512); } } while (0)
#define LN_PROC(raw, row) do { if ((row) < rend) { f32x4 v[8]; LN_UNPACK(v, raw); LN_STATS(v, mu, rstd); \
        if (MOD && lane == 0) { f32x2 st; st[0] = mu; st[1] = rstd; *(f32x2*)(ST + (size_t)(row) * 2) = st; } \
        _Pragma("unroll") for (int i = 0; i < 4; ++i) { const f32x4 h0 = v[2 * i] * rstd * G[2 * i] + B[2 * i], h1 = v[2 * i + 1] * rstd * G[2 * i + 1] + B[2 * i + 1]; \
            if (!MOD) { float* _y = Y + (size_t)(row) * 2048 + i * 512 + lane * 8; *(f32x4*)_y = h0; *(f32x4*)(_y + 4) = h1; } \
            else { u32x4 o; o[0] = pk2(h0[0], h0[1]); o[1] = pk2(h0[2], h0[3]); o[2] = pk2(h1[0], h1[1]); o[3] = pk2(h1[2], h1[3]); *(u32x4*)(H + (size_t)(row) * 2048 + i * 512 + lane * 8) = o; } } } } while (0)
    LN_LOAD(ra, row0); LN_LOAD(rb, row0 + 1);
    for (int r = row0; r < rend; r += 3) {
        LN_LOAD(rc, r + 2);
        LN_PROC(ra, r);
        LN_LOAD(ra, r + 3);
        LN_PROC(rb, r + 1);
        LN_LOAD(rb, r + 4);
        LN_PROC(rc, r + 2);
    }
#undef LN_LOAD
#undef LN_PROC
}
__device__ __forceinline__ void ln_phase(const Params& p, const float* g, const float* bta, const float* mod_next, int wv) {
    const bool fast = (NP % (gridDim.x * 16) == 0) && (4096 % (NP / (gridDim.x * 8)) == 0);
    if (fast) { if (mod_next) ln_rows_prompt<true>(p, g, bta, mod_next, wv); else ln_rows_prompt<false>(p, g, bta, mod_next, wv); }
    ln_rows_generic(p, g, bta, mod_next, fast ? NP : 0, NREAL, wv);
}

template <int D, int KS, bool BIAS>
__device__ __forceinline__ void attn_qk(const LAS unsigned char* Kl, const bf16x8 (&qf)[2][D / 32], float (&m)[2], float (&l)[2], bf16x8 (&pf)[2][2], float (&alpha)[2],
                                        float sc2, int jbase, int jhi, int qi, const LAS float* btab, int lane) {
    const int g = lane >> 4, l15 = lane & 15;
    f32x4 s[2][4];
    const LAS unsigned char* kp = Kl + l15 * KS + g * 16;
    bf16x8 kf[2][D / 32];
#pragma unroll
    for (int ks = 0; ks < D / 32; ++ks) kf[0][ks] = *(const LAS bf16x8*)(kp + ks * 64);
#pragma unroll
    for (int sub = 0; sub < 4; ++sub) { s[0][sub] = (f32x4){0.f, 0.f, 0.f, 0.f}; s[1][sub] = s[0][sub];
        if (sub + 1 < 4) {
#pragma unroll
            for (int ks = 0; ks < D / 32; ++ks) kf[(sub + 1) & 1][ks] = *(const LAS bf16x8*)(kp + (sub + 1) * 16 * KS + ks * 64);
        }
#pragma unroll
        for (int ks = 0; ks < D / 32; ++ks) {
            s[0][sub] = __builtin_amdgcn_mfma_f32_16x16x32_bf16(kf[sub & 1][ks], qf[0][ks], s[0][sub], 0, 0, 0);
            s[1][sub] = __builtin_amdgcn_mfma_f32_16x16x32_bf16(kf[sub & 1][ks], qf[1][ks], s[1][sub], 0, 0, 0); }
        __builtin_amdgcn_sched_barrier(0); }
    const bool far = BIAS && (jbase + 63 + 128 <= 512);
    const bool part = jbase + 64 > jhi;
    const float bfar = BIAS ? btab[0] : 0.f;
    const LAS float* brow = BIAS ? btab + (64 + jbase - qi + 4 * g) : btab;
#pragma unroll
    for (int u = 0; u < 2; ++u) {
        float mn, ls = 0.f;
        if (!BIAS || far) {
            float mx = -3e38f;
#pragma unroll
            for (int sub = 0; sub < 4; ++sub)
#pragma unroll
                for (int j = 0; j < 4; ++j) { if (part && jbase + sub * 16 + g * 4 + j >= jhi) s[u][sub][j] = -3e38f; mx = fmaxf(mx, s[u][sub][j]); }
            mx = xmax32(xmax16(mx));
            mn = fmaxf(m[u], __builtin_fmaf(mx, sc2, bfar)); alpha[u] = __builtin_amdgcn_exp2f(m[u] - mn); m[u] = mn;
            const float c = bfar - mn;
#pragma unroll
            for (int sub = 0; sub < 4; ++sub)
#pragma unroll
                for (int j = 0; j < 4; ++j) { const float pv = __builtin_amdgcn_exp2f(__builtin_fmaf(s[u][sub][j], sc2, c)); s[u][sub][j] = pv; ls += pv; }
        } else {
            float mx = -1e30f;
#pragma unroll
            for (int sub = 0; sub < 4; ++sub)
#pragma unroll
                for (int j = 0; j < 4; ++j) { float v = __builtin_fmaf(s[u][sub][j], sc2, brow[sub * 16 + 16 - 16 * u + j]);
                    if (part && jbase + sub * 16 + g * 4 + j >= jhi) v = -1e30f;
                    s[u][sub][j] = v; mx = fmaxf(mx, v); }
            mx = xmax32(xmax16(mx));
            mn = fmaxf(m[u], mx); alpha[u] = __builtin_amdgcn_exp2f(m[u] - mn); m[u] = mn;
#pragma unroll
            for (int sub = 0; sub < 4; ++sub)
#pragma unroll
                for (int j = 0; j < 4; ++j) { const float pv = __builtin_amdgcn_exp2f(s[u][sub][j] - mn); s[u][sub][j] = pv; ls += pv; }
        }
        l[u] = l[u] * alpha[u] + ls;
#pragma unroll
        for (int t = 0; t < 2; ++t) { u32x4 w; w[0] = pk2(s[u][2 * t][0], s[u][2 * t][1]); w[1] = pk2(s[u][2 * t][2], s[u][2 * t][3]); w[2] = pk2(s[u][2 * t + 1][0], s[u][2 * t + 1][1]); w[3] = pk2(s[u][2 * t + 1][2], s[u][2 * t + 1][3]);
            pf[u][t] = __builtin_bit_cast(bf16x8, w); }
    }
}
template <int D, int VS>
__device__ __forceinline__ void attn_pv(const LAS unsigned char* Vl, f32x4 (&o)[2][D / 16], const bf16x8 (&pf)[2][2], const float (&alpha)[2], int lane) {
    const int g = lane >> 4, q4 = (lane >> 2) & 3, p4 = lane & 3;
    const LAS unsigned char* vb = Vl + (g * 4 + q4) * VS + p4 * 8;
    if (__builtin_amdgcn_ballot_w64(alpha[0] != 1.f || alpha[1] != 1.f) != 0ull) {
#pragma unroll
        for (int ds = 0; ds < D / 16; ++ds) { o[0][ds] = o[0][ds] * alpha[0]; o[1][ds] = o[1][ds] * alpha[1]; }
    }
    bf16x8 vf[2][2];
#define PV_READ(buf, ds_) do { _Pragma("unroll") for (int t = 0; t < 2; ++t) { \
        const bf16x4 a1 = __builtin_amdgcn_ds_read_tr16_b64_v4i16((LAS bf16x4*)(vb + (t * 32) * VS + (ds_) * 32)); \
        const bf16x4 a2 = __builtin_amdgcn_ds_read_tr16_b64_v4i16((LAS bf16x4*)(vb + (t * 32 + 16) * VS + (ds_) * 32)); \
        vf[buf][t] = __builtin_shufflevector(a1, a2, 0, 1, 2, 3, 4, 5, 6, 7); } } while (0)
    PV_READ(0, 0);
#pragma unroll
    for (int ds = 0; ds < D / 16; ++ds) {
        if (ds + 1 < D / 16) PV_READ((ds + 1) & 1, ds + 1);
#pragma unroll
        for (int t = 0; t < 2; ++t) {
            o[0][ds] = __builtin_amdgcn_mfma_f32_16x16x32_bf16(vf[ds & 1][t], pf[0][t], o[0][ds], 0, 0, 0);
            o[1][ds] = __builtin_amdgcn_mfma_f32_16x16x32_bf16(vf[ds & 1][t], pf[1][t], o[1][ds], 0, 0, 0); }
        __builtin_amdgcn_sched_barrier(0);
    }
#undef PV_READ
}

struct AUnit { const bf16_t* kb; const bf16_t* vb; long qrow0; int hq, jt0, jhi, qvalid; };
__device__ __forceinline__ AUnit attn_a_unit(const Params& p, int u) {
    AUnit r; const bf16_t* Q = (const bf16_t*)(p.ws + WS_BIG); const bf16_t* Kg = Q + (size_t)MP * 2048; const bf16_t* Vg = Kg + (size_t)MP * 2048;
    if (u >= 1792 && u < 1824) { const int su = u - 1792, b = su >> 2; r.hq = su & 3; r.qrow0 = NP + b * 16; r.kb = (const bf16_t*)(p.ws + WS_KEA) + (size_t)b * 576 * 2048; r.vb = (const bf16_t*)(p.ws + WS_VEA) + (size_t)b * 576 * 2048; r.jt0 = 0; r.jhi = 528; r.qvalid = 16; return r; }
    int c, v;
    if (u < 1792) { v = u; c = 8 + (u >> 5); } else { v = u - 1824; c = 7 - (v >> 5); }
    const int b = (v >> 2) & 7; r.hq = v & 3; r.qrow0 = (long)b * 4096 + c * 64; r.kb = Kg + (r.qrow0 - 512) * 2048; r.vb = Vg + (r.qrow0 - 512) * 2048; r.jt0 = c < 8 ? 8 - c : 0; r.jhi = 576; r.qvalid = 64;
    return r;
}
__device__ __forceinline__ void attn_a_phase(const Params& p, LAS unsigned char* lds, int wv) {
    constexpr int KS = 1056, VS = 1056, NU = 2080;
    const int tid = opaque_tid(wv), wid = tid >> 6, lane = tid & 63, g = lane >> 4, l15 = lane & 15, hh = wid >> 1, rg = wid & 1;
    LAS unsigned char* Kl = lds; LAS unsigned char* Vl = lds + 64 * KS; LAS float* btab = (LAS float*)(lds + 64 * KS + 64 * VS);
    const bf16_t* Q = (const bf16_t*)(p.ws + WS_BIG);
    bf16_t* O = (bf16_t*)(p.ws + WS_H);
    const float sc2 = 0.08838834764831845f * LOG2E;
    const int skey = tid >> 6, sch = tid & 63;
    u32x4 kr[8], vr[8];
    int unit = blockIdx.x;
    if (unit >= NU) return;
    AUnit cu = attn_a_unit(p, unit);
    const unsigned voff = (unsigned)(skey * 2048 + sch * 8) * 2u;
    { const size_t ub = ((size_t)cu.jt0 * 64 * 2048 + cu.hq * 512) * 2;
#pragma unroll
      for (int i = 0; i < 8; ++i) { kr[i] = *(const u32x4*)((const char*)cu.kb + ub + (size_t)i * 32768 + voff); vr[i] = *(const u32x4*)((const char*)cu.vb + ub + (size_t)i * 32768 + voff); } }
    for (;;) {
        const int nunit = unit + gridDim.x; const bool has_next = nunit < NU;
        AUnit nu = cu; if (has_next) nu = attn_a_unit(p, nunit);
        const int h = cu.hq * 4 + hh;
        __syncthreads();
        int tid2 = tid; asm volatile("" : "+v"(tid2));
        float tb[6];
#pragma unroll
        for (int k = 0; k < 6; ++k) { int i = tid2 + 512 * k; i = i < 4 * 656 ? i : 4 * 656 - 1; const int h2 = i / 656, x = i - h2 * 656, r = x - 80; const int ti = r <= 384 ? 256 : 640 - r;
            tb[k] = p.rel_bias_a[(cu.hq * 4 + h2) * 257 + ti]; }
#pragma unroll
        for (int k = 0; k < 6; ++k) { const int i = tid2 + 512 * k;
            if (i < 4 * 656) { const int h2 = i / 656, x = i - h2 * 656; btab[h2 * 672 + x] = tb[k] * LOG2E; } }
        bf16x8 qf[2][4];
        { const int l15b = tid2 & 15, gb = (tid2 >> 4) & 3;
          const bf16_t* qp = Q + (size_t)(cu.qrow0 + rg * 32 + l15b) * 2048 + h * 128 + gb * 8;
#pragma unroll
          for (int u = 0; u < 2; ++u)
#pragma unroll
            for (int ks = 0; ks < 4; ++ks) qf[u][ks] = *(const bf16x8*)(qp + (size_t)u * 16 * 2048 + ks * 32); }
#pragma unroll
        for (int u = 0; u < 2; ++u)
#pragma unroll
            for (int ks = 0; ks < 4; ++ks) asm volatile("" : "+v"(qf[u][ks]));
        f32x4 o[2][8];
#pragma unroll
        for (int u = 0; u < 2; ++u)
#pragma unroll
            for (int i = 0; i < 8; ++i) o[u][i] = (f32x4){0.f, 0.f, 0.f, 0.f};
        float m[2] = {-1e30f, -1e30f}, l[2] = {0.f, 0.f};
        for (int jt = cu.jt0; jt < 9; ++jt) {
            __syncthreads();
#pragma unroll
            for (int i = 0; i < 8; ++i) { *(LAS u32x4*)(Kl + (skey + 8 * i) * KS + sch * 16) = kr[i]; *(LAS u32x4*)(Vl + (skey + 8 * i) * VS + sch * 16) = vr[i]; }
            __syncthreads();
            const bool more = jt + 1 < 9;
            const size_t nub = ((size_t)(more ? jt + 1 : nu.jt0) * 64 * 2048 + (more ? cu.hq : nu.hq) * 512) * 2;
            const char* nkb = (const char*)(more ? cu.kb : nu.kb) + nub; const char* nvb = (const char*)(more ? cu.vb : nu.vb) + nub;
            if (more || has_next) {
#pragma unroll
                for (int i = 0; i < 8; ++i) kr[i] = *(const u32x4*)(nkb + (size_t)i * 32768 + voff);
            }
            bf16x8 pf[2][2]; float alpha[2];
            attn_qk<128, KS, true>(Kl + hh * 256, qf, m, l, pf, alpha, sc2, jt * 64, cu.jhi, rg * 32 + l15, btab + hh * 672, lane);
            __builtin_amdgcn_sched_barrier(0);
            if (more || has_next) {
#pragma unroll
                for (int i = 0; i < 8; ++i) vr[i] = *(const u32x4*)(nvb + (size_t)i * 32768 + voff);
            }
            __builtin_amdgcn_sched_barrier(0);
            attn_pv<128, VS>(Vl + hh * 256, o, pf, alpha, lane);
        }
#pragma unroll
        for (int u = 0; u < 2; ++u) {
            float lt = l[u]; lt = xsum32(xsum16(lt));
            const float inv = 1.f / lt;
            int tid3 = tid; asm volatile("" : "+v"(tid3)); const int l15c = tid3 & 15, gc = (tid3 >> 4) & 3;
            if (rg * 32 + u * 16 + l15c < cu.qvalid) { bf16_t* op = O + (size_t)(cu.qrow0 + rg * 32 + u * 16 + l15c) * 2048 + h * 128 + gc * 4;
#pragma unroll
                for (int ds = 0; ds < 8; ++ds) { u32x2 w; w[0] = pk2(o[u][ds][0] * inv, o[u][ds][1] * inv); w[1] = pk2(o[u][ds][2] * inv, o[u][ds][3] * inv); *(u32x2*)(op + ds * 16) = w; } }
        }
        if (!has_next) break;
        cu = nu; unit = nunit;
    }
}

struct BUnit { const bf16_t* kb; const bf16_t* vb; long qrow0; int kvh, jt0, jhi, qvalid; };
__device__ __forceinline__ BUnit attn_b_unit(const Params& p, int u) {
    BUnit r; const bf16_t* Q = (const bf16_t*)(p.ws + WS_BIG); const bf16_t* Kg = Q + (size_t)MP * 2048; const bf16_t* Vg = Kg + (size_t)MP * 512;
    if (u >= 3968 && u < 4032) { const int su = u - 3968, b = su >> 3; r.kvh = su & 7; r.qrow0 = NP + b * 16; r.kb = (const bf16_t*)(p.ws + WS_KEB) + (size_t)b * 192 * 512; r.vb = (const bf16_t*)(p.ws + WS_VEB) + (size_t)b * 192 * 512; r.jt0 = 0; r.jhi = 144; r.qvalid = 16; return r; }
    int c, v;
    if (u < 3968) { v = u; c = 2 + (u >> 6); } else { v = u - 4032; c = 1 - (v >> 6); }
    const int b = (v >> 3) & 7; r.kvh = v & 7; r.qrow0 = (long)b * 4096 + c * 64; r.kb = Kg + (r.qrow0 - 128) * 512; r.vb = Vg + (r.qrow0 - 128) * 512; r.jt0 = c < 2 ? 2 - c : 0; r.jhi = 192; r.qvalid = 64;
    return r;
}
__device__ __forceinline__ void attn_b_phase(const Params& p, LAS unsigned char* lds, unsigned long long& pb_acc, int wv) {
    unsigned long long pb_t0 = 0; (void)pb_t0;
    constexpr int KS = 160, VS = 160, NU = 4160;
    const int tid = opaque_tid(wv), wid = tid >> 6, lane = tid & 63, g = lane >> 4, l15 = lane & 15;
    LAS unsigned char* Kl = lds; LAS unsigned char* Vl = lds + 192 * KS;
    const bf16_t* Q = (const bf16_t*)(p.ws + WS_BIG);
    bf16_t* O = (bf16_t*)(p.ws + WS_H);
    const float sc2 = 0.125f * LOG2E;
    const int qloc = (wid & 1) * 32 + l15;
    u32x4 kr[3], vr[3];
    bf16x8 qf[2][2], qn[2][2]; float sink_c = 0.f, sink_n = 0.f;
    int unit = blockIdx.x;
    if (unit >= NU) return;
    BUnit cu = attn_b_unit(p, unit);
#define B_LOAD(u_, q_, sk_) do { _Pragma("unroll") for (int i = 0; i < 3; ++i) { const int ci = tid + 512 * i, key = ci >> 3, ch = ci & 7; \
            if (key >= (u_).jt0 * 64) { const size_t off = (size_t)key * 512 + (u_).kvh * 64 + ch * 8; kr[i] = *(const u32x4*)((u_).kb + off); vr[i] = *(const u32x4*)((u_).vb + off); } } \
        { const bf16_t* qp = Q + (size_t)((u_).qrow0 + qloc) * 2048 + ((u_).kvh * 4 + (wid >> 1)) * 64 + g * 8; \
          _Pragma("unroll") for (int u = 0; u < 2; ++u) { q_[u][0] = *(const bf16x8*)(qp + (size_t)u * 16 * 2048); q_[u][1] = *(const bf16x8*)(qp + (size_t)u * 16 * 2048 + 32); } } \
        sk_ = p.sink_b[(u_).kvh * 4 + (wid >> 1)]; } while (0)
    B_LOAD(cu, qf, sink_c);
    for (;;) {
        const int nunit = unit + gridDim.x; const bool has_next = nunit < NU;
        BUnit nu = cu; if (has_next) nu = attn_b_unit(p, nunit);
        PB_BEGIN(512);
        __syncthreads();
#pragma unroll
        for (int i = 0; i < 3; ++i) { const int ci = tid + 512 * i, key = ci >> 3, ch = ci & 7;
            if (key >= cu.jt0 * 64) { *(LAS u32x4*)(Kl + key * KS + ch * 16) = kr[i]; *(LAS u32x4*)(Vl + key * VS + ch * 16) = vr[i]; } }
        __syncthreads();
        PB_END(512);
        if (has_next) B_LOAD(nu, qn, sink_n);
        const int h = cu.kvh * 4 + (wid >> 1);
        const float sink2 = sink_c * LOG2E;
        f32x4 o[2][4];
#pragma unroll
        for (int u = 0; u < 2; ++u)
#pragma unroll
            for (int i = 0; i < 4; ++i) o[u][i] = (f32x4){0.f, 0.f, 0.f, 0.f};
        float m[2] = {sink2, sink2}, l[2]; l[0] = l[1] = (g == 0) ? 1.f : 0.f;
        PB_BEGIN(1024);
        for (int jt = cu.jt0; jt < 3; ++jt) { bf16x8 pf[2][2]; float alpha[2];
            attn_qk<64, KS, false>(Kl + jt * 64 * KS, qf, m, l, pf, alpha, sc2, jt * 64, cu.jhi, qloc, nullptr, lane);
            attn_pv<64, VS>(Vl + jt * 64 * VS, o, pf, alpha, lane); }
        PB_END(1024);
#pragma unroll
        for (int u = 0; u < 2; ++u) {
            float lt = l[u]; lt = xsum32(xsum16(lt));
            const float inv = 1.f / lt;
            if (qloc + 16 * u < cu.qvalid) { bf16_t* op = O + (size_t)(cu.qrow0 + qloc + 16 * u) * 2048 + h * 64 + g * 4;
#pragma unroll
                for (int ds = 0; ds < 4; ++ds) { u32x2 w; w[0] = pk2(o[u][ds][0] * inv, o[u][ds][1] * inv); w[1] = pk2(o[u][ds][2] * inv, o[u][ds][3] * inv); *(u32x2*)(op + ds * 16) = w; } }
        }
        if (!has_next) break;
#pragma unroll
        for (int u = 0; u < 2; ++u) { qf[u][0] = qn[u][0]; qf[u][1] = qn[u][1]; }
        sink_c = sink_n;
        cu = nu; unit = nunit;
    }
#undef B_LOAD
}

#define XB_TMO      128
#define XB_XCNT(j)  (256  + 64 * (j))
#define XB_XSUB(j)  (1280 + 64 * (j))
#define XB_XGEN(j)  (2304 + 64 * (j))
#define XB_TOP      3328
#define XB_TOPGEN   3392
#define XCD_BAR_WORDS 3456
#define XB_SPIN_CAP (1u << 18)
__device__ __forceinline__ unsigned xb_ld(unsigned* p)              { return __hip_atomic_load(p, __ATOMIC_RELAXED, __HIP_MEMORY_SCOPE_AGENT); }
__device__ __forceinline__ unsigned xb_add(unsigned* p, unsigned v) { return __hip_atomic_fetch_add(p, v, __ATOMIC_RELAXED, __HIP_MEMORY_SCOPE_AGENT); }
__device__ __forceinline__ unsigned xb_xcc_id() { return (unsigned)__builtin_amdgcn_s_getreg((3 << 11) | 20) & 0xFu; }
#define XB_SPIN(cond, bar) do { unsigned _sp = 0; while (cond) { __builtin_amdgcn_s_sleep(1); \
    if ((++_sp & 255u) == 0u) { if (xb_ld(&(bar)[XB_TMO])) break; if (_sp > XB_SPIN_CAP) { atomicAdd(&(bar)[XB_TMO], 1u); break; } } } } while (0)
struct XcdBarrier { unsigned* bar; unsigned x; volatile LAS unsigned* st; };
__device__ __forceinline__ XcdBarrier xcd_barrier_post(unsigned* bar, volatile LAS unsigned* st) {
    XcdBarrier b; b.bar = bar; b.x = xb_xcc_id(); b.st = st;
    if (threadIdx.x == 0) (void)xb_add(&bar[XB_XCNT(b.x)], 1u);
    return b;
}
__device__ __forceinline__ void xcd_barrier_complete(unsigned* bar, unsigned x, unsigned& nloc, unsigned& nx) {
    const unsigned G = gridDim.x * gridDim.y * gridDim.z;
    unsigned sum, cnt, mine, sp = 0u;
    for (;;) {
        sum = 0u; cnt = 0u; mine = 0u;
#pragma unroll
        for (unsigned j = 0; j < 16; ++j) { const unsigned c = xb_ld(&bar[XB_XCNT(j)]); sum += c; cnt += (c > 0u) ? 1u : 0u; mine = (j == x) ? c : mine; }
        if (sum == G) break;
        __builtin_amdgcn_s_sleep(1);
        if ((++sp & 255u) == 0u) { if (xb_ld(&bar[XB_TMO])) break; if (sp > XB_SPIN_CAP) { atomicAdd(&bar[XB_TMO], 1u); break; } }
    }
    nloc = mine > 0u ? mine : 1u; nx = cnt > 0u ? cnt : 1u;
}
__device__ __forceinline__ void xcd_barrier(const XcdBarrier& b, bool leader) {
    asm volatile("s_waitcnt vmcnt(0)" ::: "memory");
    __syncthreads();
    if (leader) {
        unsigned* bar = b.bar;
        __builtin_amdgcn_s_waitcnt(0);
        unsigned nloc = b.st[0], nx = b.st[1];
        if (nloc == 0u) { xcd_barrier_complete(bar, b.x, nloc, nx); b.st[0] = nloc; b.st[1] = nx; }
        const unsigned old = xb_add(&bar[XB_XSUB(b.x)], 1u);
        const unsigned gen = old / nloc;
        if (old + 1u == (gen + 1u) * nloc) {
            __builtin_amdgcn_fence(__ATOMIC_RELEASE, "agent");
            asm volatile("s_waitcnt vmcnt(0)" ::: "memory");
            const unsigned og = xb_add(&bar[XB_TOP], 1u);
            const unsigned tg = og / nx;
            if (og + 1u == (tg + 1u) * nx) xb_add(&bar[XB_TOPGEN], 1u);
            else XB_SPIN(xb_ld(&bar[XB_TOPGEN]) == tg, bar);
            __builtin_amdgcn_fence(__ATOMIC_ACQUIRE, "agent");
            xb_add(&bar[XB_XGEN(b.x)], 1u);
            asm volatile("s_waitcnt vmcnt(0)" ::: "memory");
        } else {
            XB_SPIN(xb_ld(&bar[XB_XGEN(b.x)]) == gen, bar);
            __builtin_amdgcn_fence(__ATOMIC_ACQUIRE, "agent");
            asm volatile("s_waitcnt vmcnt(0)" ::: "memory");
        }
    }
    __syncthreads();
}

constexpr int LDS_BYTES = 147456;

__global__ void __launch_bounds__(512, 2) mega_fwd(Params p_unused) {
    extern __shared__ __attribute__((aligned(16))) unsigned char shm[];
    LAS unsigned char* lds = (LAS unsigned char*)shm;
    cg::grid_group grid = cg::this_grid();
    const int wv = __builtin_amdgcn_readfirstlane((int)(threadIdx.x >> 6));
    unsigned long long pb_t0 = 0, pb_acc = 0; (void)pb_t0; (void)pb_acc;
    volatile LAS unsigned* xb_st = (volatile LAS unsigned*)(lds + LDS_BYTES - 16);
    if (threadIdx.x == 0) { xb_st[0] = 0u; xb_st[1] = 0u; }
    __syncthreads();
    { const Params p = load_params(); (void)xcd_barrier_post((unsigned*)(p.ws + WS_BAR), xb_st); }
#define GRID_BARRIER() do { const Params pq = load_params(); XcdBarrier xb; xb.bar = (unsigned*)(pq.ws + WS_BAR); xb.x = xb_xcc_id(); \
        xb.st = (volatile LAS unsigned*)(lds + LDS_BYTES - 16); xcd_barrier(xb, opaque_tid(wv) == 0); } while (0)

    PB_BEGIN(1);
    if (gridDim.y > 1) grid.sync();
    { const Params p = load_params(); phase0(p, lds, wv); }
    GRID_BARRIER();
    PB_END(1);
    PB_BEGIN(2);
    { const Params p = load_params(); modulate0(p, wv); }
    GRID_BARRIER();
    PB_END(2);
    for (int l = 0; l < 2; ++l) {
        if (l == 0) {
            PB_BEGIN(4);
            { const Params p = load_params(); pg8::StaticOrder S; S.init(NP, 6144, gridDim.x, blockIdx.x);
              EpiQkvA E{p.ws, p.out};
              pg8::gemm_phase(lds, pg8::Gemm{(const bf16_t*)(p.ws + WS_H), (const bf16_t*)(p.ws + WS_WQKVA), NP, 6144, 2048}, S, E, wv); }
            PB_END(4);
            PB_BEGIN(8);
            { const Params p = load_params(); SEpiQkvA E{p.ws, p.out};
              skinny_gemm(lds, (const bf16_t*)(p.ws + WS_H) + (size_t)NP * 2048, 2048, (const bf16_t*)(p.ws + WS_WQKVA), 6144, 2048, E, wv); }
            PB_END(8);
            PB_BEGIN(128); GRID_BARRIER(); PB_END(128);
            PB_BEGIN(32);
            { const Params p = load_params(); attn_a_phase(p, lds, wv); }
            GRID_BARRIER();
            PB_END(32);
        } else {
            PB_BEGIN(4);
            { const Params p = load_params(); pg8::StaticOrder S; S.init(NP, 3072, gridDim.x, blockIdx.x);
              EpiQkvB E{p.ws, p.out};
              pg8::gemm_phase(lds, pg8::Gemm{(const bf16_t*)(p.ws + WS_H), (const bf16_t*)(p.ws + WS_WQKVB), NP, 3072, 2048}, S, E, wv); }
            PB_END(4);
            PB_BEGIN(8);
            { const Params p = load_params(); SEpiQkvB E{p.ws, p.out};
              skinny_gemm(lds, (const bf16_t*)(p.ws + WS_H) + (size_t)NP * 2048, 2048, (const bf16_t*)(p.ws + WS_WQKVB), 3072, 2048, E, wv); }
            PB_END(8);
            PB_BEGIN(128); GRID_BARRIER(); PB_END(128);
            PB_BEGIN(64);
            { const Params p = load_params(); attn_b_phase(p, lds, pb_acc, wv); }
            GRID_BARRIER();
            PB_END(64);
        }
        PB_BEGIN(4);
        {
            const Params p = load_params(); pg8::StaticOrder S; S.init(NP, 2048, gridDim.x, blockIdx.x);
            const float* mod = (const float*)(p.ws + WS_MOD);
            if (l == 0) { EpiRes<true> E{p.x_prompt, (bf16_t*)(p.ws + WS_Z), mod + 4096, nullptr, nullptr, nullptr};
                pg8::gemm_phase(lds, pg8::Gemm{(const bf16_t*)(p.ws + WS_H), (const bf16_t*)(p.ws + WS_WOA), NP, 2048, 2048}, S, E, wv); }
            else { EpiRes<false> E{nullptr, (bf16_t*)(p.ws + WS_Z), mod + (size_t)2 * 16 * 6144 + 4096, (const float*)(p.ws + WS_STATS), p.ln_g + 2048, p.ln_b + 2048};
                pg8::gemm_phase(lds, pg8::Gemm{(const bf16_t*)(p.ws + WS_H), (const bf16_t*)(p.ws + WS_WOB), NP, 2048, 2048}, S, E, wv); }
        }
        PB_END(4);
        PB_BEGIN(8);
        {
            const Params p = load_params(); const float* mod = (const float*)(p.ws + WS_MOD);
            SEpiRes E{l == 0 ? p.x_sample : nullptr, (bf16_t*)(p.ws + WS_Z) + (size_t)NP * 2048, mod + (size_t)(2 * l) * 16 * 6144 + 4096, (const float*)(p.ws + WS_STATS) + (size_t)NP * 2, p.ln_g + 2048, p.ln_b + 2048};
            skinny_gemm(lds, (const bf16_t*)(p.ws + WS_H) + (size_t)NP * 2048, 2048, (const bf16_t*)(p.ws + (l == 0 ? WS_WOA : WS_WOB)), 2048, 2048, E, wv);
        }
        PB_END(8);
        PB_BEGIN(128); GRID_BARRIER(); PB_END(128);
        PB_BEGIN(16);
        { const Params p = load_params(); const float* mod = (const float*)(p.ws + WS_MOD);
          ln_phase(p, p.ln_g + (2 * l) * 2048, p.ln_b + (2 * l) * 2048, mod + (size_t)(2 * l + 1) * 16 * 6144, wv); }
        GRID_BARRIER();
        PB_END(16);
        PB_BEGIN(4);
        {
            const Params p = load_params(); pg8::StaticOrder S; S.init(NP, 8192, gridDim.x, blockIdx.x);
            EpiUp E{(bf16_t*)(p.ws + WS_BIG)};
            pg8::gemm_phase(lds, pg8::Gemm{(const bf16_t*)(p.ws + WS_H), (const bf16_t*)(p.ws + WS_WUP) + (size_t)l * 2048 * 8192, NP, 8192, 2048}, S, E, wv);
        }
        PB_END(4);
        PB_BEGIN(8);
        {
            const Params p = load_params(); SEpiUp E{(bf16_t*)(p.ws + WS_BIG)};
            skinny_gemm(lds, (const bf16_t*)(p.ws + WS_H) + (size_t)NP * 2048, 2048, (const bf16_t*)(p.ws + WS_WUP) + (size_t)l * 2048 * 8192, 8192, 2048, E, wv);
        }
        PB_END(8);
        PB_BEGIN(128); GRID_BARRIER(); PB_END(128);
        PB_BEGIN(4);
        {
            const Params p = load_params(); pg8::StaticOrder S; S.init(NP, 2048, gridDim.x, blockIdx.x);
            const float* mod = (const float*)(p.ws + WS_MOD);
            EpiRes<false> E{nullptr, (bf16_t*)(p.ws + WS_Z), mod + (size_t)(2 * l + 1) * 16 * 6144 + 4096, (const float*)(p.ws + WS_STATS), p.ln_g + (2 * l) * 2048, p.ln_b + (2 * l) * 2048};
            pg8::gemm_phase(lds, pg8::Gemm{(const bf16_t*)(p.ws + WS_BIG), (const bf16_t*)(p.ws + WS_WDN) + (size_t)l * 2048 * 8192, NP, 2048, 8192}, S, E, wv);
        }
        PB_END(4);
        PB_BEGIN(8);
        {
            const Params p = load_params(); const float* mod = (const float*)(p.ws + WS_MOD);
            SEpiRes E{nullptr, (bf16_t*)(p.ws + WS_Z) + (size_t)NP * 2048, mod + (size_t)(2 * l + 1) * 16 * 6144 + 4096, (const float*)(p.ws + WS_STATS) + (size_t)NP * 2, p.ln_g + (2 * l) * 2048, p.ln_b + (2 * l) * 2048};
            skinny_gemm(lds, (const bf16_t*)(p.ws + WS_BIG) + (size_t)NP * 8192, 8192, (const bf16_t*)(p.ws + WS_WDN) + (size_t)l * 2048 * 8192, 2048, 8192, E, wv);
        }
        PB_END(8);
        PB_BEGIN(128); GRID_BARRIER(); PB_END(128);
        PB_BEGIN(16);
        { const Params p = load_params(); const float* mod = (const float*)(p.ws + WS_MOD);
          ln_phase(p, p.ln_g + (2 * l + 1) * 2048, p.ln_b + (2 * l + 1) * 2048, l == 0 ? mod + (size_t)2 * 16 * 6144 : nullptr, wv); }
        if (l == 0) GRID_BARRIER();
        PB_END(16);
    }
    if (PROBE_MASK & 256) { for (int i = 0; i < 16; ++i) GRID_BARRIER(); }
    if (PROBE_MASK) { const unsigned long long t1 = __builtin_amdgcn_s_memrealtime(); while (__builtin_amdgcn_s_memrealtime() - t1 < pb_acc) __builtin_amdgcn_s_sleep(8); }
}

extern "C" void kernel_launch(void* const* d_in, const int* in_sizes, int n_in, void* d_out, int out_size, void* d_ws, size_t ws_size, hipStream_t stream) {
    static int grid_blocks = 0;
    if (grid_blocks == 0) {
        if (ws_size < WS_END) { fprintf(stderr, "kernel_launch: workspace too small (%zu < %zu)\n", ws_size, (size_t)WS_END); grid_blocks = -1; return; }
        int dev = 0, cus = 0, per_cu = 0;
        (void)hipGetDevice(&dev);
        (void)hipDeviceGetAttribute(&cus, hipDeviceAttributeMultiprocessorCount, dev);
        if (hipFuncSetAttribute((const void*)mega_fwd, hipFuncAttributeMaxDynamicSharedMemorySize, LDS_BYTES) != hipSuccess) { fprintf(stderr, "kernel_launch: hipFuncSetAttribute failed\n"); grid_blocks = -1; return; }
        if (hipOccupancyMaxActiveBlocksPerMultiprocessor(&per_cu, (const void*)mega_fwd, 512, LDS_BYTES) != hipSuccess || per_cu < 1) { fprintf(stderr, "kernel_launch: occupancy query says %d blocks/CU\n", per_cu); per_cu = 1; }
        (void)hipGetLastError();
        grid_blocks = cus;
    }
    if (grid_blocks < 0) return;
    Params p{};
    p.x_prompt = (const float*)d_in[0]; p.x_sample = (const float*)d_in[1];
    p.cache_a_k = (const float*)d_in[2]; p.cache_a_v = (const float*)d_in[3]; p.cache_b_k = (const float*)d_in[4]; p.cache_b_v = (const float*)d_in[5];
    p.c_prompt = (const float*)d_in[6]; p.c_sample = (const float*)d_in[7];
    p.w_ada = (const float*)d_in[8]; p.b_ada = (const float*)d_in[9]; p.ln_g = (const float*)d_in[10]; p.ln_b = (const float*)d_in[11];
    p.w_qkv_a = (const float*)d_in[12]; p.w_o_a = (const float*)d_in[13]; p.rel_bias_a = (const float*)d_in[14];
    p.w_qkv_b = (const float*)d_in[15]; p.w_o_b = (const float*)d_in[16]; p.sink_b = (const float*)d_in[17];
    p.w_up = (const float*)d_in[18]; p.w_down = (const float*)d_in[19];
    p.out = (float*)d_out; p.ws = (unsigned char*)d_ws;
    if (hipMemsetAsync((char*)d_ws + WS_BAR, 0, 16384, stream) != hipSuccess) { fprintf(stderr, "kernel_launch: hipMemsetAsync of the barrier words failed\n"); return; }
    void* args[] = {&p};
    hipError_t e = hipLaunchCooperativeKernel((const void*)mega_fwd, dim3(grid_blocks), dim3(512), args, LDS_BYTES, stream);
    if (e != hipSuccess) fprintf(stderr, "cooperative launch failed: %s (grid %d)\n", hipGetErrorString(e), grid_blocks);
}
```

```cpp
#include <hip/hip_runtime.h>
#include <hip/hip_cooperative_groups.h>
#include <cstdio>
namespace cg = cooperative_groups;

#define LAS __attribute__((address_space(3)))
#ifndef PROBE_MASK
#define PROBE_MASK 0
#endif
#define PB_BEGIN(bit) do { if (PROBE_MASK & (bit)) pb_t0 = __builtin_amdgcn_s_memrealtime(); } while (0)
#define PB_END(bit)   do { if (PROBE_MASK & (bit)) pb_acc += __builtin_amdgcn_s_memrealtime() - pb_t0; } while (0)
typedef unsigned short bf16_t;
typedef short bf16x8 __attribute__((ext_vector_type(8)));
typedef short bf16x4 __attribute__((ext_vector_type(4)));
typedef float f32x4 __attribute__((ext_vector_type(4)));
typedef unsigned u32x4 __attribute__((ext_vector_type(4)));
typedef unsigned u32x2 __attribute__((ext_vector_type(2)));
typedef float f32x2 __attribute__((ext_vector_type(2)));

constexpr int DM = 2048;
constexpr int NP = 32768;
constexpr int NREAL = 32896;
constexpr int MP = 33024;
constexpr float ALPHA = 1.41421356237309515f;
constexpr float LOG2E = 1.44269504088896341f;

constexpr size_t WS_WQKVA = 0;
constexpr size_t WS_WOA   = WS_WQKVA + (size_t)6144 * 2048 * 2;
constexpr size_t WS_WQKVB = WS_WOA + (size_t)2048 * 2048 * 2;
constexpr size_t WS_WOB   = WS_WQKVB + (size_t)3072 * 2048 * 2;
constexpr size_t WS_WUP   = WS_WOB + (size_t)2048 * 2048 * 2;
constexpr size_t WS_WDN   = WS_WUP + (size_t)2 * 8192 * 2048 * 2;
constexpr size_t WS_BIG   = WS_WDN + (size_t)2 * 8192 * 2048 * 2;
constexpr size_t WS_H     = WS_BIG + (size_t)MP * 8192 * 2;
constexpr size_t WS_KEA   = WS_H + (size_t)MP * 2048 * 2;
constexpr size_t WS_VEA   = WS_KEA + (size_t)8 * 576 * 2048 * 2;
constexpr size_t WS_KEB   = WS_VEA + (size_t)8 * 576 * 2048 * 2;
constexpr size_t WS_VEB   = WS_KEB + (size_t)8 * 192 * 512 * 2;
constexpr size_t WS_MOD   = WS_VEB + (size_t)8 * 192 * 512 * 2;
constexpr size_t WS_ROPE  = WS_MOD + (size_t)4 * 16 * 6144 * 4;
constexpr size_t WS_STATS = WS_ROPE + (size_t)4112 * 16 * 4;
constexpr size_t WS_Z     = WS_STATS + (size_t)NREAL * 2 * 4;
constexpr size_t WS_BAR   = WS_Z + (size_t)NREAL * 2048 * 2;
constexpr size_t WS_END   = WS_BAR + 16384;

constexpr size_t O_Y    = 0;
constexpr size_t O_AKP  = (size_t)NREAL * 2048;
constexpr size_t O_AVP  = O_AKP + (size_t)8 * 512 * 2048;
constexpr size_t O_BKP  = O_AVP + (size_t)8 * 512 * 2048;
constexpr size_t O_BVP  = O_BKP + (size_t)8 * 128 * 512;
constexpr size_t O_AKS  = O_BVP + (size_t)8 * 128 * 512;
constexpr size_t O_AVS  = O_AKS + (size_t)128 * 2048;
constexpr size_t O_BKS  = O_AVS + (size_t)128 * 2048;
constexpr size_t O_BVS  = O_BKS + (size_t)128 * 512;

struct Params {
    const float* x_prompt; const float* x_sample;
    const float* cache_a_k; const float* cache_a_v; const float* cache_b_k; const float* cache_b_v;
    const float* c_prompt; const float* c_sample;
    const float* w_ada; const float* b_ada; const float* ln_g; const float* ln_b;
    const float* w_qkv_a; const float* w_o_a; const float* rel_bias_a;
    const float* w_qkv_b; const float* w_o_b; const float* sink_b;
    const float* w_up; const float* w_down;
    float* out; unsigned char* ws;
};

typedef const __attribute__((address_space(4))) struct Params* KParamPtr;
__device__ __forceinline__ Params load_params() {
#if defined(__HIP_DEVICE_COMPILE__)
    auto k = __builtin_amdgcn_kernarg_segment_ptr();
    asm volatile("" : "+s"(k));
    return *(KParamPtr)k;
#else
    return Params{};
#endif
}
__device__ __forceinline__ int opaque_tid(int wv) { unsigned z = 0u; asm volatile("" : "+v"(z));
    return (wv << 6) | (int)__builtin_amdgcn_mbcnt_hi(~0u, __builtin_amdgcn_mbcnt_lo(~0u, z)); }
__device__ __forceinline__ float shx(float v, int mask, int lane) { return __int_as_float(__builtin_amdgcn_ds_bpermute((lane ^ mask) << 2, __float_as_int(v))); }
template <int CTRL> __device__ __forceinline__ float dppf(float v) { return __int_as_float(__builtin_amdgcn_update_dpp(0, __float_as_int(v), CTRL, 0xf, 0xf, true)); }
__device__ __forceinline__ float xmax16(float v) { const auto r = __builtin_amdgcn_permlane16_swap(__float_as_uint(v), __float_as_uint(v), false, false); return fmaxf(__uint_as_float(r[0]), __uint_as_float(r[1])); }
__device__ __forceinline__ float xmax32(float v) { const auto r = __builtin_amdgcn_permlane32_swap(__float_as_uint(v), __float_as_uint(v), false, false); return fmaxf(__uint_as_float(r[0]), __uint_as_float(r[1])); }
__device__ __forceinline__ float xsum16(float v) { const auto r = __builtin_amdgcn_permlane16_swap(__float_as_uint(v), __float_as_uint(v), false, false); return __uint_as_float(r[0]) + __uint_as_float(r[1]); }
__device__ __forceinline__ float xsum32(float v) { const auto r = __builtin_amdgcn_permlane32_swap(__float_as_uint(v), __float_as_uint(v), false, false); return __uint_as_float(r[0]) + __uint_as_float(r[1]); }
__device__ __forceinline__ float xchg16(float v, bool odd_row) { const auto r = __builtin_amdgcn_permlane16_swap(__float_as_uint(v), __float_as_uint(v), false, false); return __uint_as_float(odd_row ? r[0] : r[1]); }
__device__ __forceinline__ float xchg32(float v, bool upper) { const auto r = __builtin_amdgcn_permlane32_swap(__float_as_uint(v), __float_as_uint(v), false, false); return __uint_as_float(upper ? r[0] : r[1]); }
__device__ __forceinline__ float wave_sum(float v) {
    v += dppf<0xB1>(v); v += dppf<0x4E>(v); v += dppf<0x141>(v); v += dppf<0x140>(v); v = xsum16(v); return xsum32(v); }
__device__ __forceinline__ float a_fma(float a, float b, float c) { float d; asm("v_fma_f32 %0, %1, %2, %3" : "=v"(d) : "v"(a), "s"(b), "v"(c)); return d; }
__device__ __forceinline__ float a_exp2(float a) { float d; asm("v_exp_f32 %0, %1" : "=v"(d) : "v"(a)); return d; }
__device__ __forceinline__ float a_add(float a, float b) { float d; asm("v_add_f32 %0, %1, %2" : "=v"(d) : "v"(a), "v"(b)); return d; }
__device__ __forceinline__ float a_sub(float a, float b) { float d; asm("v_sub_f32 %0, %1, %2" : "=v"(d) : "v"(a), "v"(b)); return d; }
__device__ __forceinline__ float bf_lo(unsigned w) { return __uint_as_float(w << 16); }
__device__ __forceinline__ float bf_hi(unsigned w) { return __uint_as_float(w & 0xffff0000u); }
__device__ __forceinline__ unsigned pk2(float lo, float hi) { unsigned r; asm("v_cvt_pk_bf16_f32 %0, %1, %2" : "=v"(r) : "v"(lo), "v"(hi)); return r; }

namespace pg8 {
constexpr int BM = 256, BK = 64, HALF = 128, HTB = HALF * BK * 2, STAGE_BYTES = 8 * HTB, NXCD = 8, WGM = 4;
__device__ __forceinline__ int lds_byte(int r, int c) { const int st = (r >> 4) * 2 + (c >> 5), rr = r & 15, cc = c & 31, ob = rr * 64 + cc * 2; return st * 1024 + (ob ^ (((ob >> 9) & 1) << 5)); }
__device__ __forceinline__ void stage_rc(int b, int& R, int& C) { const int st = b / 1024, sb = b % 1024, swz = sb ^ (((sb >> 9) & 1) << 5); R = (st >> 1) * 16 + swz / 64; C = (st & 1) * 32 + (swz % 64) / 2; }
__device__ __forceinline__ int perm32(int rho) { const int n = rho >> 4, i = rho & 15; return 8 * (i >> 2) + 4 * n + (i & 3); }
struct Unit { int pm, pn; };
struct Gemm { const bf16_t* A; const bf16_t* Bt; int M, N, K; };
struct StaticOrder {
    int nM, nN, nwg, G, c;
    __device__ void init(int M, int N, int G_, int c_) { nM = M / BM; nN = N / BM; nwg = nM * nN; G = G_; c = c_; }
    __device__ bool next(int i, Unit& u) const {
        const long L = (long)i * G + c; if (L >= nwg) return false;
        int wgid = (int)L; { const int q = nwg / NXCD, r = nwg % NXCD, xcd = wgid % NXCD, off = wgid / NXCD; wgid = (xcd < r ? xcd * (q + 1) : r * (q + 1) + (xcd - r) * q) + off; }
        const int nig = WGM * nN, gid = wgid / nig, fm = gid * WGM, gsz = (nM - fm) < WGM ? (nM - fm) : WGM;
        u.pm = fm + ((wgid % nig) % gsz); u.pn = (wgid % nig) / gsz; return true;
    }
};

template <class Epi>
__device__ __forceinline__ void gemm_phase(LAS unsigned char* lds, const Gemm g, const StaticOrder& S, const Epi& E, int wv) {
    const int tid = opaque_tid(wv), wid = __builtin_amdgcn_readfirstlane(tid >> 6), lane = tid & 63, wr = wid >> 2, wc = wid & 3, fr = lane & 15, fq = lane >> 4;
    const int K = g.K, nt = K / BK;
    unsigned voffA[2], voffB[2];
#pragma unroll
    for (int i = 0; i < 2; ++i) { int R, C; stage_rc(tid * 16 + i * 8192, R, C); const int Rb = Epi::PERM ? ((R & ~31) + perm32(R & 31)) : R;
        voffA[i] = (unsigned)(R * K + C) * 2u; voffB[i] = (unsigned)(Rb * K + C) * 2u; }
    const size_t kstep = (size_t)(BK * 2);
    const size_t hstep = (size_t)HALF * K * 2;
    const size_t tstep = 2 * hstep;
    const unsigned ldsw = (unsigned)wid * 1024u;
    const int aoff = lds_byte(wr * 64 + fr, fq * 8), boff = lds_byte(wc * 32 + fr, fq * 8);
#define PG8_SA(b, h) (((b) * 2 + (h)) * HTB)
#define PG8_SB(b, h) ((4 + (b) * 2 + (h)) * HTB)
#define PG8_STAGE(bufoff, gbase, voff) do { _Pragma("unroll") for (int _i = 0; _i < 2; ++_i) \
        __builtin_amdgcn_global_load_lds((const unsigned*)((const char*)(gbase) + (voff)[_i]), (LAS unsigned*)(lds + (bufoff) + ldsw + _i * 8192), 16, 0, 0); } while (0)
#define PG8_LDA(dst, b, h) do { _Pragma("unroll") for (int m = 0; m < 4; ++m) _Pragma("unroll") for (int k = 0; k < 2; ++k) dst[m][k] = *(const LAS bf16x8*)(lds + PG8_SA(b, h) + aoff + m * 2048 + k * 1024); } while (0)
#define PG8_LDB(dst, b, h) do { _Pragma("unroll") for (int n = 0; n < 2; ++n) _Pragma("unroll") for (int k = 0; k < 2; ++k) dst[n][k] = *(const LAS bf16x8*)(lds + PG8_SB(b, h) + boff + n * 2048 + k * 1024); } while (0)
#define PG8_MMA(ai, bj, At, Bt) do { __builtin_amdgcn_s_setprio(1); _Pragma("unroll") for (int m = 0; m < 4; ++m) _Pragma("unroll") for (int n = 0; n < 2; ++n) _Pragma("unroll") for (int k = 0; k < 2; ++k) \
        acc[ai][bj][m][n] = __builtin_amdgcn_mfma_f32_16x16x32_bf16(Bt[n][k], At[m][k], acc[ai][bj][m][n], 0, 0, 0); __builtin_amdgcn_s_setprio(0); } while (0)
#define PG8_WAIT_V(n) asm volatile("s_waitcnt vmcnt(" #n ")" ::: "memory")
#define PG8_WAIT_L(n) asm volatile("s_waitcnt lgkmcnt(" #n ")" ::: "memory")
#define PG8_BAR __builtin_amdgcn_s_barrier()
#define PG8_SCHED __builtin_amdgcn_sched_barrier(0)
    Unit cur, nxt; int ui = 0;
    if (!S.next(0, cur)) return;
    f32x4 acc[2][2][4][2];
#pragma unroll
    for (int a = 0; a < 2; ++a)
#pragma unroll
        for (int b = 0; b < 2; ++b)
#pragma unroll
            for (int m = 0; m < 4; ++m)
#pragma unroll
                for (int n = 0; n < 2; ++n) acc[a][b][m][n] = (f32x4){0.f, 0.f, 0.f, 0.f};
    bf16x8 At[4][2], B0[2][2], B1[2][2];
    const char* cA = (const char*)g.A + (size_t)cur.pm * tstep; const char* cB = (const char*)g.Bt + (size_t)cur.pn * tstep;
    PG8_STAGE(PG8_SB(0, 0), cB, voffB); PG8_STAGE(PG8_SA(0, 0), cA, voffA); PG8_STAGE(PG8_SB(0, 1), cB + hstep, voffB); PG8_STAGE(PG8_SA(0, 1), cA + hstep, voffA);
    if (wr == 1) PG8_BAR;
    PG8_WAIT_V(4); PG8_BAR;
    PG8_STAGE(PG8_SB(1, 0), cB + kstep, voffB); PG8_STAGE(PG8_SA(1, 0), cA + kstep, voffA); PG8_STAGE(PG8_SB(1, 1), cB + hstep + kstep, voffB);
    PG8_WAIT_V(6); PG8_BAR;
    for (;;) {
        const bool has_next = S.next(ui + 1, nxt);
        const char* nA = has_next ? (const char*)g.A + (size_t)nxt.pm * tstep : cA; const char* nB = has_next ? (const char*)g.Bt + (size_t)nxt.pn * tstep : cB;
        for (int t = 0; t < nt; t += 2) {
            const bool last = (t == nt - 2);
            const char* a1 = cA + (size_t)(t + 1) * kstep;
            const char* a2 = last ? nA : cA + (size_t)(t + 2) * kstep; const char* b2 = last ? nB : cB + (size_t)(t + 2) * kstep;
            const char* a3 = a2 + kstep; const char* b3 = b2 + kstep;
            PG8_LDB(B0, 0, 0); PG8_SCHED; PG8_LDA(At, 0, 0); PG8_STAGE(PG8_SA(1, 1), a1 + hstep, voffA);
            PG8_WAIT_L(8); PG8_BAR; PG8_WAIT_L(0); PG8_MMA(0, 0, At, B0); PG8_BAR; PG8_SCHED;
            PG8_LDB(B1, 0, 1); PG8_STAGE(PG8_SB(0, 0), b2, voffB);
            PG8_BAR; PG8_WAIT_L(0); PG8_MMA(0, 1, At, B1); PG8_BAR;
            PG8_LDA(At, 0, 1); PG8_STAGE(PG8_SA(0, 0), a2, voffA);
            PG8_BAR; PG8_WAIT_L(0); PG8_MMA(1, 0, At, B0); PG8_BAR; PG8_SCHED;
            PG8_STAGE(PG8_SB(0, 1), b2 + hstep, voffB);
            PG8_WAIT_V(6); PG8_BAR; PG8_MMA(1, 1, At, B1); PG8_BAR;
            PG8_LDB(B0, 1, 0); PG8_SCHED; PG8_LDA(At, 1, 0); PG8_STAGE(PG8_SA(0, 1), a2 + hstep, voffA);
            PG8_WAIT_L(8); PG8_BAR; PG8_WAIT_L(0); PG8_MMA(0, 0, At, B0); PG8_BAR; PG8_SCHED;
            PG8_LDB(B1, 1, 1); PG8_STAGE(PG8_SB(1, 0), b3, voffB);
            PG8_BAR; PG8_WAIT_L(0); PG8_MMA(0, 1, At, B1); PG8_BAR;
            PG8_LDA(At, 1, 1); PG8_STAGE(PG8_SA(1, 0), a3, voffA);
            PG8_BAR; PG8_WAIT_L(0); PG8_MMA(1, 0, At, B0); PG8_BAR; PG8_SCHED;
            PG8_STAGE(PG8_SB(1, 1), b3 + hstep, voffB);
            PG8_WAIT_V(6); PG8_BAR; PG8_MMA(1, 1, At, B1); PG8_BAR;
        }
        E(acc, cur, wr, wc, fr, fq);
        if (!has_next) break;
#pragma unroll
        for (int a = 0; a < 2; ++a)
#pragma unroll
            for (int b = 0; b < 2; ++b)
#pragma unroll
                for (int m = 0; m < 4; ++m)
#pragma unroll
                    for (int n = 0; n < 2; ++n) acc[a][b][m][n] = (f32x4){0.f, 0.f, 0.f, 0.f};
        cur = nxt; cA = nA; cB = nB; ++ui;
    }
    PG8_WAIT_V(0);
    if (wr == 0) PG8_BAR;
    PG8_BAR;
#undef PG8_SA
#undef PG8_SB
#undef PG8_STAGE
#undef PG8_LDA
#undef PG8_LDB
#undef PG8_MMA
#undef PG8_WAIT_V
#undef PG8_WAIT_L
#undef PG8_BAR
#undef PG8_SCHED
}
}
using pg8::Unit;

struct EpiQkvA {
    static constexpr bool PERM = true;
    unsigned char* ws; float* out;
    __device__ __forceinline__ void operator()(const f32x4 (&acc)[2][2][4][2], const Unit& u, int wr, int wc, int fr, int fq) const {
        const int which = u.pn >> 3, colt = (u.pn & 7) * 256;
        const int row0 = u.pm * 256 + wr * 64 + fr, col0 = colt + wc * 32 + 8 * fq;
        bf16_t* base = (bf16_t*)(ws + WS_BIG) + (size_t)which * MP * 2048;
        bf16_t* ext = (bf16_t*)(ws + (which == 1 ? WS_KEA : WS_VEA));
        float* oP = out + (which == 1 ? O_AKP : O_AVP);
        float* oS = out + (which == 1 ? O_AKS : O_AVS);
        constexpr bool prompt = true; const bool cache_tile = ((u.pm & 15) >= 14) && which > 0;
#pragma unroll
        for (int ai = 0; ai < 2; ++ai)
#pragma unroll
            for (int m = 0; m < 4; ++m) {
                const int row = row0 + ai * 128 + m * 16;
#pragma unroll
                for (int bj = 0; bj < 2; ++bj) {
                    const f32x4 v0 = acc[ai][bj][m][0], v1 = acc[ai][bj][m][1];
                    const int col = col0 + bj * 128;
                    u32x4 pk; pk[0] = pk2(v0[0], v0[1]); pk[1] = pk2(v0[2], v0[3]); pk[2] = pk2(v1[0], v1[1]); pk[3] = pk2(v1[2], v1[3]);
                    if (prompt || which == 0) *(u32x4*)(base + (size_t)row * 2048 + col) = pk;
                    if (cache_tile) { const int b = row >> 12, t = (row & 4095) - 3584; float* o = oP + ((size_t)(b * 512 + t)) * 2048 + col; *(f32x4*)o = v0; *(f32x4*)(o + 4) = v1; }
                    if (!prompt && which > 0 && row < NREAL) { const int sr = row - NP, b = sr >> 4, t = sr & 15;
                        *(u32x4*)(ext + ((size_t)(b * 576 + 512 + t)) * 2048 + col) = pk;
                        float* o = oS + (size_t)sr * 2048 + col; *(f32x4*)o = v0; *(f32x4*)(o + 4) = v1; }
                }
            }
    }
};

struct EpiQkvB {
    static constexpr bool PERM = true;
    unsigned char* ws; float* out;
    __device__ __forceinline__ void operator()(const f32x4 (&acc)[2][2][4][2], const Unit& u, int wr, int wc, int fr, int fq) const {
        const float* rope = (const float*)(ws + WS_ROPE);
        const int which = u.pn < 8 ? 0 : (u.pn < 10 ? 1 : 2);
        const int colt = which == 0 ? u.pn * 256 : (which == 1 ? (u.pn - 8) * 256 : (u.pn - 10) * 256);
        const int ld = which == 0 ? 2048 : 512;
        const int row0 = u.pm * 256 + wr * 64 + fr, col0 = colt + wc * 32 + 8 * fq;
        bf16_t* base = (bf16_t*)(ws + WS_BIG) + (which == 0 ? (size_t)0 : (which == 1 ? (size_t)MP * 2048 : (size_t)MP * 2048 + (size_t)MP * 512));
        bf16_t* ext = (bf16_t*)(ws + (which == 1 ? WS_KEB : WS_VEB));
        float* oP = out + (which == 1 ? O_BKP : O_BVP);
        float* oS = out + (which == 1 ? O_BKS : O_BVS);
        constexpr bool prompt = true; const bool last_tile = ((u.pm & 15) == 15) && which > 0;
        const bool do_rope = (which < 2) && ((wc & 1) == 0);
#pragma unroll
        for (int ai = 0; ai < 2; ++ai) {
            f32x4 rc[4][4];
            if (do_rope) {
#pragma unroll
                for (int m = 0; m < 4; ++m) { const int row = row0 + ai * 128 + m * 16; const float* rp = rope + (size_t)(row & 4095) * 16;
#pragma unroll
                    for (int q = 0; q < 4; ++q) rc[m][q] = *(const f32x4*)(rp + q * 4); } }
#pragma unroll
            for (int m = 0; m < 4; ++m) {
                const int row = row0 + ai * 128 + m * 16;
#pragma unroll
                for (int bj = 0; bj < 2; ++bj) {
                    f32x4 v0 = acc[ai][bj][m][0], v1 = acc[ai][bj][m][1];
                    if (do_rope) {
                        f32x4 p0, p1;
#pragma unroll
                        for (int j = 0; j < 4; ++j) { p0[j] = xchg16(v0[j], (fq & 1) != 0); p1[j] = xchg16(v1[j], (fq & 1) != 0); }
                        if (fq == 0) { v0 = v0 * rc[m][0] - p0 * rc[m][2]; v1 = v1 * rc[m][1] - p1 * rc[m][3]; }
                        else if (fq == 1) { v0 = v0 * rc[m][0] + p0 * rc[m][2]; v1 = v1 * rc[m][1] + p1 * rc[m][3]; }
                    }
                    const int col = col0 + bj * 128;
                    u32x4 pk; pk[0] = pk2(v0[0], v0[1]); pk[1] = pk2(v0[2], v0[3]); pk[2] = pk2(v1[0], v1[1]); pk[3] = pk2(v1[2], v1[3]);
                    *(u32x4*)(base + (size_t)row * ld + col) = pk;
                    if (last_tile && ai == 1) { const int b = row >> 12, t = (row & 4095) - 3968; float* o = oP + ((size_t)(b * 128 + t)) * 512 + col; *(f32x4*)o = v0; *(f32x4*)(o + 4) = v1; }
                }
            }
        }
    }
};

struct EpiUp {
    static constexpr bool PERM = true;
    bf16_t* U;
    __device__ __forceinline__ void operator()(const f32x4 (&acc)[2][2][4][2], const Unit& u, int wr, int wc, int fr, int fq) const {
        const int row0 = u.pm * 256 + wr * 64 + fr, col0 = u.pn * 256 + wc * 32 + 8 * fq;
#pragma unroll
        for (int ai = 0; ai < 2; ++ai)
#pragma unroll
            for (int m = 0; m < 4; ++m) {
                bf16_t* rowp = U + (size_t)(row0 + ai * 128 + m * 16) * 8192 + col0;
#pragma unroll
                for (int bj = 0; bj < 2; ++bj) {
                    f32x4 v0 = acc[ai][bj][m][0], v1 = acc[ai][bj][m][1];
#pragma unroll
                    for (int j = 0; j < 4; ++j) { const float a = fmaxf(v0[j], 0.f), b = fmaxf(v1[j], 0.f); v0[j] = a * a; v1[j] = b * b; }
                    u32x4 pk; pk[0] = pk2(v0[0], v0[1]); pk[1] = pk2(v0[2], v0[3]); pk[2] = pk2(v1[0], v1[1]); pk[3] = pk2(v1[2], v1[3]);
                    *(u32x4*)(rowp + bj * 128) = pk;
                }
            }
    }
};

template <bool HASX>
struct EpiRes {
    static constexpr bool PERM = true;
    const float* xin; bf16_t* Z; const float* gate  ; const float* stats; const float* lng; const float* lnb;
    __device__ __forceinline__ void operator()(const f32x4 (&acc)[2][2][4][2], const Unit& u, int wr, int wc, int fr, int fq) const {
        const int row0 = u.pm * 256 + wr * 64 + fr, col0 = u.pn * 256 + wc * 32 + 8 * fq;
        const float* gr = gate + (size_t)(u.pm >> 4) * 6144 + col0;
        f32x4 gv[2][2], gw[2][2], bw[2][2];
#pragma unroll
        for (int bj = 0; bj < 2; ++bj)
#pragma unroll
            for (int n = 0; n < 2; ++n) { gv[bj][n] = *(const f32x4*)(gr + bj * 128 + n * 4);
                if (!HASX) { gw[bj][n] = *(const f32x4*)(lng + col0 + bj * 128 + n * 4); bw[bj][n] = *(const f32x4*)(lnb + col0 + bj * 128 + n * 4); } }
#pragma unroll
        for (int ai = 0; ai < 2; ++ai) {
            u32x4 zz[4][2]; f32x2 st[4]; f32x4 xx[4][2][2];
#pragma unroll
            for (int m = 0; m < 4; ++m) { const int row = row0 + ai * 128 + m * 16;
                if (HASX) {
#pragma unroll
                    for (int bj = 0; bj < 2; ++bj) { const float* xr = xin + (size_t)row * 2048 + col0 + bj * 128; xx[m][bj][0] = *(const f32x4*)xr; xx[m][bj][1] = *(const f32x4*)(xr + 4); }
                } else { st[m] = *(const f32x2*)(stats + (size_t)row * 2);
#pragma unroll
                    for (int bj = 0; bj < 2; ++bj) zz[m][bj] = *(const u32x4*)(Z + (size_t)row * 2048 + col0 + bj * 128); } }
#pragma unroll
            for (int m = 0; m < 4; ++m) { const int row = row0 + ai * 128 + m * 16;
                bf16_t* zr = Z + (size_t)row * 2048 + col0;
#pragma unroll
                for (int bj = 0; bj < 2; ++bj) {
                    f32x4 x0, x1;
                    if (HASX) { x0 = xx[m][bj][0]; x1 = xx[m][bj][1]; }
                    else { const u32x4 q = zz[m][bj];
                        x0[0] = bf_lo(q[0]); x0[1] = bf_hi(q[0]); x0[2] = bf_lo(q[1]); x0[3] = bf_hi(q[1]); x1[0] = bf_lo(q[2]); x1[1] = bf_hi(q[2]); x1[2] = bf_lo(q[3]); x1[3] = bf_hi(q[3]);
                        x0 = (x0 - st[m][0]) * st[m][1] * gw[bj][0] + bw[bj][0]; x1 = (x1 - st[m][0]) * st[m][1] * gw[bj][1] + bw[bj][1]; }
                    const f32x4 z0 = x0 * ALPHA + gv[bj][0] * acc[ai][bj][m][0], z1 = x1 * ALPHA + gv[bj][1] * acc[ai][bj][m][1];
                    u32x4 pk; pk[0] = pk2(z0[0], z0[1]); pk[1] = pk2(z0[2], z0[3]); pk[2] = pk2(z1[0], z1[1]); pk[3] = pk2(z1[2], z1[3]);
                    *(u32x4*)(zr + bj * 128) = pk;
                }
            }
        }
    }
};

template <class SEpi>
__device__ __forceinline__ void skinny_gemm(LAS unsigned char* lds, const bf16_t* A, int lda, const bf16_t* Wt, int N, int K, const SEpi& E, int wv) {
    const int tid = opaque_tid(wv), wid = tid >> 6, lane = tid & 63, g = lane >> 4, l15 = lane & 15;
    const int kw = K >> 3;
    const bf16_t* ap = A + (size_t)l15 * lda + wid * kw + g * 8;
    LAS f32x4* red = (LAS f32x4*)lds;
    for (int tile = blockIdx.x; tile < (N >> 4); tile += gridDim.x) {
        const int n0 = tile * 16;
        const bf16_t* bp = Wt + (size_t)(n0 + l15) * K + wid * kw + g * 8;
        f32x4 acc[8];
#pragma unroll
        for (int rt = 0; rt < 8; ++rt) acc[rt] = (f32x4){0.f, 0.f, 0.f, 0.f};
        for (int k0 = 0; k0 < kw; k0 += 64) {
            bf16x8 b[2], a[2][8];
#pragma unroll
            for (int i = 0; i < 2; ++i) { b[i] = *(const bf16x8*)(bp + k0 + i * 32);
#pragma unroll
                for (int rt = 0; rt < 8; ++rt) a[i][rt] = *(const bf16x8*)(ap + (size_t)rt * 16 * lda + k0 + i * 32); }
            __builtin_amdgcn_sched_barrier(0);
#pragma unroll
            for (int i = 0; i < 2; ++i)
#pragma unroll
                for (int rt = 0; rt < 8; ++rt) acc[rt] = __builtin_amdgcn_mfma_f32_16x16x32_bf16(b[i], a[i][rt], acc[rt], 0, 0, 0);
            __builtin_amdgcn_sched_barrier(0);
        }
        __syncthreads();
#pragma unroll
        for (int rt = 0; rt < 8; ++rt) red[(wid * 8 + rt) * 64 + lane] = acc[rt];
        __syncthreads();
        f32x4 s = red[wid * 64 + lane];
#pragma unroll
        for (int wv = 1; wv < 8; ++wv) s += red[(wv * 8 + wid) * 64 + lane];
        E(s, wid * 16 + l15, n0, g);
    }
}
struct SEpiQkvA {
    unsigned char* ws; float* out;
    __device__ __forceinline__ void operator()(f32x4 v, int r, int n0, int g) const {
        const int which = n0 >> 11, col = (n0 & 2047) + g * 4;
        u32x2 pk; pk[0] = pk2(v[0], v[1]); pk[1] = pk2(v[2], v[3]);
        if (which == 0) { *(u32x2*)((bf16_t*)(ws + WS_BIG) + (size_t)(NP + r) * 2048 + col) = pk; return; }
        const int b = r >> 4, t = r & 15;
        *(u32x2*)((bf16_t*)(ws + (which == 1 ? WS_KEA : WS_VEA)) + ((size_t)(b * 576 + 512 + t)) * 2048 + col) = pk;
        *(f32x4*)(out + (which == 1 ? O_AKS : O_AVS) + (size_t)r * 2048 + col) = v;
    }
};
struct SEpiQkvB {
    unsigned char* ws; float* out;
    __device__ __forceinline__ void operator()(f32x4 v, int r, int n0, int g) const {
        const int which = n0 < 2048 ? 0 : (n0 < 2560 ? 1 : 2);
        if (which < 2 && (n0 & 63) == 0) {
            const float* rp = (const float*)(ws + WS_ROPE) + (size_t)(4096 + (r & 15)) * 16 + (g & 1) * 4;
            const f32x4 cs = *(const f32x4*)rp, sn = *(const f32x4*)(rp + 8);
            f32x4 pr;
#pragma unroll
            for (int j = 0; j < 4; ++j) pr[j] = xchg32(v[j], g >= 2);
            v = g < 2 ? v * cs - pr * sn : v * cs + pr * sn;
        }
        u32x2 pk; pk[0] = pk2(v[0], v[1]); pk[1] = pk2(v[2], v[3]);
        if (which == 0) { *(u32x2*)((bf16_t*)(ws + WS_BIG) + (size_t)(NP + r) * 2048 + n0 + g * 4) = pk; return; }
        const int col = n0 - (which == 1 ? 2048 : 2560) + g * 4, b = r >> 4, t = r & 15;
        *(u32x2*)((bf16_t*)(ws + (which == 1 ? WS_KEB : WS_VEB)) + ((size_t)(b * 192 + 128 + t)) * 512 + col) = pk;
        *(f32x4*)(out + (which == 1 ? O_BKS : O_BVS) + (size_t)r * 512 + col) = v;
    }
};
struct SEpiUp {
    bf16_t* U;
    __device__ __forceinline__ void operator()(f32x4 v, int r, int n0, int g) const {
#pragma unroll
        for (int j = 0; j < 4; ++j) { const float a = fmaxf(v[j], 0.f); v[j] = a * a; }
        u32x2 pk; pk[0] = pk2(v[0], v[1]); pk[1] = pk2(v[2], v[3]);
        *(u32x2*)(U + (size_t)(NP + r) * 8192 + n0 + g * 4) = pk;
    }
};
struct SEpiRes {
    const float* xin; bf16_t* Z; const float* gate; const float* stats; const float* lng; const float* lnb;
    __device__ __forceinline__ void operator()(f32x4 v, int r, int n0, int g) const {
        const int col = n0 + g * 4;
        f32x4 xv; const f32x4 gv = *(const f32x4*)(gate + (size_t)(8 + (r >> 4)) * 6144 + col);
        if (xin) xv = *(const f32x4*)(xin + (size_t)r * 2048 + col);
        else { const u32x2 zz = *(const u32x2*)(Z + (size_t)r * 2048 + col); const f32x2 st = *(const f32x2*)(stats + (size_t)r * 2);
            xv[0] = bf_lo(zz[0]); xv[1] = bf_hi(zz[0]); xv[2] = bf_lo(zz[1]); xv[3] = bf_hi(zz[1]);
            xv = (xv - st[0]) * st[1] * *(const f32x4*)(lng + col) + *(const f32x4*)(lnb + col); }
        const f32x4 z = xv * ALPHA + gv * v;
        u32x2 pk; pk[0] = pk2(z[0], z[1]); pk[1] = pk2(z[2], z[3]);
        *(u32x2*)(Z + (size_t)r * 2048 + col) = pk;
    }
};

__device__ __forceinline__ void ada_item(const Params& p, int item, LAS float* lds, int wv) {
    const int tid = opaque_tid(wv), wid = tid >> 6, lane = tid & 63;
    const int combo = item / 24, cb = item % 24, col0 = cb * 256;
    const float* W = p.w_ada + (size_t)combo * 2048 * 6144;
    __syncthreads();
    for (int i0 = 0; i0 < 64; i0 += 16) {
        float c[16];
#pragma unroll
        for (int q = 0; q < 16; ++q) { const int idx = tid + 512 * (i0 + q), r = idx >> 11, k = idx & 2047;
            c[q] = r < 8 ? p.c_prompt[r * 2048 + k] : p.c_sample[(r - 8) * 2048 + k]; }
#pragma unroll
        for (int q = 0; q < 16; ++q) { const int idx = tid + 512 * (i0 + q), r = idx >> 11, k = idx & 2047;
            lds[k * 16 + r] = c[q] / (1.f + __expf(-c[q])); }
    }
    __syncthreads();
    f32x4 acc[16];
#pragma unroll
    for (int r = 0; r < 16; ++r) acc[r] = (f32x4){0.f, 0.f, 0.f, 0.f};
    const float* wp = W + (size_t)(wid * 256) * 6144 + col0 + lane * 4;
    for (int kk = 0; kk < 256; kk += 16) {
        f32x4 w[16];
#pragma unroll
        for (int q = 0; q < 16; ++q) w[q] = *(const f32x4*)(wp + (size_t)(kk + q) * 6144);
        __builtin_amdgcn_sched_barrier(0);
#pragma unroll
        for (int q = 0; q < 16; ++q) {
            const LAS f32x4* sp = (const LAS f32x4*)(lds + (wid * 256 + kk + q) * 16);
#pragma unroll
            for (int r4 = 0; r4 < 4; ++r4) { const f32x4 s = sp[r4];
#pragma unroll
                for (int j = 0; j < 4; ++j) acc[r4 * 4 + j] += w[q] * s[j]; }
        }
    }
    __syncthreads();
#pragma unroll
    for (int r = 0; r < 16; ++r) *(LAS f32x4*)(lds + (wid * 16 + r) * 256 + lane * 4) = acc[r];
    __syncthreads();
    float* mod = (float*)(p.ws + WS_MOD);
#pragma unroll
    for (int i = 0; i < 8; ++i) { const int idx = tid + 512 * i, r = idx >> 8, c = idx & 255; float s = 0.f;
#pragma unroll
        for (int w = 0; w < 8; ++w) s += lds[(w * 16 + r) * 256 + c];
        mod[((size_t)combo * 16 + r) * 6144 + col0 + c] = s + p.b_ada[combo * 6144 + col0 + c]; }
}

struct TTile { const float* src; bf16_t* dst; int K, N; };
__device__ __forceinline__ TTile ttile_of(const Params& p, int it) {
    constexpr int T0 = 768, T1 = T0 + 256, T2 = T1 + 384, T3 = T2 + 256, T4 = T3 + 2048;
    const float* src; bf16_t* dst; int K, N, tl;
    if (it < T0)      { src = p.w_qkv_a; dst = (bf16_t*)(p.ws + WS_WQKVA); K = 2048; N = 6144; tl = it; }
    else if (it < T1) { src = p.w_o_a;   dst = (bf16_t*)(p.ws + WS_WOA);   K = 2048; N = 2048; tl = it - T0; }
    else if (it < T2) { src = p.w_qkv_b; dst = (bf16_t*)(p.ws + WS_WQKVB); K = 2048; N = 3072; tl = it - T1; }
    else if (it < T3) { src = p.w_o_b;   dst = (bf16_t*)(p.ws + WS_WOB);   K = 2048; N = 2048; tl = it - T2; }
    else if (it < T4) { const int l = (it - T3) >> 10; src = p.w_up + (size_t)l * 2048 * 8192; dst = (bf16_t*)(p.ws + WS_WUP) + (size_t)l * 2048 * 8192; K = 2048; N = 8192; tl = (it - T3) & 1023; }
    else              { const int l = (it - T4) >> 10; src = p.w_down + (size_t)l * 2048 * 8192; dst = (bf16_t*)(p.ws + WS_WDN) + (size_t)l * 2048 * 8192; K = 8192; N = 2048; tl = (it - T4) & 1023; }
    const int ntn = N >> 7, tk = tl / ntn, tn = tl % ntn;
    TTile r; r.src = src + (size_t)tk * 128 * N + tn * 128; r.dst = dst + (size_t)tn * 128 * K + tk * 128; r.K = K; r.N = N; return r;
}
__device__ __forceinline__ int my_ttile(int j) {
    constexpr int NT = 5760;
    const int nb = gridDim.x, blk = blockIdx.x;
    int idx;
    if (nb == 256) { if (blk >= 96) idx = j < 12 ? j * 160 + (blk - 96) : 1920 + (j - 12) * 256 + blk; else idx = 1920 + j * 256 + blk; }
    else idx = j * nb + blk;
    return idx < NT ? idx : -1;
}
__device__ __forceinline__ void transpose_stream(const Params& p, LAS unsigned* lds, int wv) {
    const int t = opaque_tid(wv), c4 = t & 31, rp = t >> 5;
    f32x4 a[4], b[4];
    int j = 0, it = my_ttile(0), itl = it;
    if (it < 0) return;
    TTile cur = ttile_of(p, it), ld = cur;
#define T_LOAD() do { _Pragma("unroll") for (int ps = 0; ps < 4; ++ps) { const int r = 2 * (rp + 16 * ps); \
        a[ps] = *(const f32x4*)(ld.src + (size_t)r * ld.N + c4 * 4); b[ps] = *(const f32x4*)(ld.src + (size_t)(r + 1) * ld.N + c4 * 4); } } while (0)
#define T_WRITE(buf) do { _Pragma("unroll") for (int ps = 0; ps < 4; ++ps) { const int kp = rp + 16 * ps; \
        _Pragma("unroll") for (int jj = 0; jj < 4; ++jj) { const int n = c4 * 4 + jj; lds[(buf) * 8192 + n * 64 + (kp ^ (((n >> 2) & 7) << 2))] = pk2(a[ps][jj], b[ps][jj]); } } } while (0)
    __syncthreads();
    T_LOAD(); T_WRITE(0);
    int jl = 1; itl = my_ttile(1); if (itl >= 0) { ld = ttile_of(p, itl); T_LOAD(); }
    int bsel = 0;
    for (;;) {
        __syncthreads();
        TTile nxt = ld; const int itn = itl;
        if (itl >= 0) { T_WRITE(bsel ^ 1); ++jl; itl = my_ttile(jl); if (itl >= 0) { ld = ttile_of(p, itl); T_LOAD(); } }
#pragma unroll
        for (int i = 0; i < 4; ++i) { const int n = (t >> 4) + 32 * i, ch = t & 15;
            const u32x4 v = *(const LAS u32x4*)(lds + bsel * 8192 + n * 64 + ((4 * ch) ^ (((n >> 2) & 7) << 2)));
            *(u32x4*)(cur.dst + (size_t)n * cur.K + ch * 8) = v; }
        if (itn < 0) break;
        cur = nxt; bsel ^= 1; ++j;
    }
#undef T_LOAD
#undef T_WRITE
}

__device__ __forceinline__ void phase0(const Params& p, LAS unsigned char* lds, int wv) {
    const int tid = opaque_tid(wv);
    for (int it = blockIdx.x; it < 96; it += gridDim.x) ada_item(p, it, (LAS float*)lds, wv);
    transpose_stream(p, (LAS unsigned*)lds, wv);
    const size_t gtid = (size_t)blockIdx.x * 512 + tid, gstride = (size_t)gridDim.x * 512;
    {
        bf16_t* KE = (bf16_t*)(p.ws + WS_KEA); bf16_t* VE = (bf16_t*)(p.ws + WS_VEA);
        for (size_t i0 = gtid; i0 < (size_t)8 * 576 * 512; i0 += 2 * gstride) {
            f32x4 a[2], c[2]; bool ok[2], ld[2];
#pragma unroll
            for (int q = 0; q < 2; ++q) { const size_t i = i0 + q * gstride; ok[q] = i < (size_t)8 * 576 * 512; const int c4 = (int)(i & 511); const int r = (int)((i >> 9) % 576), b = (int)((i >> 9) / 576);
                ld[q] = ok[q] && r < 512; if (ld[q]) { const size_t sidx = ((size_t)(b * 512 + r)) * 2048 + c4 * 4; a[q] = *(const f32x4*)(p.cache_a_k + sidx); c[q] = *(const f32x4*)(p.cache_a_v + sidx); } }
#pragma unroll
            for (int q = 0; q < 2; ++q) { const size_t i = i0 + q * gstride; if (ok[q]) { u32x2 k = {0u, 0u}, v = {0u, 0u};
                if (ld[q]) { k[0] = pk2(a[q][0], a[q][1]); k[1] = pk2(a[q][2], a[q][3]); v[0] = pk2(c[q][0], c[q][1]); v[1] = pk2(c[q][2], c[q][3]); }
                *(u32x2*)(KE + i * 4) = k; *(u32x2*)(VE + i * 4) = v; } }
        }
    }
    {
        bf16_t* KE = (bf16_t*)(p.ws + WS_KEB); bf16_t* VE = (bf16_t*)(p.ws + WS_VEB);
        for (size_t i = gtid; i < (size_t)8 * 192 * 128; i += gstride) { const int c4 = (int)(i & 127); const int r = (int)((i >> 7) % 192), b = (int)((i >> 7) / 192);
            u32x2 k = {0u, 0u}, v = {0u, 0u};
            if (r < 128) { const size_t s = ((size_t)(b * 128 + r)) * 512 + c4 * 4; const f32x4 a = *(const f32x4*)(p.cache_b_k + s), c = *(const f32x4*)(p.cache_b_v + s);
                k[0] = pk2(a[0], a[1]); k[1] = pk2(a[2], a[3]); v[0] = pk2(c[0], c[1]); v[1] = pk2(c[2], c[3]); }
            *(u32x2*)(KE + i * 4) = k; *(u32x2*)(VE + i * 4) = v; }
    }
    {
        float* rope = (float*)(p.ws + WS_ROPE);
        for (size_t i = gtid; i < (size_t)4112 * 8; i += gstride) { const int f = (int)(i & 7), pi = (int)(i >> 3); const int pos = pi < 4096 ? pi : 1024 + (pi - 4096);
            const double fr = f == 0 ? 1.0 : f == 1 ? 0.19392274474868576 : f == 2 ? 0.03760603093086393 : f == 3 ? 0.007292664737217109 : f == 4 ? 0.001414213562373095 : f == 5 ? 0.0002742481756762073 : f == 6 ? 5.318295896944988e-05 : 1.031338537721246e-05;
            double rev = (double)pos * fr * 0.15915494309189535; rev -= __builtin_rint(rev);
            const float rf = (float)rev;
            rope[(size_t)pi * 16 + f] = __builtin_amdgcn_cosf(rf); rope[(size_t)pi * 16 + 8 + f] = __builtin_amdgcn_sinf(rf); }
    }
}

__device__ __forceinline__ void modulate0(const Params& p, int wv) {
    const float* mod = (const float*)(p.ws + WS_MOD); bf16_t* H = (bf16_t*)(p.ws + WS_H);
    const size_t gtid = (size_t)blockIdx.x * 512 + opaque_tid(wv), gstride = (size_t)gridDim.x * 512, n = (size_t)NREAL * 512;
    for (size_t i0 = gtid; i0 < n; i0 += 4 * gstride) {
        f32x4 x[4], sh[4], sc[4];
#pragma unroll
        for (int q = 0; q < 4; ++q) { const size_t i = i0 + q * gstride; if (i < n) { const int row = (int)(i >> 9), c = (int)(i & 511) * 4;
            const float* xr = row < NP ? p.x_prompt + (size_t)row * 2048 : p.x_sample + (size_t)(row - NP) * 2048;
            const int r16 = row < NP ? (row >> 12) : 8 + ((row - NP) >> 4);
            x[q] = *(const f32x4*)(xr + c); sh[q] = *(const f32x4*)(mod + (size_t)r16 * 6144 + c); sc[q] = *(const f32x4*)(mod + (size_t)r16 * 6144 + 2048 + c); } }
#pragma unroll
        for (int q = 0; q < 4; ++q) { const size_t i = i0 + q * gstride; if (i < n) { const int row = (int)(i >> 9), c = (int)(i & 511) * 4;
            const f32x4 h = x[q] * (sc[q] + 1.f) + sh[q];
            u32x2 o; o[0] = pk2(h[0], h[1]); o[1] = pk2(h[2], h[3]);
            *(u32x2*)(H + (size_t)row * 2048 + c) = o; } }
    }
}

#define LN_UNPACK(v, raw) do { _Pragma("unroll") for (int i = 0; i < 4; ++i) { v[2 * i][0] = bf_lo(raw[i][0]); v[2 * i][1] = bf_hi(raw[i][0]); v[2 * i][2] = bf_lo(raw[i][1]); v[2 * i][3] = bf_hi(raw[i][1]); \
        v[2 * i + 1][0] = bf_lo(raw[i][2]); v[2 * i + 1][1] = bf_hi(raw[i][2]); v[2 * i + 1][2] = bf_lo(raw[i][3]); v[2 * i + 1][3] = bf_hi(raw[i][3]); } } while (0)
#define LN_STATS(v, mu, rstd) float mu, rstd; do { float s_ = 0.f; \
        _Pragma("unroll") for (int i = 0; i < 8; ++i) s_ += (v[i][0] + v[i][1]) + (v[i][2] + v[i][3]); \
        s_ = wave_sum(s_); \
        mu = s_ * (1.f / 2048.f); float q_ = 0.f; \
        _Pragma("unroll") for (int i = 0; i < 8; ++i) { v[i] = v[i] - mu; q_ += (v[i][0] * v[i][0] + v[i][1] * v[i][1]) + (v[i][2] * v[i][2] + v[i][3] * v[i][3]); } \
        q_ = wave_sum(q_); \
        rstd = __builtin_amdgcn_rsqf(q_ * (1.f / 2048.f) + 1e-5f); } while (0)
__device__ __forceinline__ void ln_rows_generic(const Params& p, const float* g, const float* bta, const float* mod_next, int row_begin, int row_end, int wv) {
    float* Y = p.out; bf16_t* H = (bf16_t*)(p.ws + WS_H); const bf16_t* Z = (const bf16_t*)(p.ws + WS_Z); float* ST = (float*)(p.ws + WS_STATS);
    const int tid = opaque_tid(wv), wid = tid >> 6, lane = tid & 63;
    for (int row = row_begin + blockIdx.x * 8 + wid; row < row_end; row += gridDim.x * 8) {
        u32x4 raw[4];
#pragma unroll
        for (int i = 0; i < 4; ++i) raw[i] = *(const u32x4*)(Z + (size_t)row * 2048 + i * 512 + lane * 8);
        f32x4 v[8]; LN_UNPACK(v, raw);
        LN_STATS(v, mu, rstd);
        const int r16 = row < NP ? (row >> 12) : 8 + ((row - NP) >> 4);
        if (mod_next && lane == 0) { f32x2 st; st[0] = mu; st[1] = rstd; *(f32x2*)(ST + (size_t)row * 2) = st; }
        f32x4 pg[8], pb[8], psh[8], psc[8];
#pragma unroll
        for (int i = 0; i < 8; ++i) { const int c = (i >> 1) * 512 + lane * 8 + (i & 1) * 4; pg[i] = *(const f32x4*)(g + c); pb[i] = *(const f32x4*)(bta + c);
            if (mod_next) { const float* mp = mod_next + (size_t)r16 * 6144 + c; psh[i] = *(const f32x4*)mp; psc[i] = *(const f32x4*)(mp + 2048); } }
#pragma unroll
        for (int i = 0; i < 4; ++i) { const int c = i * 512 + lane * 8;
            f32x4 y0 = v[2 * i] * rstd * pg[2 * i] + pb[2 * i], y1 = v[2 * i + 1] * rstd * pg[2 * i + 1] + pb[2 * i + 1];
            if (!mod_next) { *(f32x4*)(Y + (size_t)row * 2048 + c) = y0; *(f32x4*)(Y + (size_t)row * 2048 + c + 4) = y1; }
            else { y0 = y0 * (psc[2 * i] + 1.f) + psh[2 * i]; y1 = y1 * (psc[2 * i + 1] + 1.f) + psh[2 * i + 1];
                u32x4 o; o[0] = pk2(y0[0], y0[1]); o[1] = pk2(y0[2], y0[3]); o[2] = pk2(y1[0], y1[1]); o[3] = pk2(y1[2], y1[3]);
                *(u32x4*)(H + (size_t)row * 2048 + c) = o; } }
    }
}
template <bool MOD>
__device__ __forceinline__ void ln_rows_prompt(const Params& p, const float* g, const float* bta, const float* mod_next, int wv) {
    float* Y = p.out; bf16_t* H = (bf16_t*)(p.ws + WS_H); const bf16_t* Z = (const bf16_t*)(p.ws + WS_Z); float* ST = (float*)(p.ws + WS_STATS);
    const int tid = opaque_tid(wv), wid = tid >> 6, lane = tid & 63;
    const int rpw = NP / (gridDim.x * 8);
    const int row0 = (blockIdx.x * 8 + wid) * rpw, r16 = row0 >> 12, rend = row0 + rpw;
    f32x4 G[8], B[8];
#pragma unroll
    for (int i = 0; i < 8; ++i) { const int c = (i >> 1) * 512 + lane * 8 + (i & 1) * 4; G[i] = *(const f32x4*)(g + c); B[i] = *(const f32x4*)(bta + c);
        if (MOD) { const f32x4 sh = *(const f32x4*)(mod_next + (size_t)r16 * 6144 + c), sc = *(const f32x4*)(mod_next + (size_t)r16 * 6144 + 2048 + c);
            G[i] = G[i] * (sc + 1.f); B[i] = B[i] * (sc + 1.f) + sh; } }
    u32x4 ra[4], rb[4], rc[4];
#define LN_LOAD(raw, row) do { if ((row) < rend) { const bf16_t* _z = Z + (size_t)(row) * 2048 + lane * 8; _Pragma("unroll") for (int i = 0; i < 4; ++i) raw[i] = *(const u32x4*)(_z + i * 512); } } while (0)
#define LN_PROC(raw, row) do { if ((row) < rend) { f32x4 v[8]; LN_UNPACK(v, raw); LN_STATS(v, mu, rstd); \
        if (MOD && lane == 0) { f32x2 st; st[0] = mu; st[1] = rstd; *(f32x2*)(ST + (size_t)(row) * 2) = st; } \
        _Pragma("unroll") for (int i = 0; i < 4; ++i) { const f32x4 h0 = v[2 * i] * rstd * G[2 * i] + B[2 * i], h1 = v[2 * i + 1] * rstd * G[2 * i + 1] + B[2 * i + 1]; \
            if (!MOD) { float* _y = Y + (size_t)(row) * 2048 + i * 512 + lane * 8; *(f32x4*)_y = h0; *(f32x4*)(_y + 4) = h1; } \
            else { u32x4 o; o[0] = pk2(h0[0], h0[1]); o[1] = pk2(h0[2], h0[3]); o[2] = pk2(h1[0], h1[1]); o[3] = pk2(h1[2], h1[3]); *(u32x4*)(H + (size_t)(row) * 2048 + i * 512 + lane * 8) = o; } } } } while (0)
    LN_LOAD(ra, row0); LN_LOAD(rb, row0 + 1);
    for (int r = row0; r < rend; r += 3) {
        LN_LOAD(rc, r + 2);
        LN_PROC(ra, r);
        LN_LOAD(ra, r + 3);
        LN_PROC(rb, r + 1);
        LN_LOAD(rb, r + 4);
        LN_PROC(rc, r + 2);
    }
#undef LN_LOAD
#undef LN_PROC
}
__device__ __forceinline__ void ln_phase(const Params& p, const float* g, const float* bta, const float* mod_next, int wv) {
    const bool fast = (NP % (gridDim.x * 16) == 0) && (4096 % (NP / (gridDim.x * 8)) == 0);
    if (fast) { if (mod_next) ln_rows_prompt<true>(p, g, bta, mod_next, wv); else ln_rows_prompt<false>(p, g, bta, mod_next, wv); }
    ln_rows_generic(p, g, bta, mod_next, fast ? NP : 0, NREAL, wv);
}

template <int D, int KS, bool BIAS>
__device__ __forceinline__ void attn_qk(const LAS unsigned char* Kl, const bf16x8 (&qf)[2][D / 32], float (&m)[2], float (&l)[2], bf16x8 (&pf)[2][2], float (&alpha)[2],
                                        float sc2, int jbase, int jhi, int qi, const LAS float* btab, int lane) {
    const int g = lane >> 4, l15 = lane & 15;
    f32x4 s[2][4];
    const LAS unsigned char* kp = Kl + l15 * KS + g * 16;
    bf16x8 kf[2][D / 32];
#pragma unroll
    for (int ks = 0; ks < D / 32; ++ks) kf[0][ks] = *(const LAS bf16x8*)(kp + ks * 64);
#pragma unroll
    for (int sub = 0; sub < 4; ++sub) { s[0][sub] = (f32x4){0.f, 0.f, 0.f, 0.f}; s[1][sub] = s[0][sub];
        if (sub + 1 < 4) {
#pragma unroll
            for (int ks = 0; ks < D / 32; ++ks) kf[(sub + 1) & 1][ks] = *(const LAS bf16x8*)(kp + (sub + 1) * 16 * KS + ks * 64);
        }
#pragma unroll
        for (int ks = 0; ks < D / 32; ++ks) {
            s[0][sub] = __builtin_amdgcn_mfma_f32_16x16x32_bf16(kf[sub & 1][ks], qf[0][ks], s[0][sub], 0, 0, 0);
            s[1][sub] = __builtin_amdgcn_mfma_f32_16x16x32_bf16(kf[sub & 1][ks], qf[1][ks], s[1][sub], 0, 0, 0); }
        __builtin_amdgcn_sched_barrier(0); }
    const bool far = BIAS && (jbase + 63 + 128 <= 512);
    const bool part = jbase + 64 > jhi;
    const float bfar = BIAS ? btab[0] : 0.f;
    const LAS float* brow = BIAS ? btab + (64 + jbase - qi + 4 * g) : btab;
#pragma unroll
    for (int u = 0; u < 2; ++u) {
        float mn, ls = 0.f;
        if (!BIAS || far) {
            float mx = -3e38f;
#pragma unroll
            for (int sub = 0; sub < 4; ++sub)
#pragma unroll
                for (int j = 0; j < 4; ++j) { if (part && jbase + sub * 16 + g * 4 + j >= jhi) s[u][sub][j] = -3e38f; mx = fmaxf(mx, s[u][sub][j]); }
            mx = xmax32(xmax16(mx));
            mn = fmaxf(m[u], __builtin_fmaf(mx, sc2, bfar)); alpha[u] = __builtin_amdgcn_exp2f(m[u] - mn); m[u] = mn;
            const float c = bfar - mn;
#pragma unroll
            for (int sub = 0; sub < 4; ++sub)
#pragma unroll
                for (int j = 0; j < 4; ++j) { const float pv = a_exp2(a_fma(s[u][sub][j], sc2, c)); s[u][sub][j] = pv; ls = a_add(ls, pv); }
        } else {
            float mx = -1e30f;
#pragma unroll
            for (int sub = 0; sub < 4; ++sub)
#pragma unroll
                for (int j = 0; j < 4; ++j) { float v = __builtin_fmaf(s[u][sub][j], sc2, brow[sub * 16 + 16 - 16 * u + j]);
                    if (part && jbase + sub * 16 + g * 4 + j >= jhi) v = -1e30f;
                    s[u][sub][j] = v; mx = fmaxf(mx, v); }
            mx = xmax32(xmax16(mx));
            mn = fmaxf(m[u], mx); alpha[u] = __builtin_amdgcn_exp2f(m[u] - mn); m[u] = mn;
#pragma unroll
            for (int sub = 0; sub < 4; ++sub)
#pragma unroll
                for (int j = 0; j < 4; ++j) { const float pv = a_exp2(a_sub(s[u][sub][j], mn)); s[u][sub][j] = pv; ls = a_add(ls, pv); }
        }
        l[u] = l[u] * alpha[u] + ls;
#pragma unroll
        for (int t = 0; t < 2; ++t) { u32x4 w; w[0] = pk2(s[u][2 * t][0], s[u][2 * t][1]); w[1] = pk2(s[u][2 * t][2], s[u][2 * t][3]); w[2] = pk2(s[u][2 * t + 1][0], s[u][2 * t + 1][1]); w[3] = pk2(s[u][2 * t + 1][2], s[u][2 * t + 1][3]);
            pf[u][t] = __builtin_bit_cast(bf16x8, w); }
    }
}
template <int D, int VS>
__device__ __forceinline__ void attn_pv(const LAS unsigned char* Vl, f32x4 (&o)[2][D / 16], const bf16x8 (&pf)[2][2], const float (&alpha)[2], int lane) {
    const int g = lane >> 4, q4 = (lane >> 2) & 3, p4 = lane & 3;
    const LAS unsigned char* vb = Vl + (g * 4 + q4) * VS + p4 * 8;
    if (__builtin_amdgcn_ballot_w64(alpha[0] != 1.f || alpha[1] != 1.f) != 0ull) {
#pragma unroll
        for (int ds = 0; ds < D / 16; ++ds) { o[0][ds] = o[0][ds] * alpha[0]; o[1][ds] = o[1][ds] * alpha[1]; }
    }
    bf16x8 vf[2][2];
#define PV_READ(buf, ds_) do { _Pragma("unroll") for (int t = 0; t < 2; ++t) { \
        const bf16x4 a1 = __builtin_amdgcn_ds_read_tr16_b64_v4i16((LAS bf16x4*)(vb + (t * 32) * VS + (ds_) * 32)); \
        const bf16x4 a2 = __builtin_amdgcn_ds_read_tr16_b64_v4i16((LAS bf16x4*)(vb + (t * 32 + 16) * VS + (ds_) * 32)); \
        vf[buf][t] = __builtin_shufflevector(a1, a2, 0, 1, 2, 3, 4, 5, 6, 7); } } while (0)
    PV_READ(0, 0);
#pragma unroll
    for (int ds = 0; ds < D / 16; ++ds) {
        if (ds + 1 < D / 16) PV_READ((ds + 1) & 1, ds + 1);
#pragma unroll
        for (int t = 0; t < 2; ++t) {
            o[0][ds] = __builtin_amdgcn_mfma_f32_16x16x32_bf16(vf[ds & 1][t], pf[0][t], o[0][ds], 0, 0, 0);
            o[1][ds] = __builtin_amdgcn_mfma_f32_16x16x32_bf16(vf[ds & 1][t], pf[1][t], o[1][ds], 0, 0, 0); }
        __builtin_amdgcn_sched_barrier(0);
    }
#undef PV_READ
}

struct AUnit { const bf16_t* kb; const bf16_t* vb; long qrow0; int hq, jt0, jhi, qvalid; };
__device__ __forceinline__ AUnit attn_a_unit(const Params& p, int u) {
    AUnit r; const bf16_t* Q = (const bf16_t*)(p.ws + WS_BIG); const bf16_t* Kg = Q + (size_t)MP * 2048; const bf16_t* Vg = Kg + (size_t)MP * 2048;
    if (u >= 1792 && u < 1824) { const int su = u - 1792, b = su >> 2; r.hq = su & 3; r.qrow0 = NP + b * 16; r.kb = (const bf16_t*)(p.ws + WS_KEA) + (size_t)b * 576 * 2048; r.vb = (const bf16_t*)(p.ws + WS_VEA) + (size_t)b * 576 * 2048; r.jt0 = 0; r.jhi = 528; r.qvalid = 16; return r; }
    int c, v;
    if (u < 1792) { v = u; c = 8 + (u >> 5); } else { v = u - 1824; c = 7 - (v >> 5); }
    const int b = (v >> 2) & 7; r.hq = v & 3; r.qrow0 = (long)b * 4096 + c * 64; r.kb = Kg + (r.qrow0 - 512) * 2048; r.vb = Vg + (r.qrow0 - 512) * 2048; r.jt0 = c < 8 ? 8 - c : 0; r.jhi = 576; r.qvalid = 64;
    return r;
}
__device__ __forceinline__ void attn_a_phase(const Params& p, LAS unsigned char* lds, int wv) {
    constexpr int KS = 1056, VS = 1056, NU = 2080;
    const int tid = opaque_tid(wv), wid = tid >> 6, lane = tid & 63, g = lane >> 4, l15 = lane & 15, hh = wid >> 1, rg = wid & 1;
    LAS unsigned char* Kl = lds; LAS unsigned char* Vl = lds + 64 * KS; LAS float* btab = (LAS float*)(lds + 64 * KS + 64 * VS);
    const bf16_t* Q = (const bf16_t*)(p.ws + WS_BIG);
    bf16_t* O = (bf16_t*)(p.ws + WS_H);
    const float sc2 = 0.08838834764831845f * LOG2E;
    const int skey = tid >> 6, sch = tid & 63;
    u32x4 kr[8], vr[8];
    int unit = blockIdx.x;
    if (unit >= NU) return;
    AUnit cu = attn_a_unit(p, unit);
    const unsigned voff = (unsigned)(skey * 2048 + sch * 8) * 2u;
    { const size_t ub = ((size_t)cu.jt0 * 64 * 2048 + cu.hq * 512) * 2;
#pragma unroll
      for (int i = 0; i < 8; ++i) { kr[i] = *(const u32x4*)((const char*)cu.kb + ub + (size_t)i * 32768 + voff); vr[i] = *(const u32x4*)((const char*)cu.vb + ub + (size_t)i * 32768 + voff); } }
    for (;;) {
        const int nunit = unit + gridDim.x; const bool has_next = nunit < NU;
        AUnit nu = cu; if (has_next) nu = attn_a_unit(p, nunit);
        const int h = cu.hq * 4 + hh;
        __syncthreads();
        int tid2 = tid; asm volatile("" : "+v"(tid2));
        float tb[6];
#pragma unroll
        for (int k = 0; k < 6; ++k) { int i = tid2 + 512 * k; i = i < 4 * 656 ? i : 4 * 656 - 1; const int h2 = i / 656, x = i - h2 * 656, r = x - 80; const int ti = r <= 384 ? 256 : 640 - r;
            tb[k] = p.rel_bias_a[(cu.hq * 4 + h2) * 257 + ti]; }
#pragma unroll
        for (int k = 0; k < 6; ++k) { const int i = tid2 + 512 * k;
            if (i < 4 * 656) { const int h2 = i / 656, x = i - h2 * 656; btab[h2 * 672 + x] = tb[k] * LOG2E; } }
        bf16x8 qf[2][4];
        { const int l15b = tid2 & 15, gb = (tid2 >> 4) & 3;
          const bf16_t* qp = Q + (size_t)(cu.qrow0 + rg * 32 + l15b) * 2048 + h * 128 + gb * 8;
#pragma unroll
          for (int u = 0; u < 2; ++u)
#pragma unroll
            for (int ks = 0; ks < 4; ++ks) qf[u][ks] = *(const bf16x8*)(qp + (size_t)u * 16 * 2048 + ks * 32); }
        f32x4 o[2][8];
#pragma unroll
        for (int u = 0; u < 2; ++u)
#pragma unroll
            for (int i = 0; i < 8; ++i) o[u][i] = (f32x4){0.f, 0.f, 0.f, 0.f};
        float m[2] = {-1e30f, -1e30f}, l[2] = {0.f, 0.f};
        for (int jt = cu.jt0; jt < 9; ++jt) {
            __syncthreads();
#pragma unroll
            for (int i = 0; i < 8; ++i) { *(LAS u32x4*)(Kl + (skey + 8 * i) * KS + sch * 16) = kr[i]; *(LAS u32x4*)(Vl + (skey + 8 * i) * VS + sch * 16) = vr[i]; }
            __syncthreads();
            const bool more = jt + 1 < 9;
            const size_t nub = ((size_t)(more ? jt + 1 : nu.jt0) * 64 * 2048 + (more ? cu.hq : nu.hq) * 512) * 2;
            const char* nkb = (const char*)(more ? cu.kb : nu.kb) + nub; const char* nvb = (const char*)(more ? cu.vb : nu.vb) + nub;
            if (more || has_next) {
#pragma unroll
                for (int i = 0; i < 8; ++i) kr[i] = *(const u32x4*)(nkb + (size_t)i * 32768 + voff);
            }
            bf16x8 pf[2][2]; float alpha[2];
            attn_qk<128, KS, true>(Kl + hh * 256, qf, m, l, pf, alpha, sc2, jt * 64, cu.jhi, rg * 32 + l15, btab + hh * 672, lane);
            __builtin_amdgcn_sched_barrier(0);
            if (more || has_next) {
#pragma unroll
                for (int i = 0; i < 8; ++i) vr[i] = *(const u32x4*)(nvb + (size_t)i * 32768 + voff);
            }
            __builtin_amdgcn_sched_barrier(0);
            attn_pv<128, VS>(Vl + hh * 256, o, pf, alpha, lane);
        }
#pragma unroll
        for (int u = 0; u < 2; ++u) {
            float lt = l[u]; lt = xsum32(xsum16(lt));
            const float inv = 1.f / lt;
            int tid3 = tid; asm volatile("" : "+v"(tid3)); const int l15c = tid3 & 15, gc = (tid3 >> 4) & 3;
            if (rg * 32 + u * 16 + l15c < cu.qvalid) { bf16_t* op = O + (size_t)(cu.qrow0 + rg * 32 + u * 16 + l15c) * 2048 + h * 128 + gc * 4;
#pragma unroll
                for (int ds = 0; ds < 8; ++ds) { u32x2 w; w[0] = pk2(o[u][ds][0] * inv, o[u][ds][1] * inv); w[1] = pk2(o[u][ds][2] * inv, o[u][ds][3] * inv); *(u32x2*)(op + ds * 16) = w; } }
        }
        if (!has_next) break;
        cu = nu; unit = nunit;
    }
}

struct BUnit { const bf16_t* kb; const bf16_t* vb; long qrow0; int kvh, jt0, jhi, qvalid; };
__device__ __forceinline__ BUnit attn_b_unit(const Params& p, int u) {
    BUnit r; const bf16_t* Q = (const bf16_t*)(p.ws + WS_BIG); const bf16_t* Kg = Q + (size_t)MP * 2048; const bf16_t* Vg = Kg + (size_t)MP * 512;
    if (u >= 3968 && u < 4032) { const int su = u - 3968, b = su >> 3; r.kvh = su & 7; r.qrow0 = NP + b * 16; r.kb = (const bf16_t*)(p.ws + WS_KEB) + (size_t)b * 192 * 512; r.vb = (const bf16_t*)(p.ws + WS_VEB) + (size_t)b * 192 * 512; r.jt0 = 0; r.jhi = 144; r.qvalid = 16; return r; }
    int c, v;
    if (u < 3968) { v = u; c = 2 + (u >> 6); } else { v = u - 4032; c = 1 - (v >> 6); }
    const int b = (v >> 3) & 7; r.kvh = v & 7; r.qrow0 = (long)b * 4096 + c * 64; r.kb = Kg + (r.qrow0 - 128) * 512; r.vb = Vg + (r.qrow0 - 128) * 512; r.jt0 = c < 2 ? 2 - c : 0; r.jhi = 192; r.qvalid = 64;
    return r;
}
__device__ __forceinline__ void attn_b_phase(const Params& p, LAS unsigned char* lds, unsigned long long& pb_acc, int wv) {
    unsigned long long pb_t0 = 0; (void)pb_t0;
    constexpr int KS = 160, VS = 160, NU = 4160;
    const int tid = opaque_tid(wv), wid = tid >> 6, lane = tid & 63, g = lane >> 4, l15 = lane & 15;
    LAS unsigned char* Kl = lds; LAS unsigned char* Vl = lds + 192 * KS;
    const bf16_t* Q = (const bf16_t*)(p.ws + WS_BIG);
    bf16_t* O = (bf16_t*)(p.ws + WS_H);
    const float sc2 = 0.125f * LOG2E;
    const int qloc = (wid & 1) * 32 + l15;
    u32x4 kr[3], vr[3];
    bf16x8 qf[2][2], qn[2][2]; float sink_c = 0.f, sink_n = 0.f;
    int unit = blockIdx.x;
    if (unit >= NU) return;
    BUnit cu = attn_b_unit(p, unit);
#define B_LOAD(u_, q_, sk_) do { _Pragma("unroll") for (int i = 0; i < 3; ++i) { const int ci = tid + 512 * i, key = ci >> 3, ch = ci & 7; \
            if (key >= (u_).jt0 * 64) { const size_t off = (size_t)key * 512 + (u_).kvh * 64 + ch * 8; kr[i] = *(const u32x4*)((u_).kb + off); vr[i] = *(const u32x4*)((u_).vb + off); } } \
        { const bf16_t* qp = Q + (size_t)((u_).qrow0 + qloc) * 2048 + ((u_).kvh * 4 + (wid >> 1)) * 64 + g * 8; \
          _Pragma("unroll") for (int u = 0; u < 2; ++u) { q_[u][0] = *(const bf16x8*)(qp + (size_t)u * 16 * 2048); q_[u][1] = *(const bf16x8*)(qp + (size_t)u * 16 * 2048 + 32); } } \
        sk_ = p.sink_b[(u_).kvh * 4 + (wid >> 1)]; } while (0)
    B_LOAD(cu, qf, sink_c);
    for (;;) {
        const int nunit = unit + gridDim.x; const bool has_next = nunit < NU;
        BUnit nu = cu; if (has_next) nu = attn_b_unit(p, nunit);
        PB_BEGIN(512);
        __syncthreads();
#pragma unroll
        for (int i = 0; i < 3; ++i) { const int ci = tid + 512 * i, key = ci >> 3, ch = ci & 7;
            if (key >= cu.jt0 * 64) { *(LAS u32x4*)(Kl + key * KS + ch * 16) = kr[i]; *(LAS u32x4*)(Vl + key * VS + ch * 16) = vr[i]; } }
        __syncthreads();
        PB_END(512);
        if (has_next) B_LOAD(nu, qn, sink_n);
        const int h = cu.kvh * 4 + (wid >> 1);
        const float sink2 = sink_c * LOG2E;
        f32x4 o[2][4];
#pragma unroll
        for (int u = 0; u < 2; ++u)
#pragma unroll
            for (int i = 0; i < 4; ++i) o[u][i] = (f32x4){0.f, 0.f, 0.f, 0.f};
        float m[2] = {sink2, sink2}, l[2]; l[0] = l[1] = (g == 0) ? 1.f : 0.f;
        PB_BEGIN(1024);
        for (int jt = cu.jt0; jt < 3; ++jt) { bf16x8 pf[2][2]; float alpha[2];
            attn_qk<64, KS, false>(Kl + jt * 64 * KS, qf, m, l, pf, alpha, sc2, jt * 64, cu.jhi, qloc, nullptr, lane);
            attn_pv<64, VS>(Vl + jt * 64 * VS, o, pf, alpha, lane); }
        PB_END(1024);
#pragma unroll
        for (int u = 0; u < 2; ++u) {
            float lt = l[u]; lt = xsum32(xsum16(lt));
            const float inv = 1.f / lt;
            if (qloc + 16 * u < cu.qvalid) { bf16_t* op = O + (size_t)(cu.qrow0 + qloc + 16 * u) * 2048 + h * 64 + g * 4;
#pragma unroll
                for (int ds = 0; ds < 4; ++ds) { u32x2 w; w[0] = pk2(o[u][ds][0] * inv, o[u][ds][1] * inv); w[1] = pk2(o[u][ds][2] * inv, o[u][ds][3] * inv); *(u32x2*)(op + ds * 16) = w; } }
        }
        if (!has_next) break;
#pragma unroll
        for (int u = 0; u < 2; ++u) { qf[u][0] = qn[u][0]; qf[u][1] = qn[u][1]; }
        sink_c = sink_n;
        cu = nu; unit = nunit;
    }
#undef B_LOAD
}

#define XB_TMO      128
#define XB_XCNT(j)  (256  + 64 * (j))
#define XB_XSUB(j)  (1280 + 64 * (j))
#define XB_XGEN(j)  (2304 + 64 * (j))
#define XB_TOP      3328
#define XB_TOPGEN   3392
#define XCD_BAR_WORDS 3456
#define XB_SPIN_CAP (1u << 18)
__device__ __forceinline__ unsigned xb_ld(unsigned* p)              { return __hip_atomic_load(p, __ATOMIC_RELAXED, __HIP_MEMORY_SCOPE_AGENT); }
__device__ __forceinline__ unsigned xb_add(unsigned* p, unsigned v) { return __hip_atomic_fetch_add(p, v, __ATOMIC_RELAXED, __HIP_MEMORY_SCOPE_AGENT); }
__device__ __forceinline__ unsigned xb_xcc_id() { return (unsigned)__builtin_amdgcn_s_getreg((3 << 11) | 20) & 0xFu; }
#define XB_SPIN(cond, bar) do { unsigned _sp = 0; while (cond) { __builtin_amdgcn_s_sleep(1); \
    if ((++_sp & 255u) == 0u) { if (xb_ld(&(bar)[XB_TMO])) break; if (_sp > XB_SPIN_CAP) { atomicAdd(&(bar)[XB_TMO], 1u); break; } } } } while (0)
struct XcdBarrier { unsigned* bar; unsigned x; volatile LAS unsigned* st; };
__device__ __forceinline__ XcdBarrier xcd_barrier_post(unsigned* bar, volatile LAS unsigned* st) {
    XcdBarrier b; b.bar = bar; b.x = xb_xcc_id(); b.st = st;
    if (threadIdx.x == 0) (void)xb_add(&bar[XB_XCNT(b.x)], 1u);
    return b;
}
__device__ __forceinline__ void xcd_barrier_complete(unsigned* bar, unsigned x, unsigned& nloc, unsigned& nx) {
    const unsigned G = gridDim.x * gridDim.y * gridDim.z;
    unsigned sum, cnt, mine, sp = 0u;
    for (;;) {
        sum = 0u; cnt = 0u; mine = 0u;
#pragma unroll
        for (unsigned j = 0; j < 16; ++j) { const unsigned c = xb_ld(&bar[XB_XCNT(j)]); sum += c; cnt += (c > 0u) ? 1u : 0u; mine = (j == x) ? c : mine; }
        if (sum == G) break;
        __builtin_amdgcn_s_sleep(1);
        if ((++sp & 255u) == 0u) { if (xb_ld(&bar[XB_TMO])) break; if (sp > XB_SPIN_CAP) { atomicAdd(&bar[XB_TMO], 1u); break; } }
    }
    nloc = mine > 0u ? mine : 1u; nx = cnt > 0u ? cnt : 1u;
}
__device__ __forceinline__ void xcd_barrier(const XcdBarrier& b, bool leader) {
    asm volatile("s_waitcnt vmcnt(0)" ::: "memory");
    __syncthreads();
    if (leader) {
        unsigned* bar = b.bar;
        __builtin_amdgcn_s_waitcnt(0);
        unsigned nloc = b.st[0], nx = b.st[1];
        if (nloc == 0u) { xcd_barrier_complete(bar, b.x, nloc, nx); b.st[0] = nloc; b.st[1] = nx; }
        const unsigned old = xb_add(&bar[XB_XSUB(b.x)], 1u);
        const unsigned gen = old / nloc;
        if (old + 1u == (gen + 1u) * nloc) {
            __builtin_amdgcn_fence(__ATOMIC_RELEASE, "agent");
            asm volatile("s_waitcnt vmcnt(0)" ::: "memory");
            const unsigned og = xb_add(&bar[XB_TOP], 1u);
            const unsigned tg = og / nx;
            if (og + 1u == (tg + 1u) * nx) xb_add(&bar[XB_TOPGEN], 1u);
            else XB_SPIN(xb_ld(&bar[XB_TOPGEN]) == tg, bar);
            __builtin_amdgcn_fence(__ATOMIC_ACQUIRE, "agent");
            xb_add(&bar[XB_XGEN(b.x)], 1u);
            asm volatile("s_waitcnt vmcnt(0)" ::: "memory");
        } else {
            XB_SPIN(xb_ld(&bar[XB_XGEN(b.x)]) == gen, bar);
            __builtin_amdgcn_fence(__ATOMIC_ACQUIRE, "agent");
            asm volatile("s_waitcnt vmcnt(0)" ::: "memory");
        }
    }
    __syncthreads();
}

constexpr int LDS_BYTES = 147456;

__global__ void __launch_bounds__(512, 2) mega_fwd(Params p_unused) {
    extern __shared__ __attribute__((aligned(16))) unsigned char shm[];
    LAS unsigned char* lds = (LAS unsigned char*)shm;
    cg::grid_group grid = cg::this_grid();
    const int wv = __builtin_amdgcn_readfirstlane((int)(threadIdx.x >> 6));
    unsigned long long pb_t0 = 0, pb_acc = 0; (void)pb_t0; (void)pb_acc;
    volatile LAS unsigned* xb_st = (volatile LAS unsigned*)(lds + LDS_BYTES - 16);
    if (threadIdx.x == 0) { xb_st[0] = 0u; xb_st[1] = 0u; }
    __syncthreads();
    { const Params p = load_params(); (void)xcd_barrier_post((unsigned*)(p.ws + WS_BAR), xb_st); }
#define GRID_BARRIER() do { const Params pq = load_params(); XcdBarrier xb; xb.bar = (unsigned*)(pq.ws + WS_BAR); xb.x = xb_xcc_id(); \
        xb.st = (volatile LAS unsigned*)(lds + LDS_BYTES - 16); xcd_barrier(xb, opaque_tid(wv) == 0); } while (0)

    PB_BEGIN(1);
    if (gridDim.y > 1) grid.sync();
    { const Params p = load_params(); phase0(p, lds, wv); }
    GRID_BARRIER();
    PB_END(1);
    PB_BEGIN(2);
    { const Params p = load_params(); modulate0(p, wv); }
    GRID_BARRIER();
    PB_END(2);
    for (int l = 0; l < 2; ++l) {
        if (l == 0) {
            PB_BEGIN(4);
            { const Params p = load_params(); pg8::StaticOrder S; S.init(NP, 6144, gridDim.x, blockIdx.x);
              EpiQkvA E{p.ws, p.out};
              pg8::gemm_phase(lds, pg8::Gemm{(const bf16_t*)(p.ws + WS_H), (const bf16_t*)(p.ws + WS_WQKVA), NP, 6144, 2048}, S, E, wv); }
            PB_END(4);
            PB_BEGIN(8);
            { const Params p = load_params(); SEpiQkvA E{p.ws, p.out};
              skinny_gemm(lds, (const bf16_t*)(p.ws + WS_H) + (size_t)NP * 2048, 2048, (const bf16_t*)(p.ws + WS_WQKVA), 6144, 2048, E, wv); }
            PB_END(8);
            PB_BEGIN(128); GRID_BARRIER(); PB_END(128);
            PB_BEGIN(32);
            { const Params p = load_params(); attn_a_phase(p, lds, wv); }
            GRID_BARRIER();
            PB_END(32);
        } else {
            PB_BEGIN(4);
            { const Params p = load_params(); pg8::StaticOrder S; S.init(NP, 3072, gridDim.x, blockIdx.x);
              EpiQkvB E{p.ws, p.out};
              pg8::gemm_phase(lds, pg8::Gemm{(const bf16_t*)(p.ws + WS_H), (const bf16_t*)(p.ws + WS_WQKVB), NP, 3072, 2048}, S, E, wv); }
            PB_END(4);
            PB_BEGIN(8);
            { const Params p = load_params(); SEpiQkvB E{p.ws, p.out};
              skinny_gemm(lds, (const bf16_t*)(p.ws + WS_H) + (size_t)NP * 2048, 2048, (const bf16_t*)(p.ws + WS_WQKVB), 3072, 2048, E, wv); }
            PB_END(8);
            PB_BEGIN(128); GRID_BARRIER(); PB_END(128);
            PB_BEGIN(64);
            { const Params p = load_params(); attn_b_phase(p, lds, pb_acc, wv); }
            GRID_BARRIER();
            PB_END(64);
        }
        PB_BEGIN(4);
        {
            const Params p = load_params(); pg8::StaticOrder S; S.init(NP, 2048, gridDim.x, blockIdx.x);
            const float* mod = (const float*)(p.ws + WS_MOD);
            if (l == 0) { EpiRes<true> E{p.x_prompt, (bf16_t*)(p.ws + WS_Z), mod + 4096, nullptr, nullptr, nullptr};
                pg8::gemm_phase(lds, pg8::Gemm{(const bf16_t*)(p.ws + WS_H), (const bf16_t*)(p.ws + WS_WOA), NP, 2048, 2048}, S, E, wv); }
            else { EpiRes<false> E{nullptr, (bf16_t*)(p.ws + WS_Z), mod + (size_t)2 * 16 * 6144 + 4096, (const float*)(p.ws + WS_STATS), p.ln_g + 2048, p.ln_b + 2048};
                pg8::gemm_phase(lds, pg8::Gemm{(const bf16_t*)(p.ws + WS_H), (const bf16_t*)(p.ws + WS_WOB), NP, 2048, 2048}, S, E, wv); }
        }
        PB_END(4);
        PB_BEGIN(8);
        {
            const Params p = load_params(); const float* mod = (const float*)(p.ws + WS_MOD);
            SEpiRes E{l == 0 ? p.x_sample : nullptr, (bf16_t*)(p.ws + WS_Z) + (size_t)NP * 2048, mod + (size_t)(2 * l) * 16 * 6144 + 4096, (const float*)(p.ws + WS_STATS) + (size_t)NP * 2, p.ln_g + 2048, p.ln_b + 2048};
            skinny_gemm(lds, (const bf16_t*)(p.ws + WS_H) + (size_t)NP * 2048, 2048, (const bf16_t*)(p.ws + (l == 0 ? WS_WOA : WS_WOB)), 2048, 2048, E, wv);
        }
        PB_END(8);
        PB_BEGIN(128); GRID_BARRIER(); PB_END(128);
        PB_BEGIN(16);
        { const Params p = load_params(); const float* mod = (const float*)(p.ws + WS_MOD);
          ln_phase(p, p.ln_g + (2 * l) * 2048, p.ln_b + (2 * l) * 2048, mod + (size_t)(2 * l + 1) * 16 * 6144, wv); }
        GRID_BARRIER();
        PB_END(16);
        PB_BEGIN(4);
        {
            const Params p = load_params(); pg8::StaticOrder S; S.init(NP, 8192, gridDim.x, blockIdx.x);
            EpiUp E{(bf16_t*)(p.ws + WS_BIG)};
            pg8::gemm_phase(lds, pg8::Gemm{(const bf16_t*)(p.ws + WS_H), (const bf16_t*)(p.ws + WS_WUP) + (size_t)l * 2048 * 8192, NP, 8192, 2048}, S, E, wv);
        }
        PB_END(4);
        PB_BEGIN(8);
        {
            const Params p = load_params(); SEpiUp E{(bf16_t*)(p.ws + WS_BIG)};
            skinny_gemm(lds, (const bf16_t*)(p.ws + WS_H) + (size_t)NP * 2048, 2048, (const bf16_t*)(p.ws + WS_WUP) + (size_t)l * 2048 * 8192, 8192, 2048, E, wv);
        }
        PB_END(8);
        PB_BEGIN(128); GRID_BARRIER(); PB_END(128);
        PB_BEGIN(4);
        {
            const Params p = load_params(); pg8::StaticOrder S; S.init(NP, 2048, gridDim.x, blockIdx.x);
            const float* mod = (const float*)(p.ws + WS_MOD);
            EpiRes<false> E{nullptr, (bf16_t*)(p.ws + WS_Z), mod + (size_t)(2 * l + 1) * 16 * 6144 + 4096, (const float*)(p.ws + WS_STATS), p.ln_g + (2 * l) * 2048, p.ln_b + (2 * l) * 2048};
            pg8::gemm_phase(lds, pg8::Gemm{(const bf16_t*)(p.ws + WS_BIG), (const bf16_t*)(p.ws + WS_WDN) + (size_t)l * 2048 * 8192, NP, 2048, 8192}, S, E, wv);
        }
        PB_END(4);
        PB_BEGIN(8);
        {
            const Params p = load_params(); const float* mod = (const float*)(p.ws + WS_MOD);
            SEpiRes E{nullptr, (bf16_t*)(p.ws + WS_Z) + (size_t)NP * 2048, mod + (size_t)(2 * l + 1) * 16 * 6144 + 4096, (const float*)(p.ws + WS_STATS) + (size_t)NP * 2, p.ln_g + (2 * l) * 2048, p.ln_b + (2 * l) * 2048};
            skinny_gemm(lds, (const bf16_t*)(p.ws + WS_BIG) + (size_t)NP * 8192, 8192, (const bf16_t*)(p.ws + WS_WDN) + (size_t)l * 2048 * 8192, 2048, 8192, E, wv);
        }
        PB_END(8);
        PB_BEGIN(128); GRID_BARRIER(); PB_END(128);
        PB_BEGIN(16);
        { const Params p = load_params(); const float* mod = (const float*)(p.ws + WS_MOD);
          ln_phase(p, p.ln_g + (2 * l + 1) * 2048, p.ln_b + (2 * l + 1) * 2048, l == 0 ? mod + (size_t)2 * 16 * 6144 : nullptr, wv); }
        if (l == 0) GRID_BARRIER();
        PB_END(16);
    }
    if (PROBE_MASK & 256) { for (int i = 0; i < 16; ++i) GRID_BARRIER(); }
    if (PROBE_MASK) { const unsigned long long t1 = __builtin_amdgcn_s_memrealtime(); while (__builtin_amdgcn_s_memrealtime() - t1 < pb_acc) __builtin_amdgcn_s_sleep(8); }
}

extern "C" void kernel_launch(void* const* d_in, const int* in_sizes, int n_in, void* d_out, int out_size, void* d_ws, size_t ws_size, hipStream_t stream) {
    static int grid_blocks = 0;
    if (grid_blocks == 0) {
        if (ws_size < WS_END) { fprintf(stderr, "kernel_launch: workspace too small (%zu < %zu)\n", ws_size, (size_t)WS_END); grid_blocks = -1; return; }
        int dev = 0, cus = 0, per_cu = 0;
        (void)hipGetDevice(&dev);
        (void)hipDeviceGetAttribute(&cus, hipDeviceAttributeMultiprocessorCount, dev);
        if (hipFuncSetAttribute((const void*)mega_fwd, hipFuncAttributeMaxDynamicSharedMemorySize, LDS_BYTES) != hipSuccess) { fprintf(stderr, "kernel_launch: hipFuncSetAttribute failed\n"); grid_blocks = -1; return; }
        if (hipOccupancyMaxActiveBlocksPerMultiprocessor(&per_cu, (const void*)mega_fwd, 512, LDS_BYTES) != hipSuccess || per_cu < 1) { fprintf(stderr, "kernel_launch: occupancy query says %d blocks/CU\n", per_cu); per_cu = 1; }
        (void)hipGetLastError();
        grid_blocks = cus;
    }
    if (grid_blocks < 0) return;
    Params p{};
    p.x_prompt = (const float*)d_in[0]; p.x_sample = (const float*)d_in[1];
    p.cache_a_k = (const float*)d_in[2]; p.cache_a_v = (const float*)d_in[3]; p.cache_b_k = (const float*)d_in[4]; p.cache_b_v = (const float*)d_in[5];
    p.c_prompt = (const float*)d_in[6]; p.c_sample = (const float*)d_in[7];
    p.w_ada = (const float*)d_in[8]; p.b_ada = (const float*)d_in[9]; p.ln_g = (const float*)d_in[10]; p.ln_b = (const float*)d_in[11];
    p.w_qkv_a = (const float*)d_in[12]; p.w_o_a = (const float*)d_in[13]; p.rel_bias_a = (const float*)d_in[14];
    p.w_qkv_b = (const float*)d_in[15]; p.w_o_b = (const float*)d_in[16]; p.sink_b = (const float*)d_in[17];
    p.w_up = (const float*)d_in[18]; p.w_down = (const float*)d_in[19];
    p.out = (float*)d_out; p.ws = (unsigned char*)d_ws;
    if (hipMemsetAsync((char*)d_ws + WS_BAR, 0, 16384, stream) != hipSuccess) { fprintf(stderr, "kernel_launch: hipMemsetAsync of the barrier words failed\n"); return; }
    void* args[] = {&p};
    hipError_t e = hipLaunchCooperativeKernel((const void*)mega_fwd, dim3(grid_blocks), dim3(512), args, LDS_BYTES, stream);
    if (e != hipSuccess) fprintf(stderr, "cooperative launch failed: %s (grid %d)\n", hipGetErrorString(e), grid_blocks);
}
```

```cpp
#include <hip/hip_runtime.h>
#include <hip/hip_cooperative_groups.h>
#include <cstdio>
namespace cg = cooperative_groups;

#define LAS __attribute__((address_space(3)))
#ifndef PROBE_MASK
#define PROBE_MASK 0
#endif
#define PB_BEGIN(bit) do { if (PROBE_MASK & (bit)) pb_t0 = __builtin_amdgcn_s_memrealtime(); } while (0)
#define PB_END(bit)   do { if (PROBE_MASK & (bit)) pb_acc += __builtin_amdgcn_s_memrealtime() - pb_t0; } while (0)
typedef unsigned short bf16_t;
typedef short bf16x8 __attribute__((ext_vector_type(8)));
typedef short bf16x4 __attribute__((ext_vector_type(4)));
typedef float f32x4 __attribute__((ext_vector_type(4)));
typedef unsigned u32x4 __attribute__((ext_vector_type(4)));
typedef unsigned u32x2 __attribute__((ext_vector_type(2)));
typedef float f32x2 __attribute__((ext_vector_type(2)));

constexpr int DM = 2048;
constexpr int NP = 32768;
constexpr int NREAL = 32896;
constexpr int MP = 33024;
constexpr float ALPHA = 1.41421356237309515f;
constexpr float LOG2E = 1.44269504088896341f;

constexpr size_t WS_WQKVA = 0;
constexpr size_t WS_WOA   = WS_WQKVA + (size_t)6144 * 2048 * 2;
constexpr size_t WS_WQKVB = WS_WOA + (size_t)2048 * 2048 * 2;
constexpr size_t WS_WOB   = WS_WQKVB + (size_t)3072 * 2048 * 2;
constexpr size_t WS_WUP   = WS_WOB + (size_t)2048 * 2048 * 2;
constexpr size_t WS_WDN   = WS_WUP + (size_t)2 * 8192 * 2048 * 2;
constexpr size_t WS_BIG   = WS_WDN + (size_t)2 * 8192 * 2048 * 2;
constexpr size_t WS_H     = WS_BIG + (size_t)MP * 8192 * 2;
constexpr size_t WS_KEA   = WS_H + (size_t)MP * 2048 * 2;
constexpr size_t WS_VEA   = WS_KEA + (size_t)8 * 576 * 2048 * 2;
constexpr size_t WS_KEB   = WS_VEA + (size_t)8 * 576 * 2048 * 2;
constexpr size_t WS_VEB   = WS_KEB + (size_t)8 * 192 * 512 * 2;
constexpr size_t WS_MOD   = WS_VEB + (size_t)8 * 192 * 512 * 2;
constexpr size_t WS_ROPE  = WS_MOD + (size_t)4 * 16 * 6144 * 4;
constexpr size_t WS_STATS = WS_ROPE + (size_t)4112 * 16 * 4;
constexpr size_t WS_Z     = WS_STATS + (size_t)NREAL * 2 * 4;
constexpr size_t WS_BAR   = WS_Z + (size_t)NREAL * 2048 * 2;
constexpr size_t WS_END   = WS_BAR + 16384;

constexpr size_t O_Y    = 0;
constexpr size_t O_AKP  = (size_t)NREAL * 2048;
constexpr size_t O_AVP  = O_AKP + (size_t)8 * 512 * 2048;
constexpr size_t O_BKP  = O_AVP + (size_t)8 * 512 * 2048;
constexpr size_t O_BVP  = O_BKP + (size_t)8 * 128 * 512;
constexpr size_t O_AKS  = O_BVP + (size_t)8 * 128 * 512;
constexpr size_t O_AVS  = O_AKS + (size_t)128 * 2048;
constexpr size_t O_BKS  = O_AVS + (size_t)128 * 2048;
constexpr size_t O_BVS  = O_BKS + (size_t)128 * 512;

struct Params {
    const float* x_prompt; const float* x_sample;
    const float* cache_a_k; const float* cache_a_v; const float* cache_b_k; const float* cache_b_v;
    const float* c_prompt; const float* c_sample;
    const float* w_ada; const float* b_ada; const float* ln_g; const float* ln_b;
    const float* w_qkv_a; const float* w_o_a; const float* rel_bias_a;
    const float* w_qkv_b; const float* w_o_b; const float* sink_b;
    const float* w_up; const float* w_down;
    float* out; unsigned char* ws;
};

typedef const __attribute__((address_space(4))) struct Params* KParamPtr;
__device__ __forceinline__ Params load_params() {
#if defined(__HIP_DEVICE_COMPILE__)
    auto k = __builtin_amdgcn_kernarg_segment_ptr();
    asm volatile("" : "+s"(k));
    return *(KParamPtr)k;
#else
    return Params{};
#endif
}
__device__ __forceinline__ int opaque_tid(int wv) { unsigned z = 0u; asm volatile("" : "+v"(z));
    return (wv << 6) | (int)__builtin_amdgcn_mbcnt_hi(~0u, __builtin_amdgcn_mbcnt_lo(~0u, z)); }
__device__ __forceinline__ float shx(float v, int mask, int lane) { return __int_as_float(__builtin_amdgcn_ds_bpermute((lane ^ mask) << 2, __float_as_int(v))); }
template <int CTRL> __device__ __forceinline__ float dppf(float v) { return __int_as_float(__builtin_amdgcn_update_dpp(0, __float_as_int(v), CTRL, 0xf, 0xf, true)); }
__device__ __forceinline__ float xmax16(float v) { const auto r = __builtin_amdgcn_permlane16_swap(__float_as_uint(v), __float_as_uint(v), false, false); return fmaxf(__uint_as_float(r[0]), __uint_as_float(r[1])); }
__device__ __forceinline__ float xmax32(float v) { const auto r = __builtin_amdgcn_permlane32_swap(__float_as_uint(v), __float_as_uint(v), false, false); return fmaxf(__uint_as_float(r[0]), __uint_as_float(r[1])); }
__device__ __forceinline__ float xsum16(float v) { const auto r = __builtin_amdgcn_permlane16_swap(__float_as_uint(v), __float_as_uint(v), false, false); return __uint_as_float(r[0]) + __uint_as_float(r[1]); }
__device__ __forceinline__ float xsum32(float v) { const auto r = __builtin_amdgcn_permlane32_swap(__float_as_uint(v), __float_as_uint(v), false, false); return __uint_as_float(r[0]) + __uint_as_float(r[1]); }
__device__ __forceinline__ float xchg16(float v, bool odd_row) { const auto r = __builtin_amdgcn_permlane16_swap(__float_as_uint(v), __float_as_uint(v), false, false); return __uint_as_float(odd_row ? r[0] : r[1]); }
__device__ __forceinline__ float xchg32(float v, bool upper) { const auto r = __builtin_amdgcn_permlane32_swap(__float_as_uint(v), __float_as_uint(v), false, false); return __uint_as_float(upper ? r[0] : r[1]); }
__device__ __forceinline__ float wave_sum(float v) {
    v += dppf<0xB1>(v); v += dppf<0x4E>(v); v += dppf<0x141>(v); v += dppf<0x140>(v); v = xsum16(v); return xsum32(v); }
__device__ __forceinline__ float a_fma(float a, float b, float c) { float d; asm("v_fma_f32 %0, %1, %2, %3" : "=v"(d) : "v"(a), "s"(b), "v"(c)); return d; }
__device__ __forceinline__ float a_exp2(float a) { float d; asm("v_exp_f32 %0, %1" : "=v"(d) : "v"(a)); return d; }
__device__ __forceinline__ float a_add(float a, float b) { float d; asm("v_add_f32 %0, %1, %2" : "=v"(d) : "v"(a), "v"(b)); return d; }
__device__ __forceinline__ float a_sub(float a, float b) { float d; asm("v_sub_f32 %0, %1, %2" : "=v"(d) : "v"(a), "v"(b)); return d; }
__device__ __forceinline__ float bf_lo(unsigned w) { return __uint_as_float(w << 16); }
__device__ __forceinline__ float bf_hi(unsigned w) { return __uint_as_float(w & 0xffff0000u); }
__device__ __forceinline__ unsigned pk2(float lo, float hi) { unsigned r; asm("v_cvt_pk_bf16_f32 %0, %1, %2" : "=v"(r) : "v"(lo), "v"(hi)); return r; }

namespace pg8 {
constexpr int BM = 256, BK = 64, HALF = 128, HTB = HALF * BK * 2, STAGE_BYTES = 8 * HTB, NXCD = 8, WGM = 4;
__device__ __forceinline__ int lds_byte(int r, int c) { const int st = (r >> 4) * 2 + (c >> 5), rr = r & 15, cc = c & 31, ob = rr * 64 + cc * 2; return st * 1024 + (ob ^ (((ob >> 9) & 1) << 5)); }
__device__ __forceinline__ void stage_rc(int b, int& R, int& C) { const int st = b / 1024, sb = b % 1024, swz = sb ^ (((sb >> 9) & 1) << 5); R = (st >> 1) * 16 + swz / 64; C = (st & 1) * 32 + (swz % 64) / 2; }
__device__ __forceinline__ int perm32(int rho) { const int n = rho >> 4, i = rho & 15; return 8 * (i >> 2) + 4 * n + (i & 3); }
struct Unit { int pm, pn; };
struct Gemm { const bf16_t* A; const bf16_t* Bt; int M, N, K; };
struct StaticOrder {
    int nM, nN, nwg, G, c;
    __device__ void init(int M, int N, int G_, int c_) { nM = M / BM; nN = N / BM; nwg = nM * nN; G = G_; c = c_; }
    __device__ bool next(int i, Unit& u) const {
        const long L = (long)i * G + c; if (L >= nwg) return false;
        int wgid = (int)L; { const int q = nwg / NXCD, r = nwg % NXCD, xcd = wgid % NXCD, off = wgid / NXCD; wgid = (xcd < r ? xcd * (q + 1) : r * (q + 1) + (xcd - r) * q) + off; }
        const int nig = WGM * nN, gid = wgid / nig, fm = gid * WGM, gsz = (nM - fm) < WGM ? (nM - fm) : WGM;
        u.pm = fm + ((wgid % nig) % gsz); u.pn = (wgid % nig) / gsz; return true;
    }
};

template <class Epi>
__device__ __forceinline__ void gemm_phase(LAS unsigned char* lds, const Gemm g, const StaticOrder& S, const Epi& E, int wv) {
    const int tid = opaque_tid(wv), wid = __builtin_amdgcn_readfirstlane(tid >> 6), lane = tid & 63, wr = wid >> 2, wc = wid & 3, fr = lane & 15, fq = lane >> 4;
    const int K = g.K, nt = K / BK;
    unsigned voffA[2], voffB[2];
#pragma unroll
    for (int i = 0; i < 2; ++i) { int R, C; stage_rc(tid * 16 + i * 8192, R, C); const int Rb = Epi::PERM ? ((R & ~31) + perm32(R & 31)) : R;
        voffA[i] = (unsigned)(R * K + C) * 2u; voffB[i] = (unsigned)(Rb * K + C) * 2u; }
    const size_t kstep = (size_t)(BK * 2);
    const size_t hstep = (size_t)HALF * K * 2;
    const size_t tstep = 2 * hstep;
    const unsigned ldsw = (unsigned)wid * 1024u;
    const int aoff = lds_byte(wr * 64 + fr, fq * 8), boff = lds_byte(wc * 32 + fr, fq * 8);
#define PG8_SA(b, h) (((b) * 2 + (h)) * HTB)
#define PG8_SB(b, h) ((4 + (b) * 2 + (h)) * HTB)
#define PG8_STAGE(bufoff, gbase, voff) do { _Pragma("unroll") for (int _i = 0; _i < 2; ++_i) \
        __builtin_amdgcn_global_load_lds((const unsigned*)((const char*)(gbase) + (voff)[_i]), (LAS unsigned*)(lds + (bufoff) + ldsw + _i * 8192), 16, 0, 0); } while (0)
#define PG8_LDA(dst, b, h) do { _Pragma("unroll") for (int m = 0; m < 4; ++m) _Pragma("unroll") for (int k = 0; k < 2; ++k) dst[m][k] = *(const LAS bf16x8*)(lds + PG8_SA(b, h) + aoff + m * 2048 + k * 1024); } while (0)
#define PG8_LDB(dst, b, h) do { _Pragma("unroll") for (int n = 0; n < 2; ++n) _Pragma("unroll") for (int k = 0; k < 2; ++k) dst[n][k] = *(const LAS bf16x8*)(lds + PG8_SB(b, h) + boff + n * 2048 + k * 1024); } while (0)
#define PG8_MMA(ai, bj, At, Bt) do { __builtin_amdgcn_s_setprio(1); _Pragma("unroll") for (int m = 0; m < 4; ++m) _Pragma("unroll") for (int n = 0; n < 2; ++n) _Pragma("unroll") for (int k = 0; k < 2; ++k) \
        acc[ai][bj][m][n] = __builtin_amdgcn_mfma_f32_16x16x32_bf16(Bt[n][k], At[m][k], acc[ai][bj][m][n], 0, 0, 0); __builtin_amdgcn_s_setprio(0); } while (0)
#define PG8_WAIT_V(n) asm volatile("s_waitcnt vmcnt(" #n ")" ::: "memory")
#define PG8_WAIT_L(n) asm volatile("s_waitcnt lgkmcnt(" #n ")" ::: "memory")
#define PG8_BAR __builtin_amdgcn_s_barrier()
#define PG8_SCHED __builtin_amdgcn_sched_barrier(0)
    Unit cur, nxt; int ui = 0;
    if (!S.next(0, cur)) return;
    f32x4 acc[2][2][4][2];
#pragma unroll
    for (int a = 0; a < 2; ++a)
#pragma unroll
        for (int b = 0; b < 2; ++b)
#pragma unroll
            for (int m = 0; m < 4; ++m)
#pragma unroll
                for (int n = 0; n < 2; ++n) acc[a][b][m][n] = (f32x4){0.f, 0.f, 0.f, 0.f};
    bf16x8 At[4][2], B0[2][2], B1[2][2];
    const char* cA = (const char*)g.A + (size_t)cur.pm * tstep; const char* cB = (const char*)g.Bt + (size_t)cur.pn * tstep;
    PG8_STAGE(PG8_SB(0, 0), cB, voffB); PG8_STAGE(PG8_SA(0, 0), cA, voffA); PG8_STAGE(PG8_SB(0, 1), cB + hstep, voffB); PG8_STAGE(PG8_SA(0, 1), cA + hstep, voffA);
    if (wr == 1) PG8_BAR;
    PG8_WAIT_V(4); PG8_BAR;
    PG8_STAGE(PG8_SB(1, 0), cB + kstep, voffB); PG8_STAGE(PG8_SA(1, 0), cA + kstep, voffA); PG8_STAGE(PG8_SB(1, 1), cB + hstep + kstep, voffB);
    PG8_WAIT_V(6); PG8_BAR;
    for (;;) {
        const bool has_next = S.next(ui + 1, nxt);
        const char* nA = has_next ? (const char*)g.A + (size_t)nxt.pm * tstep : cA; const char* nB = has_next ? (const char*)g.Bt + (size_t)nxt.pn * tstep : cB;
        for (int t = 0; t < nt; t += 2) {
            const bool last = (t == nt - 2);
            const char* a1 = cA + (size_t)(t + 1) * kstep;
            const char* a2 = last ? nA : cA + (size_t)(t + 2) * kstep; const char* b2 = last ? nB : cB + (size_t)(t + 2) * kstep;
            const char* a3 = a2 + kstep; const char* b3 = b2 + kstep;
            PG8_LDB(B0, 0, 0); PG8_SCHED; PG8_LDA(At, 0, 0); PG8_STAGE(PG8_SA(1, 1), a1 + hstep, voffA);
            PG8_WAIT_L(8); PG8_BAR; PG8_WAIT_L(0); PG8_MMA(0, 0, At, B0); PG8_BAR; PG8_SCHED;
            PG8_LDB(B1, 0, 1); PG8_STAGE(PG8_SB(0, 0), b2, voffB);
            PG8_BAR; PG8_WAIT_L(0); PG8_MMA(0, 1, At, B1); PG8_BAR;
            PG8_LDA(At, 0, 1); PG8_STAGE(PG8_SA(0, 0), a2, voffA);
            PG8_BAR; PG8_WAIT_L(0); PG8_MMA(1, 0, At, B0); PG8_BAR; PG8_SCHED;
            PG8_STAGE(PG8_SB(0, 1), b2 + hstep, voffB);
            PG8_WAIT_V(6); PG8_BAR; PG8_MMA(1, 1, At, B1); PG8_BAR;
            PG8_LDB(B0, 1, 0); PG8_SCHED; PG8_LDA(At, 1, 0); PG8_STAGE(PG8_SA(0, 1), a2 + hstep, voffA);
            PG8_WAIT_L(8); PG8_BAR; PG8_WAIT_L(0); PG8_MMA(0, 0, At, B0); PG8_BAR; PG8_SCHED;
            PG8_LDB(B1, 1, 1); PG8_STAGE(PG8_SB(1, 0), b3, voffB);
            PG8_BAR; PG8_WAIT_L(0); PG8_MMA(0, 1, At, B1); PG8_BAR;
            PG8_LDA(At, 1, 1); PG8_STAGE(PG8_SA(1, 0), a3, voffA);
            PG8_BAR; PG8_WAIT_L(0); PG8_MMA(1, 0, At, B0); PG8_BAR; PG8_SCHED;
            PG8_STAGE(PG8_SB(1, 1), b3 + hstep, voffB);
            PG8_WAIT_V(6); PG8_BAR; PG8_MMA(1, 1, At, B1); PG8_BAR;
        }
        E(acc, cur, wr, wc, fr, fq);
        if (!has_next) break;
#pragma unroll
        for (int a = 0; a < 2; ++a)
#pragma unroll
            for (int b = 0; b < 2; ++b)
#pragma unroll
                for (int m = 0; m < 4; ++m)
#pragma unroll
                    for (int n = 0; n < 2; ++n) acc[a][b][m][n] = (f32x4){0.f, 0.f, 0.f, 0.f};
        cur = nxt; cA = nA; cB = nB; ++ui;
    }
    PG8_WAIT_V(0);
    if (wr == 0) PG8_BAR;
    PG8_BAR;
#undef PG8_SA
#undef PG8_SB
#undef PG8_STAGE
#undef PG8_LDA
#undef PG8_LDB
#undef PG8_MMA
#undef PG8_WAIT_V
#undef PG8_WAIT_L
#undef PG8_BAR
#undef PG8_SCHED
}
}
using pg8::Unit;

struct EpiQkvA {
    static constexpr bool PERM = true;
    unsigned char* ws; float* out;
    __device__ __forceinline__ void operator()(const f32x4 (&acc)[2][2][4][2], const Unit& u, int wr, int wc, int fr, int fq) const {
        const int which = u.pn >> 3, colt = (u.pn & 7) * 256;
        const int row0 = u.pm * 256 + wr * 64 + fr, col0 = colt + wc * 32 + 8 * fq;
        bf16_t* base = (bf16_t*)(ws + WS_BIG) + (size_t)which * MP * 2048;
        bf16_t* ext = (bf16_t*)(ws + (which == 1 ? WS_KEA : WS_VEA));
        float* oP = out + (which == 1 ? O_AKP : O_AVP);
        float* oS = out + (which == 1 ? O_AKS : O_AVS);
        constexpr bool prompt = true; const bool cache_tile = ((u.pm & 15) >= 14) && which > 0;
#pragma unroll
        for (int ai = 0; ai < 2; ++ai)
#pragma unroll
            for (int m = 0; m < 4; ++m) {
                const int row = row0 + ai * 128 + m * 16;
#pragma unroll
                for (int bj = 0; bj < 2; ++bj) {
                    const f32x4 v0 = acc[ai][bj][m][0], v1 = acc[ai][bj][m][1];
                    const int col = col0 + bj * 128;
                    u32x4 pk; pk[0] = pk2(v0[0], v0[1]); pk[1] = pk2(v0[2], v0[3]); pk[2] = pk2(v1[0], v1[1]); pk[3] = pk2(v1[2], v1[3]);
                    if (prompt || which == 0) *(u32x4*)(base + (size_t)row * 2048 + col) = pk;
                    if (cache_tile) { const int b = row >> 12, t = (row & 4095) - 3584; float* o = oP + ((size_t)(b * 512 + t)) * 2048 + col; *(f32x4*)o = v0; *(f32x4*)(o + 4) = v1; }
                    if (!prompt && which > 0 && row < NREAL) { const int sr = row - NP, b = sr >> 4, t = sr & 15;
                        *(u32x4*)(ext + ((size_t)(b * 576 + 512 + t)) * 2048 + col) = pk;
                        float* o = oS + (size_t)sr * 2048 + col; *(f32x4*)o = v0; *(f32x4*)(o + 4) = v1; }
                }
            }
    }
};

struct EpiQkvB {
    static constexpr bool PERM = true;
    unsigned char* ws; float* out;
    __device__ __forceinline__ void operator()(const f32x4 (&acc)[2][2][4][2], const Unit& u, int wr, int wc, int fr, int fq) const {
        const float* rope = (const float*)(ws + WS_ROPE);
        const int which = u.pn < 8 ? 0 : (u.pn < 10 ? 1 : 2);
        const int colt = which == 0 ? u.pn * 256 : (which == 1 ? (u.pn - 8) * 256 : (u.pn - 10) * 256);
        const int ld = which == 0 ? 2048 : 512;
        const int row0 = u.pm * 256 + wr * 64 + fr, col0 = colt + wc * 32 + 8 * fq;
        bf16_t* base = (bf16_t*)(ws + WS_BIG) + (which == 0 ? (size_t)0 : (which == 1 ? (size_t)MP * 2048 : (size_t)MP * 2048 + (size_t)MP * 512));
        bf16_t* ext = (bf16_t*)(ws + (which == 1 ? WS_KEB : WS_VEB));
        float* oP = out + (which == 1 ? O_BKP : O_BVP);
        float* oS = out + (which == 1 ? O_BKS : O_BVS);
        constexpr bool prompt = true; const bool last_tile = ((u.pm & 15) == 15) && which > 0;
        const bool do_rope = (which < 2) && ((wc & 1) == 0);
#pragma unroll
        for (int ai = 0; ai < 2; ++ai) {
            f32x4 rc[4][4];
            if (do_rope) {
#pragma unroll
                for (int m = 0; m < 4; ++m) { const int row = row0 + ai * 128 + m * 16; const float* rp = rope + (size_t)(row & 4095) * 16;
#pragma unroll
                    for (int q = 0; q < 4; ++q) rc[m][q] = *(const f32x4*)(rp + q * 4); } }
#pragma unroll
            for (int m = 0; m < 4; ++m) {
                const int row = row0 + ai * 128 + m * 16;
#pragma unroll
                for (int bj = 0; bj < 2; ++bj) {
                    f32x4 v0 = acc[ai][bj][m][0], v1 = acc[ai][bj][m][1];
                    if (do_rope) {
                        f32x4 p0, p1;
#pragma unroll
                        for (int j = 0; j < 4; ++j) { p0[j] = xchg16(v0[j], (fq & 1) != 0); p1[j] = xchg16(v1[j], (fq & 1) != 0); }
                        if (fq == 0) { v0 = v0 * rc[m][0] - p0 * rc[m][2]; v1 = v1 * rc[m][1] - p1 * rc[m][3]; }
                        else if (fq == 1) { v0 = v0 * rc[m][0] + p0 * rc[m][2]; v1 = v1 * rc[m][1] + p1 * rc[m][3]; }
                    }
                    const int col = col0 + bj * 128;
                    u32x4 pk; pk[0] = pk2(v0[0], v0[1]); pk[1] = pk2(v0[2], v0[3]); pk[2] = pk2(v1[0], v1[1]); pk[3] = pk2(v1[2], v1[3]);
                    *(u32x4*)(base + (size_t)row * ld + col) = pk;
                    if (last_tile && ai == 1) { const int b = row >> 12, t = (row & 4095) - 3968; float* o = oP + ((size_t)(b * 128 + t)) * 512 + col; *(f32x4*)o = v0; *(f32x4*)(o + 4) = v1; }
                }
            }
        }
    }
};

struct EpiUp {
    static constexpr bool PERM = true;
    bf16_t* U;
    __device__ __forceinline__ void operator()(const f32x4 (&acc)[2][2][4][2], const Unit& u, int wr, int wc, int fr, int fq) const {
        const int row0 = u.pm * 256 + wr * 64 + fr, col0 = u.pn * 256 + wc * 32 + 8 * fq;
#pragma unroll
        for (int ai = 0; ai < 2; ++ai)
#pragma unroll
            for (int m = 0; m < 4; ++m) {
                bf16_t* rowp = U + (size_t)(row0 + ai * 128 + m * 16) * 8192 + col0;
#pragma unroll
                for (int bj = 0; bj < 2; ++bj) {
                    f32x4 v0 = acc[ai][bj][m][0], v1 = acc[ai][bj][m][1];
#pragma unroll
                    for (int j = 0; j < 4; ++j) { const float a = fmaxf(v0[j], 0.f), b = fmaxf(v1[j], 0.f); v0[j] = a * a; v1[j] = b * b; }
                    u32x4 pk; pk[0] = pk2(v0[0], v0[1]); pk[1] = pk2(v0[2], v0[3]); pk[2] = pk2(v1[0], v1[1]); pk[3] = pk2(v1[2], v1[3]);
                    *(u32x4*)(rowp + bj * 128) = pk;
                }
            }
    }
};

template <bool HASX>
struct EpiRes {
    static constexpr bool PERM = true;
    const float* xin; bf16_t* Z; const float* gate  ; const float* stats; const float* lng; const float* lnb;
    __device__ __forceinline__ void operator()(const f32x4 (&acc)[2][2][4][2], const Unit& u, int wr, int wc, int fr, int fq) const {
        const int row0 = u.pm * 256 + wr * 64 + fr, col0 = u.pn * 256 + wc * 32 + 8 * fq;
        const float* gr = gate + (size_t)(u.pm >> 4) * 6144 + col0;
        f32x4 gv[2][2], gw[2][2], bw[2][2];
#pragma unroll
        for (int bj = 0; bj < 2; ++bj)
#pragma unroll
            for (int n = 0; n < 2; ++n) { gv[bj][n] = *(const f32x4*)(gr + bj * 128 + n * 4);
                if (!HASX) { gw[bj][n] = *(const f32x4*)(lng + col0 + bj * 128 + n * 4); bw[bj][n] = *(const f32x4*)(lnb + col0 + bj * 128 + n * 4); } }
#pragma unroll
        for (int ai = 0; ai < 2; ++ai) {
            u32x4 zz[4][2]; f32x2 st[4]; f32x4 xx[4][2][2];
#pragma unroll
            for (int m = 0; m < 4; ++m) { const int row = row0 + ai * 128 + m * 16;
                if (HASX) {
#pragma unroll
                    for (int bj = 0; bj < 2; ++bj) { const float* xr = xin + (size_t)row * 2048 + col0 + bj * 128; xx[m][bj][0] = *(const f32x4*)xr; xx[m][bj][1] = *(const f32x4*)(xr + 4); }
                } else { st[m] = *(const f32x2*)(stats + (size_t)row * 2);
#pragma unroll
                    for (int bj = 0; bj < 2; ++bj) zz[m][bj] = *(const u32x4*)(Z + (size_t)row * 2048 + col0 + bj * 128); } }
#pragma unroll
            for (int m = 0; m < 4; ++m) { const int row = row0 + ai * 128 + m * 16;
                bf16_t* zr = Z + (size_t)row * 2048 + col0;
#pragma unroll
                for (int bj = 0; bj < 2; ++bj) {
                    f32x4 x0, x1;
                    if (HASX) { x0 = xx[m][bj][0]; x1 = xx[m][bj][1]; }
                    else { const u32x4 q = zz[m][bj];
                        x0[0] = bf_lo(q[0]); x0[1] = bf_hi(q[0]); x0[2] = bf_lo(q[1]); x0[3] = bf_hi(q[1]); x1[0] = bf_lo(q[2]); x1[1] = bf_hi(q[2]); x1[2] = bf_lo(q[3]); x1[3] = bf_hi(q[3]);
                        x0 = (x0 - st[m][0]) * st[m][1] * gw[bj][0] + bw[bj][0]; x1 = (x1 - st[m][0]) * st[m][1] * gw[bj][1] + bw[bj][1]; }
                    const f32x4 z0 = x0 * ALPHA + gv[bj][0] * acc[ai][bj][m][0], z1 = x1 * ALPHA + gv[bj][1] * acc[ai][bj][m][1];
                    u32x4 pk; pk[0] = pk2(z0[0], z0[1]); pk[1] = pk2(z0[2], z0[3]); pk[2] = pk2(z1[0], z1[1]); pk[3] = pk2(z1[2], z1[3]);
                    *(u32x4*)(zr + bj * 128) = pk;
                }
            }
        }
    }
};

template <class SEpi>
__device__ __forceinline__ void skinny_gemm(LAS unsigned char* lds, const bf16_t* A, int lda, const bf16_t* Wt, int N, int K, const SEpi& E, int wv) {
    const int tid = opaque_tid(wv), wid = tid >> 6, lane = tid & 63, g = lane >> 4, l15 = lane & 15;
    const int kw = K >> 3;
    const bf16_t* ap = A + (size_t)l15 * lda + wid * kw + g * 8;
    LAS f32x4* red = (LAS f32x4*)lds;
    for (int tile = blockIdx.x; tile < (N >> 4); tile += gridDim.x) {
        const int n0 = tile * 16;
        const bf16_t* bp = Wt + (size_t)(n0 + l15) * K + wid * kw + g * 8;
        f32x4 acc[8];
#pragma unroll
        for (int rt = 0; rt < 8; ++rt) acc[rt] = (f32x4){0.f, 0.f, 0.f, 0.f};
        for (int k0 = 0; k0 < kw; k0 += 64) {
            bf16x8 b[2], a[2][8];
#pragma unroll
            for (int i = 0; i < 2; ++i) { b[i] = *(const bf16x8*)(bp + k0 + i * 32);
#pragma unroll
                for (int rt = 0; rt < 8; ++rt) a[i][rt] = *(const bf16x8*)(ap + (size_t)rt * 16 * lda + k0 + i * 32); }
            __builtin_amdgcn_sched_barrier(0);
#pragma unroll
            for (int i = 0; i < 2; ++i)
#pragma unroll
                for (int rt = 0; rt < 8; ++rt) acc[rt] = __builtin_amdgcn_mfma_f32_16x16x32_bf16(b[i], a[i][rt], acc[rt], 0, 0, 0);
            __builtin_amdgcn_sched_barrier(0);
        }
        __syncthreads();
#pragma unroll
        for (int rt = 0; rt < 8; ++rt) red[(wid * 8 + rt) * 64 + lane] = acc[rt];
        __syncthreads();
        f32x4 s = red[wid * 64 + lane];
#pragma unroll
        for (int wv = 1; wv < 8; ++wv) s += red[(wv * 8 + wid) * 64 + lane];
        E(s, wid * 16 + l15, n0, g);
    }
}
struct SEpiQkvA {
    unsigned char* ws; float* out;
    __device__ __forceinline__ void operator()(f32x4 v, int r, int n0, int g) const {
        const int which = n0 >> 11, col = (n0 & 2047) + g * 4;
        u32x2 pk; pk[0] = pk2(v[0], v[1]); pk[1] = pk2(v[2], v[3]);
        if (which == 0) { *(u32x2*)((bf16_t*)(ws + WS_BIG) + (size_t)(NP + r) * 2048 + col) = pk; return; }
        const int b = r >> 4, t = r & 15;
        *(u32x2*)((bf16_t*)(ws + (which == 1 ? WS_KEA : WS_VEA)) + ((size_t)(b * 576 + 512 + t)) * 2048 + col) = pk;
        *(f32x4*)(out + (which == 1 ? O_AKS : O_AVS) + (size_t)r * 2048 + col) = v;
    }
};
struct SEpiQkvB {
    unsigned char* ws; float* out;
    __device__ __forceinline__ void operator()(f32x4 v, int r, int n0, int g) const {
        const int which = n0 < 2048 ? 0 : (n0 < 2560 ? 1 : 2);
        if (which < 2 && (n0 & 63) == 0) {
            const float* rp = (const float*)(ws + WS_ROPE) + (size_t)(4096 + (r & 15)) * 16 + (g & 1) * 4;
            const f32x4 cs = *(const f32x4*)rp, sn = *(const f32x4*)(rp + 8);
            f32x4 pr;
#pragma unroll
            for (int j = 0; j < 4; ++j) pr[j] = xchg32(v[j], g >= 2);
            v = g < 2 ? v * cs - pr * sn : v * cs + pr * sn;
        }
        u32x2 pk; pk[0] = pk2(v[0], v[1]); pk[1] = pk2(v[2], v[3]);
        if (which == 0) { *(u32x2*)((bf16_t*)(ws + WS_BIG) + (size_t)(NP + r) * 2048 + n0 + g * 4) = pk; return; }
        const int col = n0 - (which == 1 ? 2048 : 2560) + g * 4, b = r >> 4, t = r & 15;
        *(u32x2*)((bf16_t*)(ws + (which == 1 ? WS_KEB : WS_VEB)) + ((size_t)(b * 192 + 128 + t)) * 512 + col) = pk;
        *(f32x4*)(out + (which == 1 ? O_BKS : O_BVS) + (size_t)r * 512 + col) = v;
    }
};
struct SEpiUp {
    bf16_t* U;
    __device__ __forceinline__ void operator()(f32x4 v, int r, int n0, int g) const {
#pragma unroll
        for (int j = 0; j < 4; ++j) { const float a = fmaxf(v[j], 0.f); v[j] = a * a; }
        u32x2 pk; pk[0] = pk2(v[0], v[1]); pk[1] = pk2(v[2], v[3]);
        *(u32x2*)(U + (size_t)(NP + r) * 8192 + n0 + g * 4) = pk;
    }
};
struct SEpiRes {
    const float* xin; bf16_t* Z; const float* gate; const float* stats; const float* lng; const float* lnb;
    __device__ __forceinline__ void operator()(f32x4 v, int r, int n0, int g) const {
        const int col = n0 + g * 4;
        f32x4 xv; const f32x4 gv = *(const f32x4*)(gate + (size_t)(8 + (r >> 4)) * 6144 + col);
        if (xin) xv = *(const f32x4*)(xin + (size_t)r * 2048 + col);
        else { const u32x2 zz = *(const u32x2*)(Z + (size_t)r * 2048 + col); const f32x2 st = *(const f32x2*)(stats + (size_t)r * 2);
            xv[0] = bf_lo(zz[0]); xv[1] = bf_hi(zz[0]); xv[2] = bf_lo(zz[1]); xv[3] = bf_hi(zz[1]);
            xv = (xv - st[0]) * st[1] * *(const f32x4*)(lng + col) + *(const f32x4*)(lnb + col); }
        const f32x4 z = xv * ALPHA + gv * v;
        u32x2 pk; pk[0] = pk2(z[0], z[1]); pk[1] = pk2(z[2], z[3]);
        *(u32x2*)(Z + (size_t)r * 2048 + col) = pk;
    }
};

__device__ __forceinline__ void ada_item(const Params& p, int item, LAS float* lds, int wv) {
    const int tid = opaque_tid(wv), wid = tid >> 6, lane = tid & 63;
    const int combo = item / 24, cb = item % 24, col0 = cb * 256;
    const float* W = p.w_ada + (size_t)combo * 2048 * 6144;
    __syncthreads();
    for (int i0 = 0; i0 < 64; i0 += 16) {
        float c[16];
#pragma unroll
        for (int q = 0; q < 16; ++q) { const int idx = tid + 512 * (i0 + q), r = idx >> 11, k = idx & 2047;
            c[q] = r < 8 ? p.c_prompt[r * 2048 + k] : p.c_sample[(r - 8) * 2048 + k]; }
#pragma unroll
        for (int q = 0; q < 16; ++q) { const int idx = tid + 512 * (i0 + q), r = idx >> 11, k = idx & 2047;
            lds[k * 16 + r] = c[q] / (1.f + __expf(-c[q])); }
    }
    __syncthreads();
    f32x4 acc[16];
#pragma unroll
    for (int r = 0; r < 16; ++r) acc[r] = (f32x4){0.f, 0.f, 0.f, 0.f};
    const float* wp = W + (size_t)(wid * 256) * 6144 + col0 + lane * 4;
    for (int kk = 0; kk < 256; kk += 16) {
        f32x4 w[16];
#pragma unroll
        for (int q = 0; q < 16; ++q) w[q] = *(const f32x4*)(wp + (size_t)(kk + q) * 6144);
        __builtin_amdgcn_sched_barrier(0);
#pragma unroll
        for (int q = 0; q < 16; ++q) {
            const LAS f32x4* sp = (const LAS f32x4*)(lds + (wid * 256 + kk + q) * 16);
#pragma unroll
            for (int r4 = 0; r4 < 4; ++r4) { const f32x4 s = sp[r4];
#pragma unroll
                for (int j = 0; j < 4; ++j) acc[r4 * 4 + j] += w[q] * s[j]; }
        }
    }
    __syncthreads();
#pragma unroll
    for (int r = 0; r < 16; ++r) *(LAS f32x4*)(lds + (wid * 16 + r) * 256 + lane * 4) = acc[r];
    __syncthreads();
    float* mod = (float*)(p.ws + WS_MOD);
#pragma unroll
    for (int i = 0; i < 8; ++i) { const int idx = tid + 512 * i, r = idx >> 8, c = idx & 255; float s = 0.f;
#pragma unroll
        for (int w = 0; w < 8; ++w) s += lds[(w * 16 + r) * 256 + c];
        mod[((size_t)combo * 16 + r) * 6144 + col0 + c] = s + p.b_ada[combo * 6144 + col0 + c]; }
}

struct TTile { const float* src; bf16_t* dst; int K, N; };
__device__ __forceinline__ TTile ttile_of(const Params& p, int it) {
    constexpr int T0 = 768, T1 = T0 + 256, T2 = T1 + 384, T3 = T2 + 256, T4 = T3 + 2048;
    const float* src; bf16_t* dst; int K, N, tl;
    if (it < T0)      { src = p.w_qkv_a; dst = (bf16_t*)(p.ws + WS_WQKVA); K = 2048; N = 6144; tl = it; }
    else if (it < T1) { src = p.w_o_a;   dst = (bf16_t*)(p.ws + WS_WOA);   K = 2048; N = 2048; tl = it - T0; }
    else if (it < T2) { src = p.w_qkv_b; dst = (bf16_t*)(p.ws + WS_WQKVB); K = 2048; N = 3072; tl = it - T1; }
    else if (it < T3) { src = p.w_o_b;   dst = (bf16_t*)(p.ws + WS_WOB);   K = 2048; N = 2048; tl = it - T2; }
    else if (it < T4) { const int l = (it - T3) >> 10; src = p.w_up + (size_t)l * 2048 * 8192; dst = (bf16_t*)(p.ws + WS_WUP) + (size_t)l * 2048 * 8192; K = 2048; N = 8192; tl = (it - T3) & 1023; }
    else              { const int l = (it - T4) >> 10; src = p.w_down + (size_t)l * 2048 * 8192; dst = (bf16_t*)(p.ws + WS_WDN) + (size_t)l * 2048 * 8192; K = 8192; N = 2048; tl = (it - T4) & 1023; }
    const int ntn = N >> 7, tk = tl / ntn, tn = tl % ntn;
    TTile r; r.src = src + (size_t)tk * 128 * N + tn * 128; r.dst = dst + (size_t)tn * 128 * K + tk * 128; r.K = K; r.N = N; return r;
}
__device__ __forceinline__ int my_ttile(int j) {
    constexpr int NT = 5760;
    const int nb = gridDim.x, blk = blockIdx.x;
    int idx;
    if (nb == 256) { if (blk >= 96) idx = j < 12 ? j * 160 + (blk - 96) : 1920 + (j - 12) * 256 + blk; else idx = 1920 + j * 256 + blk; }
    else idx = j * nb + blk;
    return idx < NT ? idx : -1;
}
__device__ __forceinline__ void transpose_stream(const Params& p, LAS unsigned* lds, int wv) {
    const int t = opaque_tid(wv), c4 = t & 31, rp = t >> 5;
    f32x4 a[4], b[4];
    int j = 0, it = my_ttile(0), itl = it;
    if (it < 0) return;
    TTile cur = ttile_of(p, it), ld = cur;
#define T_LOAD() do { _Pragma("unroll") for (int ps = 0; ps < 4; ++ps) { const int r = 2 * (rp + 16 * ps); \
        a[ps] = *(const f32x4*)(ld.src + (size_t)r * ld.N + c4 * 4); b[ps] = *(const f32x4*)(ld.src + (size_t)(r + 1) * ld.N + c4 * 4); } } while (0)
#define T_WRITE(buf) do { _Pragma("unroll") for (int ps = 0; ps < 4; ++ps) { const int kp = rp + 16 * ps; \
        _Pragma("unroll") for (int jj = 0; jj < 4; ++jj) { const int n = c4 * 4 + jj; lds[(buf) * 8192 + n * 64 + (kp ^ (((n >> 2) & 7) << 2))] = pk2(a[ps][jj], b[ps][jj]); } } } while (0)
    __syncthreads();
    T_LOAD(); T_WRITE(0);
    int jl = 1; itl = my_ttile(1); if (itl >= 0) { ld = ttile_of(p, itl); T_LOAD(); }
    int bsel = 0;
    for (;;) {
        __syncthreads();
        TTile nxt = ld; const int itn = itl;
        if (itl >= 0) { T_WRITE(bsel ^ 1); ++jl; itl = my_ttile(jl); if (itl >= 0) { ld = ttile_of(p, itl); T_LOAD(); } }
#pragma unroll
        for (int i = 0; i < 4; ++i) { const int n = (t >> 4) + 32 * i, ch = t & 15;
            const u32x4 v = *(const LAS u32x4*)(lds + bsel * 8192 + n * 64 + ((4 * ch) ^ (((n >> 2) & 7) << 2)));
            *(u32x4*)(cur.dst + (size_t)n * cur.K + ch * 8) = v; }
        if (itn < 0) break;
        cur = nxt; bsel ^= 1; ++j;
    }
#undef T_LOAD
#undef T_WRITE
}

__device__ __forceinline__ void phase0(const Params& p, LAS unsigned char* lds, int wv) {
    const int tid = opaque_tid(wv);
    for (int it = blockIdx.x; it < 96; it += gridDim.x) ada_item(p, it, (LAS float*)lds, wv);
    transpose_stream(p, (LAS unsigned*)lds, wv);
    const size_t gtid = (size_t)blockIdx.x * 512 + tid, gstride = (size_t)gridDim.x * 512;
    {
        bf16_t* KE = (bf16_t*)(p.ws + WS_KEA); bf16_t* VE = (bf16_t*)(p.ws + WS_VEA);
        for (size_t i0 = gtid; i0 < (size_t)8 * 576 * 512; i0 += 2 * gstride) {
            f32x4 a[2], c[2]; bool ok[2], ld[2];
#pragma unroll
            for (int q = 0; q < 2; ++q) { const size_t i = i0 + q * gstride; ok[q] = i < (size_t)8 * 576 * 512; const int c4 = (int)(i & 511); const int r = (int)((i >> 9) % 576), b = (int)((i >> 9) / 576);
                ld[q] = ok[q] && r < 512; if (ld[q]) { const size_t sidx = ((size_t)(b * 512 + r)) * 2048 + c4 * 4; a[q] = *(const f32x4*)(p.cache_a_k + sidx); c[q] = *(const f32x4*)(p.cache_a_v + sidx); } }
#pragma unroll
            for (int q = 0; q < 2; ++q) { const size_t i = i0 + q * gstride; if (ok[q]) { u32x2 k = {0u, 0u}, v = {0u, 0u};
                if (ld[q]) { k[0] = pk2(a[q][0], a[q][1]); k[1] = pk2(a[q][2], a[q][3]); v[0] = pk2(c[q][0], c[q][1]); v[1] = pk2(c[q][2], c[q][3]); }
                *(u32x2*)(KE + i * 4) = k; *(u32x2*)(VE + i * 4) = v; } }
        }
    }
    {
        bf16_t* KE = (bf16_t*)(p.ws + WS_KEB); bf16_t* VE = (bf16_t*)(p.ws + WS_VEB);
        for (size_t i = gtid; i < (size_t)8 * 192 * 128; i += gstride) { const int c4 = (int)(i & 127); const int r = (int)((i >> 7) % 192), b = (int)((i >> 7) / 192);
            u32x2 k = {0u, 0u}, v = {0u, 0u};
            if (r < 128) { const size_t s = ((size_t)(b * 128 + r)) * 512 + c4 * 4; const f32x4 a = *(const f32x4*)(p.cache_b_k + s), c = *(const f32x4*)(p.cache_b_v + s);
                k[0] = pk2(a[0], a[1]); k[1] = pk2(a[2], a[3]); v[0] = pk2(c[0], c[1]); v[1] = pk2(c[2], c[3]); }
            *(u32x2*)(KE + i * 4) = k; *(u32x2*)(VE + i * 4) = v; }
    }
    {
        float* rope = (float*)(p.ws + WS_ROPE);
        for (size_t i = gtid; i < (size_t)4112 * 8; i += gstride) { const int f = (int)(i & 7), pi = (int)(i >> 3); const int pos = pi < 4096 ? pi : 1024 + (pi - 4096);
            const double fr = f == 0 ? 1.0 : f == 1 ? 0.19392274474868576 : f == 2 ? 0.03760603093086393 : f == 3 ? 0.007292664737217109 : f == 4 ? 0.001414213562373095 : f == 5 ? 0.0002742481756762073 : f == 6 ? 5.318295896944988e-05 : 1.031338537721246e-05;
            double rev = (double)pos * fr * 0.15915494309189535; rev -= __builtin_rint(rev);
            const float rf = (float)rev;
            rope[(size_t)pi * 16 + f] = __builtin_amdgcn_cosf(rf); rope[(size_t)pi * 16 + 8 + f] = __builtin_amdgcn_sinf(rf); }
    }
}

__device__ __forceinline__ void modulate0(const Params& p, int wv) {
    const float* mod = (const float*)(p.ws + WS_MOD); bf16_t* H = (bf16_t*)(p.ws + WS_H);
    const size_t gtid = (size_t)blockIdx.x * 512 + opaque_tid(wv), gstride = (size_t)gridDim.x * 512, n = (size_t)NREAL * 512;
    for (size_t i0 = gtid; i0 < n; i0 += 4 * gstride) {
        f32x4 x[4], sh[4], sc[4];
#pragma unroll
        for (int q = 0; q < 4; ++q) { const size_t i = i0 + q * gstride; if (i < n) { const int row = (int)(i >> 9), c = (int)(i & 511) * 4;
            const float* xr = row < NP ? p.x_prompt + (size_t)row * 2048 : p.x_sample + (size_t)(row - NP) * 2048;
            const int r16 = row < NP ? (row >> 12) : 8 + ((row - NP) >> 4);
            x[q] = *(const f32x4*)(xr + c); sh[q] = *(const f32x4*)(mod + (size_t)r16 * 6144 + c); sc[q] = *(const f32x4*)(mod + (size_t)r16 * 6144 + 2048 + c); } }
#pragma unroll
        for (int q = 0; q < 4; ++q) { const size_t i = i0 + q * gstride; if (i < n) { const int row = (int)(i >> 9), c = (int)(i & 511) * 4;
            const f32x4 h = x[q] * (sc[q] + 1.f) + sh[q];
            u32x2 o; o[0] = pk2(h[0], h[1]); o[1] = pk2(h[2], h[3]);
            *(u32x2*)(H + (size_t)row * 2048 + c) = o; } }
    }
}

#define LN_UNPACK(v, raw) do { _Pragma("unroll") for (int i = 0; i < 4; ++i) { v[2 * i][0] = bf_lo(raw[i][0]); v[2 * i][1] = bf_hi(raw[i][0]); v[2 * i][2] = bf_lo(raw[i][1]); v[2 * i][3] = bf_hi(raw[i][1]); \
        v[2 * i + 1][0] = bf_lo(raw[i][2]); v[2 * i + 1][1] = bf_hi(raw[i][2]); v[2 * i + 1][2] = bf_lo(raw[i][3]); v[2 * i + 1][3] = bf_hi(raw[i][3]); } } while (0)
#define LN_STATS(v, mu, rstd) float mu, rstd; do { float s_ = 0.f; \
        _Pragma("unroll") for (int i = 0; i < 8; ++i) s_ += (v[i][0] + v[i][1]) + (v[i][2] + v[i][3]); \
        s_ = wave_sum(s_); \
        mu = s_ * (1.f / 2048.f); float q_ = 0.f; \
        _Pragma("unroll") for (int i = 0; i < 8; ++i) { v[i] = v[i] - mu; q_ += (v[i][0] * v[i][0] + v[i][1] * v[i][1]) + (v[i][2] * v[i][2] + v[i][3] * v[i][3]); } \
        q_ = wave_sum(q_); \
        rstd = __builtin_amdgcn_rsqf(q_ * (1.f / 2048.f) + 1e-5f); } while (0)
__device__ __forceinline__ void ln_rows_generic(const Params& p, const float* g, const float* bta, const float* mod_next, int row_begin, int row_end, int wv) {
    float* Y = p.out; bf16_t* H = (bf16_t*)(p.ws + WS_H); const bf16_t* Z = (const bf16_t*)(p.ws + WS_Z); float* ST = (float*)(p.ws + WS_STATS);
    const int tid = opaque_tid(wv), wid = tid >> 6, lane = tid & 63;
    for (int row = row_begin + blockIdx.x * 8 + wid; row < row_end; row += gridDim.x * 8) {
        u32x4 raw[4];
#pragma unroll
        for (int i = 0; i < 4; ++i) raw[i] = *(const u32x4*)(Z + (size_t)row * 2048 + i * 512 + lane * 8);
        f32x4 v[8]; LN_UNPACK(v, raw);
        LN_STATS(v, mu, rstd);
        const int r16 = row < NP ? (row >> 12) : 8 + ((row - NP) >> 4);
        if (mod_next && lane == 0) { f32x2 st; st[0] = mu; st[1] = rstd; *(f32x2*)(ST + (size_t)row * 2) = st; }
        f32x4 pg[8], pb[8], psh[8], psc[8];
#pragma unroll
        for (int i = 0; i < 8; ++i) { const int c = (i >> 1) * 512 + lane * 8 + (i & 1) * 4; pg[i] = *(const f32x4*)(g + c); pb[i] = *(const f32x4*)(bta + c);
            if (mod_next) { const float* mp = mod_next + (size_t)r16 * 6144 + c; psh[i] = *(const f32x4*)mp; psc[i] = *(const f32x4*)(mp + 2048); } }
#pragma unroll
        for (int i = 0; i < 4; ++i) { const int c = i * 512 + lane * 8;
            f32x4 y0 = v[2 * i] * rstd * pg[2 * i] + pb[2 * i], y1 = v[2 * i + 1] * rstd * pg[2 * i + 1] + pb[2 * i + 1];
            if (!mod_next) { *(f32x4*)(Y + (size_t)row * 2048 + c) = y0; *(f32x4*)(Y + (size_t)row * 2048 + c + 4) = y1; }
            else { y0 = y0 * (psc[2 * i] + 1.f) + psh[2 * i]; y1 = y1 * (psc[2 * i + 1] + 1.f) + psh[2 * i + 1];
                u32x4 o; o[0] = pk2(y0[0], y0[1]); o[1] = pk2(y0[2], y0[3]); o[2] = pk2(y1[0], y1[1]); o[3] = pk2(y1[2], y1[3]);
                *(u32x4*)(H + (size_t)row * 2048 + c) = o; } }
    }
}
template <bool MOD>
__device__ __forceinline__ void ln_rows_prompt(const Params& p, const float* g, const float* bta, const float* mod_next, int wv) {
    float* Y = p.out; bf16_t* H = (bf16_t*)(p.ws + WS_H); const bf16_t* Z = (const bf16_t*)(p.ws + WS_Z); float* ST = (float*)(p.ws + WS_STATS);
    const int tid = opaque_tid(wv), wid = tid >> 6, lane = tid & 63;
    const int rpw = NP / (gridDim.x * 8);
    const int row0 = (blockIdx.x * 8 + wid) * rpw, r16 = row0 >> 12, rend = row0 + rpw;
    f32x4 G[8], B[8];
#pragma unroll
    for (int i = 0; i < 8; ++i) { const int c = (i >> 1) * 512 + lane * 8 + (i & 1) * 4; G[i] = *(const f32x4*)(g + c); B[i] = *(const f32x4*)(bta + c);
        if (MOD) { const f32x4 sh = *(const f32x4*)(mod_next + (size_t)r16 * 6144 + c), sc = *(const f32x4*)(mod_next + (size_t)r16 * 6144 + 2048 + c);
            G[i] = G[i] * (sc + 1.f); B[i] = B[i] * (sc + 1.f) + sh; } }
    u32x4 ra[4], rb[4], rc[4];
#define LN_LOAD(raw, row) do { if ((row) < rend) { const bf16_t* _z = Z + (size_t)(row) * 2048 + lane * 8; _Pragma("unroll") for (int i = 0; i < 4; ++i) raw[i] = *(const u32x4*)(_z + i * 512); } } while (0)
#define LN_PROC(raw, row) do { if ((row) < rend) { f32x4 v[8]; LN_UNPACK(v, raw); LN_STATS(v, mu, rstd); \
        if (MOD && lane == 0) { f32x2 st; st[0] = mu; st[1] = rstd; *(f32x2*)(ST + (size_t)(row) * 2) = st; } \
        _Pragma("unroll") for (int i = 0; i < 4; ++i) { const f32x4 h0 = v[2 * i] * rstd * G[2 * i] + B[2 * i], h1 = v[2 * i + 1] * rstd * G[2 * i + 1] + B[2 * i + 1]; \
            if (!MOD) { float* _y = Y + (size_t)(row) * 2048 + i * 512 + lane * 8; *(f32x4*)_y = h0; *(f32x4*)(_y + 4) = h1; } \
            else { u32x4 o; o[0] = pk2(h0[0], h0[1]); o[1] = pk2(h0[2], h0[3]); o[2] = pk2(h1[0], h1[1]); o[3] = pk2(h1[2], h1[3]); *(u32x4*)(H + (size_t)(row) * 2048 + i * 512 + lane * 8) = o; } } } } while (0)
    LN_LOAD(ra, row0); LN_LOAD(rb, row0 + 1);
    for (int r = row0; r < rend; r += 3) {
        LN_LOAD(rc, r + 2);
        LN_PROC(ra, r);
        LN_LOAD(ra, r + 3);
        LN_PROC(rb, r + 1);
        LN_LOAD(rb, r + 4);
        LN_PROC(rc, r + 2);
    }
#undef LN_LOAD
#undef LN_PROC
}
__device__ __forceinline__ void ln_phase(const Params& p, const float* g, const float* bta, const float* mod_next, int wv) {
    const bool fast = (NP % (gridDim.x * 16) == 0) && (4096 % (NP / (gridDim.x * 8)) == 0);
    if (fast) { if (mod_next) ln_rows_prompt<true>(p, g, bta, mod_next, wv); else ln_rows_prompt<false>(p, g, bta, mod_next, wv); }
    ln_rows_generic(p, g, bta, mod_next, fast ? NP : 0, NREAL, wv);
}

template <int D, int KS, bool BIAS>
__device__ __forceinline__ void attn_qk(const LAS unsigned char* Kl, const bf16x8 (&qf)[2][D / 32], float (&m)[2], float (&l)[2], bf16x8 (&pf)[2][2], float (&alpha)[2],
                                        float sc2, int jbase, int jhi, int qi, const LAS float* btab, int lane) {
    const int g = lane >> 4, l15 = lane & 15;
    f32x4 s[2][4];
    const LAS unsigned char* kp = Kl + l15 * KS + g * 16;
    bf16x8 kf[2][D / 32];
#pragma unroll
    for (int ks = 0; ks < D / 32; ++ks) kf[0][ks] = *(const LAS bf16x8*)(kp + ks * 64);
#pragma unroll
    for (int sub = 0; sub < 4; ++sub) { s[0][sub] = (f32x4){0.f, 0.f, 0.f, 0.f}; s[1][sub] = s[0][sub];
        if (sub + 1 < 4) {
#pragma unroll
            for (int ks = 0; ks < D / 32; ++ks) kf[(sub + 1) & 1][ks] = *(const LAS bf16x8*)(kp + (sub + 1) * 16 * KS + ks * 64);
        }
#pragma unroll
        for (int ks = 0; ks < D / 32; ++ks) {
            s[0][sub] = __builtin_amdgcn_mfma_f32_16x16x32_bf16(kf[sub & 1][ks], qf[0][ks], s[0][sub], 0, 0, 0);
            s[1][sub] = __builtin_amdgcn_mfma_f32_16x16x32_bf16(kf[sub & 1][ks], qf[1][ks], s[1][sub], 0, 0, 0); }
        __builtin_amdgcn_sched_barrier(0); }
    const bool far = BIAS && (jbase + 63 + 128 <= 512);
    const bool part = jbase + 64 > jhi;
    const float bfar = BIAS ? btab[0] : 0.f;
    const LAS float* brow = BIAS ? btab + (64 + jbase - qi + 4 * g) : btab;
    if (part) {
#pragma unroll
        for (int u = 0; u < 2; ++u)
#pragma unroll
            for (int sub = 0; sub < 4; ++sub)
#pragma unroll
                for (int j = 0; j < 4; ++j) if (jbase + sub * 16 + g * 4 + j >= jhi) s[u][sub][j] = -3e38f;
    }
#pragma unroll
    for (int u = 0; u < 2; ++u) {
        float mn, ls = 0.f;
        if (!BIAS || far) {
            float mx = -3e38f;
#pragma unroll
            for (int sub = 0; sub < 4; ++sub)
#pragma unroll
                for (int j = 0; j < 4; ++j) mx = fmaxf(mx, s[u][sub][j]);
            mx = xmax32(xmax16(mx));
            mn = fmaxf(m[u], __builtin_fmaf(mx, sc2, bfar)); alpha[u] = __builtin_amdgcn_exp2f(m[u] - mn); m[u] = mn;
            const float c = bfar - mn;
#pragma unroll
            for (int sub = 0; sub < 4; ++sub)
#pragma unroll
                for (int j = 0; j < 4; ++j) { const float pv = a_exp2(a_fma(s[u][sub][j], sc2, c)); s[u][sub][j] = pv; ls = a_add(ls, pv); }
        } else {
            float mx = -1e30f;
#pragma unroll
            for (int sub = 0; sub < 4; ++sub)
#pragma unroll
                for (int j = 0; j < 4; ++j) { float v = __builtin_fmaf(s[u][sub][j], sc2, brow[sub * 16 + 16 - 16 * u + j]);
                    s[u][sub][j] = v; mx = fmaxf(mx, v); }
            mx = xmax32(xmax16(mx));
            mn = fmaxf(m[u], mx); alpha[u] = __builtin_amdgcn_exp2f(m[u] - mn); m[u] = mn;
#pragma unroll
            for (int sub = 0; sub < 4; ++sub)
#pragma unroll
                for (int j = 0; j < 4; ++j) { const float pv = a_exp2(a_sub(s[u][sub][j], mn)); s[u][sub][j] = pv; ls = a_add(ls, pv); }
        }
        l[u] = l[u] * alpha[u] + ls;
#pragma unroll
        for (int t = 0; t < 2; ++t) { u32x4 w; w[0] = pk2(s[u][2 * t][0], s[u][2 * t][1]); w[1] = pk2(s[u][2 * t][2], s[u][2 * t][3]); w[2] = pk2(s[u][2 * t + 1][0], s[u][2 * t + 1][1]); w[3] = pk2(s[u][2 * t + 1][2], s[u][2 * t + 1][3]);
            pf[u][t] = __builtin_bit_cast(bf16x8, w); }
    }
}
template <int D, int VS>
__device__ __forceinline__ void attn_pv(const LAS unsigned char* Vl, f32x4 (&o)[2][D / 16], const bf16x8 (&pf)[2][2], const float (&alpha)[2], int lane) {
    const int g = lane >> 4, q4 = (lane >> 2) & 3, p4 = lane & 3;
    const LAS unsigned char* vb = Vl + (g * 4 + q4) * VS + p4 * 8;
    if (__builtin_amdgcn_ballot_w64(alpha[0] != 1.f || alpha[1] != 1.f) != 0ull) {
#pragma unroll
        for (int ds = 0; ds < D / 16; ++ds) { o[0][ds] = o[0][ds] * alpha[0]; o[1][ds] = o[1][ds] * alpha[1]; }
    }
    bf16x8 vf[2][2];
#define PV_READ(buf, ds_) do { _Pragma("unroll") for (int t = 0; t < 2; ++t) { \
        const bf16x4 a1 = __builtin_amdgcn_ds_read_tr16_b64_v4i16((LAS bf16x4*)(vb + (t * 32) * VS + (ds_) * 32)); \
        const bf16x4 a2 = __builtin_amdgcn_ds_read_tr16_b64_v4i16((LAS bf16x4*)(vb + (t * 32 + 16) * VS + (ds_) * 32)); \
        vf[buf][t] = __builtin_shufflevector(a1, a2, 0, 1, 2, 3, 4, 5, 6, 7); } } while (0)
    PV_READ(0, 0);
#pragma unroll
    for (int ds = 0; ds < D / 16; ++ds) {
        if (ds + 1 < D / 16) PV_READ((ds + 1) & 1, ds + 1);
#pragma unroll
        for (int t = 0; t < 2; ++t) {
            o[0][ds] = __builtin_amdgcn_mfma_f32_16x16x32_bf16(vf[ds & 1][t], pf[0][t], o[0][ds], 0, 0, 0);
            o[1][ds] = __builtin_amdgcn_mfma_f32_16x16x32_bf16(vf[ds & 1][t], pf[1][t], o[1][ds], 0, 0, 0); }
        __builtin_amdgcn_sched_barrier(0);
    }
#undef PV_READ
}

struct AUnit { const bf16_t* kb; const bf16_t* vb; long qrow0; int hq, jt0, jhi, qvalid; };
__device__ __forceinline__ AUnit attn_a_unit(const Params& p, int u) {
    AUnit r; const bf16_t* Q = (const bf16_t*)(p.ws + WS_BIG); const bf16_t* Kg = Q + (size_t)MP * 2048; const bf16_t* Vg = Kg + (size_t)MP * 2048;
    if (u >= 1792 && u < 1824) { const int su = u - 1792, b = su >> 2; r.hq = su & 3; r.qrow0 = NP + b * 16; r.kb = (const bf16_t*)(p.ws + WS_KEA) + (size_t)b * 576 * 2048; r.vb = (const bf16_t*)(p.ws + WS_VEA) + (size_t)b * 576 * 2048; r.jt0 = 0; r.jhi = 528; r.qvalid = 16; return r; }
    int c, v;
    if (u < 1792) { v = u; c = 8 + (u >> 5); } else { v = u - 1824; c = 7 - (v >> 5); }
    const int b = (v >> 2) & 7; r.hq = v & 3; r.qrow0 = (long)b * 4096 + c * 64; r.kb = Kg + (r.qrow0 - 512) * 2048; r.vb = Vg + (r.qrow0 - 512) * 2048; r.jt0 = c < 8 ? 8 - c : 0; r.jhi = 576; r.qvalid = 64;
    return r;
}
__device__ __forceinline__ void attn_a_phase(const Params& p, LAS unsigned char* lds, int wv) {
    constexpr int KS = 1056, VS = 1056, NU = 2080;
    const int tid = opaque_tid(wv), wid = tid >> 6, lane = tid & 63, g = lane >> 4, l15 = lane & 15, hh = wid >> 1, rg = wid & 1;
    LAS unsigned char* Kl = lds; LAS unsigned char* Vl = lds + 64 * KS; LAS float* btab = (LAS float*)(lds + 64 * KS + 64 * VS);
    const bf16_t* Q = (const bf16_t*)(p.ws + WS_BIG);
    bf16_t* O = (bf16_t*)(p.ws + WS_H);
    const float sc2 = 0.08838834764831845f * LOG2E;
    const int skey = tid >> 6, sch = tid & 63;
    u32x4 kr[8], vr[8];
    int unit = blockIdx.x;
    if (unit >= NU) return;
    AUnit cu = attn_a_unit(p, unit);
    const unsigned voff = (unsigned)(skey * 2048 + sch * 8) * 2u;
    { const size_t ub = ((size_t)cu.jt0 * 64 * 2048 + cu.hq * 512) * 2;
#pragma unroll
      for (int i = 0; i < 8; ++i) { kr[i] = *(const u32x4*)((const char*)cu.kb + ub + (size_t)i * 32768 + voff); vr[i] = *(const u32x4*)((const char*)cu.vb + ub + (size_t)i * 32768 + voff); } }
    for (;;) {
        const int nunit = unit + gridDim.x; const bool has_next = nunit < NU;
        AUnit nu = cu; if (has_next) nu = attn_a_unit(p, nunit);
        const int h = cu.hq * 4 + hh;
        __syncthreads();
        int tid2 = tid; asm volatile("" : "+v"(tid2));
        float tb[6];
#pragma unroll
        for (int k = 0; k < 6; ++k) { int i = tid2 + 512 * k; i = i < 4 * 656 ? i : 4 * 656 - 1; const int h2 = i / 656, x = i - h2 * 656, r = x - 80; const int ti = r <= 384 ? 256 : 640 - r;
            tb[k] = p.rel_bias_a[(cu.hq * 4 + h2) * 257 + ti]; }
#pragma unroll
        for (int k = 0; k < 6; ++k) { const int i = tid2 + 512 * k;
            if (i < 4 * 656) { const int h2 = i / 656, x = i - h2 * 656; btab[h2 * 672 + x] = tb[k] * LOG2E; } }
        bf16x8 qf[2][4];
        { const int l15b = tid2 & 15, gb = (tid2 >> 4) & 3;
          const bf16_t* qp = Q + (size_t)(cu.qrow0 + rg * 32 + l15b) * 2048 + h * 128 + gb * 8;
#pragma unroll
          for (int u = 0; u < 2; ++u)
#pragma unroll
            for (int ks = 0; ks < 4; ++ks) qf[u][ks] = *(const bf16x8*)(qp + (size_t)u * 16 * 2048 + ks * 32); }
        f32x4 o[2][8];
#pragma unroll
        for (int u = 0; u < 2; ++u)
#pragma unroll
            for (int i = 0; i < 8; ++i) o[u][i] = (f32x4){0.f, 0.f, 0.f, 0.f};
        float m[2] = {-1e30f, -1e30f}, l[2] = {0.f, 0.f};
        for (int jt = cu.jt0; jt < 9; ++jt) {
            __syncthreads();
#pragma unroll
            for (int i = 0; i < 8; ++i) { *(LAS u32x4*)(Kl + (skey + 8 * i) * KS + sch * 16) = kr[i]; *(LAS u32x4*)(Vl + (skey + 8 * i) * VS + sch * 16) = vr[i]; }
            __syncthreads();
            const bool more = jt + 1 < 9;
            const size_t nub = ((size_t)(more ? jt + 1 : nu.jt0) * 64 * 2048 + (more ? cu.hq : nu.hq) * 512) * 2;
            const char* nkb = (const char*)(more ? cu.kb : nu.kb) + nub; const char* nvb = (const char*)(more ? cu.vb : nu.vb) + nub;
            if (more || has_next) {
#pragma unroll
                for (int i = 0; i < 8; ++i) kr[i] = *(const u32x4*)(nkb + (size_t)i * 32768 + voff);
            }
            bf16x8 pf[2][2]; float alpha[2];
            attn_qk<128, KS, true>(Kl + hh * 256, qf, m, l, pf, alpha, sc2, jt * 64, cu.jhi, rg * 32 + l15, btab + hh * 672, lane);
            __builtin_amdgcn_sched_barrier(0);
            if (more || has_next) {
#pragma unroll
                for (int i = 0; i < 8; ++i) vr[i] = *(const u32x4*)(nvb + (size_t)i * 32768 + voff);
            }
            __builtin_amdgcn_sched_barrier(0);
            attn_pv<128, VS>(Vl + hh * 256, o, pf, alpha, lane);
        }
#pragma unroll
        for (int u = 0; u < 2; ++u) {
            float lt = l[u]; lt = xsum32(xsum16(lt));
            const float inv = 1.f / lt;
            int tid3 = tid; asm volatile("" : "+v"(tid3)); const int l15c = tid3 & 15, gc = (tid3 >> 4) & 3;
            if (rg * 32 + u * 16 + l15c < cu.qvalid) { bf16_t* op = O + (size_t)(cu.qrow0 + rg * 32 + u * 16 + l15c) * 2048 + h * 128 + gc * 4;
#pragma unroll
                for (int ds = 0; ds < 8; ++ds) { u32x2 w; w[0] = pk2(o[u][ds][0] * inv, o[u][ds][1] * inv); w[1] = pk2(o[u][ds][2] * inv, o[u][ds][3] * inv); *(u32x2*)(op + ds * 16) = w; } }
        }
        if (!has_next) break;
        cu = nu; unit = nunit;
    }
}

struct BUnit { const bf16_t* kb; const bf16_t* vb; long qrow0; int kvh, jt0, jhi, qvalid; };
__device__ __forceinline__ BUnit attn_b_unit(const Params& p, int u) {
    BUnit r; const bf16_t* Q = (const bf16_t*)(p.ws + WS_BIG); const bf16_t* Kg = Q + (size_t)MP * 2048; const bf16_t* Vg = Kg + (size_t)MP * 512;
    if (u >= 3968 && u < 4032) { const int su = u - 3968, b = su >> 3; r.kvh = su & 7; r.qrow0 = NP + b * 16; r.kb = (const bf16_t*)(p.ws + WS_KEB) + (size_t)b * 192 * 512; r.vb = (const bf16_t*)(p.ws + WS_VEB) + (size_t)b * 192 * 512; r.jt0 = 0; r.jhi = 144; r.qvalid = 16; return r; }
    int c, v;
    if (u < 3968) { v = u; c = 2 + (u >> 6); } else { v = u - 4032; c = 1 - (v >> 6); }
    const int b = (v >> 3) & 7; r.kvh = v & 7; r.qrow0 = (long)b * 4096 + c * 64; r.kb = Kg + (r.qrow0 - 128) * 512; r.vb = Vg + (r.qrow0 - 128) * 512; r.jt0 = c < 2 ? 2 - c : 0; r.jhi = 192; r.qvalid = 64;
    return r;
}
__device__ __forceinline__ void attn_b_phase(const Params& p, LAS unsigned char* lds, unsigned long long& pb_acc, int wv) {
    unsigned long long pb_t0 = 0; (void)pb_t0;
    constexpr int KS = 160, VS = 160, NU = 4160;
    const int tid = opaque_tid(wv), wid = tid >> 6, lane = tid & 63, g = lane >> 4, l15 = lane & 15;
    LAS unsigned char* Kl = lds; LAS unsigned char* Vl = lds + 192 * KS;
    const bf16_t* Q = (const bf16_t*)(p.ws + WS_BIG);
    bf16_t* O = (bf16_t*)(p.ws + WS_H);
    const float sc2 = 0.125f * LOG2E;
    const int qloc = (wid & 1) * 32 + l15;
    u32x4 kr[3], vr[3];
    bf16x8 qf[2][2], qn[2][2]; float sink_c = 0.f, sink_n = 0.f;
    int unit = blockIdx.x;
    if (unit >= NU) return;
    BUnit cu = attn_b_unit(p, unit);
#define B_LOAD(u_, q_, sk_) do { _Pragma("unroll") for (int i = 0; i < 3; ++i) { const int ci = tid + 512 * i, key = ci >> 3, ch = ci & 7; \
            if (key >= (u_).jt0 * 64) { const size_t off = (size_t)key * 512 + (u_).kvh * 64 + ch * 8; kr[i] = *(const u32x4*)((u_).kb + off); vr[i] = *(const u32x4*)((u_).vb + off); } } \
        { const bf16_t* qp = Q + (size_t)((u_).qrow0 + qloc) * 2048 + ((u_).kvh * 4 + (wid >> 1)) * 64 + g * 8; \
          _Pragma("unroll") for (int u = 0; u < 2; ++u) { q_[u][0] = *(const bf16x8*)(qp + (size_t)u * 16 * 2048); q_[u][1] = *(const bf16x8*)(qp + (size_t)u * 16 * 2048 + 32); } } \
        sk_ = p.sink_b[(u_).kvh * 4 + (wid >> 1)]; } while (0)
    B_LOAD(cu, qf, sink_c);
    for (;;) {
        const int nunit = unit + gridDim.x; const bool has_next = nunit < NU;
        BUnit nu = cu; if (has_next) nu = attn_b_unit(p, nunit);
        PB_BEGIN(512);
        __syncthreads();
#pragma unroll
        for (int i = 0; i < 3; ++i) { const int ci = tid + 512 * i, key = ci >> 3, ch = ci & 7;
            if (key >= cu.jt0 * 64) { *(LAS u32x4*)(Kl + key * KS + ch * 16) = kr[i]; *(LAS u32x4*)(Vl + key * VS + ch * 16) = vr[i]; } }
        __syncthreads();
        PB_END(512);
        if (has_next) B_LOAD(nu, qn, sink_n);
        const int h = cu.kvh * 4 + (wid >> 1);
        const float sink2 = sink_c * LOG2E;
        f32x4 o[2][4];
#pragma unroll
        for (int u = 0; u < 2; ++u)
#pragma unroll
            for (int i = 0; i < 4; ++i) o[u][i] = (f32x4){0.f, 0.f, 0.f, 0.f};
        float m[2] = {sink2, sink2}, l[2]; l[0] = l[1] = (g == 0) ? 1.f : 0.f;
        PB_BEGIN(1024);
        for (int jt = cu.jt0; jt < 3; ++jt) { bf16x8 pf[2][2]; float alpha[2];
            attn_qk<64, KS, false>(Kl + jt * 64 * KS, qf, m, l, pf, alpha, sc2, jt * 64, cu.jhi, qloc, nullptr, lane);
            attn_pv<64, VS>(Vl + jt * 64 * VS, o, pf, alpha, lane); }
        PB_END(1024);
#pragma unroll
        for (int u = 0; u < 2; ++u) {
            float lt = l[u]; lt = xsum32(xsum16(lt));
            const float inv = 1.f / lt;
            if (qloc + 16 * u < cu.qvalid) { bf16_t* op = O + (size_t)(cu.qrow0 + qloc + 16 * u) * 2048 + h * 64 + g * 4;
#pragma unroll
                for (int ds = 0; ds < 4; ++ds) { u32x2 w; w[0] = pk2(o[u][ds][0] * inv, o[u][ds][1] * inv); w[1] = pk2(o[u][ds][2] * inv, o[u][ds][3] * inv); *(u32x2*)(op + ds * 16) = w; } }
        }
        if (!has_next) break;
#pragma unroll
        for (int u = 0; u < 2; ++u) { qf[u][0] = qn[u][0]; qf[u][1] = qn[u][1]; }
        sink_c = sink_n;
        cu = nu; unit = nunit;
    }
#undef B_LOAD
}

#define XB_TMO      128
#define XB_XCNT(j)  (256  + 64 * (j))
#define XB_XSUB(j)  (1280 + 64 * (j))
#define XB_XGEN(j)  (2304 + 64 * (j))
#define XB_TOP      3328
#define XB_TOPGEN   3392
#define XCD_BAR_WORDS 3456
#define XB_SPIN_CAP (1u << 18)
__device__ __forceinline__ unsigned xb_ld(unsigned* p)              { return __hip_atomic_load(p, __ATOMIC_RELAXED, __HIP_MEMORY_SCOPE_AGENT); }
__device__ __forceinline__ unsigned xb_add(unsigned* p, unsigned v) { return __hip_atomic_fetch_add(p, v, __ATOMIC_RELAXED, __HIP_MEMORY_SCOPE_AGENT); }
__device__ __forceinline__ unsigned xb_xcc_id() { return (unsigned)__builtin_amdgcn_s_getreg((3 << 11) | 20) & 0xFu; }
#define XB_SPIN(cond, bar) do { unsigned _sp = 0; while (cond) { __builtin_amdgcn_s_sleep(1); \
    if ((++_sp & 255u) == 0u) { if (xb_ld(&(bar)[XB_TMO])) break; if (_sp > XB_SPIN_CAP) { atomicAdd(&(bar)[XB_TMO], 1u); break; } } } } while (0)
struct XcdBarrier { unsigned* bar; unsigned x; volatile LAS unsigned* st; };
__device__ __forceinline__ XcdBarrier xcd_barrier_post(unsigned* bar, volatile LAS unsigned* st) {
    XcdBarrier b; b.bar = bar; b.x = xb_xcc_id(); b.st = st;
    if (threadIdx.x == 0) (void)xb_add(&bar[XB_XCNT(b.x)], 1u);
    return b;
}
__device__ __forceinline__ void xcd_barrier_complete(unsigned* bar, unsigned x, unsigned& nloc, unsigned& nx) {
    const unsigned G = gridDim.x * gridDim.y * gridDim.z;
    unsigned sum, cnt, mine, sp = 0u;
    for (;;) {
        sum = 0u; cnt = 0u; mine = 0u;
#pragma unroll
        for (unsigned j = 0; j < 16; ++j) { const unsigned c = xb_ld(&bar[XB_XCNT(j)]); sum += c; cnt += (c > 0u) ? 1u : 0u; mine = (j == x) ? c : mine; }
        if (sum == G) break;
        __builtin_amdgcn_s_sleep(1);
        if ((++sp & 255u) == 0u) { if (xb_ld(&bar[XB_TMO])) break; if (sp > XB_SPIN_CAP) { atomicAdd(&bar[XB_TMO], 1u); break; } }
    }
    nloc = mine > 0u ? mine : 1u; nx = cnt > 0u ? cnt : 1u;
}
__device__ __forceinline__ void xcd_barrier(const XcdBarrier& b, bool leader) {
    asm volatile("s_waitcnt vmcnt(0)" ::: "memory");
    __syncthreads();
    if (leader) {
        unsigned* bar = b.bar;
        __builtin_amdgcn_s_waitcnt(0);
        unsigned nloc = b.st[0], nx = b.st[1];
        if (nloc == 0u) { xcd_barrier_complete(bar, b.x, nloc, nx); b.st[0] = nloc; b.st[1] = nx; }
        const unsigned old = xb_add(&bar[XB_XSUB(b.x)], 1u);
        const unsigned gen = old / nloc;
        if (old + 1u == (gen + 1u) * nloc) {
            __builtin_amdgcn_fence(__ATOMIC_RELEASE, "agent");
            asm volatile("s_waitcnt vmcnt(0)" ::: "memory");
            const unsigned og = xb_add(&bar[XB_TOP], 1u);
            const unsigned tg = og / nx;
            if (og + 1u == (tg + 1u) * nx) xb_add(&bar[XB_TOPGEN], 1u);
            else XB_SPIN(xb_ld(&bar[XB_TOPGEN]) == tg, bar);
            __builtin_amdgcn_fence(__ATOMIC_ACQUIRE, "agent");
            xb_add(&bar[XB_XGEN(b.x)], 1u);
            asm volatile("s_waitcnt vmcnt(0)" ::: "memory");
        } else {
            XB_SPIN(xb_ld(&bar[XB_XGEN(b.x)]) == gen, bar);
            __builtin_amdgcn_fence(__ATOMIC_ACQUIRE, "agent");
            asm volatile("s_waitcnt vmcnt(0)" ::: "memory");
        }
    }
    __syncthreads();
}

constexpr int LDS_BYTES = 147456;

__global__ void __launch_bounds__(512, 2) mega_fwd(Params p_unused) {
    extern __shared__ __attribute__((aligned(16))) unsigned char shm[];
    LAS unsigned char* lds = (LAS unsigned char*)shm;
    cg::grid_group grid = cg::this_grid();
    const int wv = __builtin_amdgcn_readfirstlane((int)(threadIdx.x >> 6));
    unsigned long long pb_t0 = 0, pb_acc = 0; (void)pb_t0; (void)pb_acc;
    volatile LAS unsigned* xb_st = (volatile LAS unsigned*)(lds + LDS_BYTES - 16);
    if (threadIdx.x == 0) { xb_st[0] = 0u; xb_st[1] = 0u; }
    __syncthreads();
    { const Params p = load_params(); (void)xcd_barrier_post((unsigned*)(p.ws + WS_BAR), xb_st); }
#define GRID_BARRIER() do { const Params pq = load_params(); XcdBarrier xb; xb.bar = (unsigned*)(pq.ws + WS_BAR); xb.x = xb_xcc_id(); \
        xb.st = (volatile LAS unsigned*)(lds + LDS_BYTES - 16); xcd_barrier(xb, opaque_tid(wv) == 0); } while (0)

    PB_BEGIN(1);
    if (gridDim.y > 1) grid.sync();
    { const Params p = load_params(); phase0(p, lds, wv); }
    GRID_BARRIER();
    PB_END(1);
    PB_BEGIN(2);
    { const Params p = load_params(); modulate0(p, wv); }
    GRID_BARRIER();
    PB_END(2);
    for (int l = 0; l < 2; ++l) {
        if (l == 0) {
            PB_BEGIN(4);
            { const Params p = load_params(); pg8::StaticOrder S; S.init(NP, 6144, gridDim.x, blockIdx.x);
              EpiQkvA E{p.ws, p.out};
              pg8::gemm_phase(lds, pg8::Gemm{(const bf16_t*)(p.ws + WS_H), (const bf16_t*)(p.ws + WS_WQKVA), NP, 6144, 2048}, S, E, wv); }
            PB_END(4);
            PB_BEGIN(8);
            { const Params p = load_params(); SEpiQkvA E{p.ws, p.out};
              skinny_gemm(lds, (const bf16_t*)(p.ws + WS_H) + (size_t)NP * 2048, 2048, (const bf16_t*)(p.ws + WS_WQKVA), 6144, 2048, E, wv); }
            PB_END(8);
            PB_BEGIN(128); GRID_BARRIER(); PB_END(128);
            PB_BEGIN(32);
            { const Params p = load_params(); attn_a_phase(p, lds, wv); }
            GRID_BARRIER();
            PB_END(32);
        } else {
            PB_BEGIN(4);
            { const Params p = load_params(); pg8::StaticOrder S; S.init(NP, 3072, gridDim.x, blockIdx.x);
              EpiQkvB E{p.ws, p.out};
              pg8::gemm_phase(lds, pg8::Gemm{(const bf16_t*)(p.ws + WS_H), (const bf16_t*)(p.ws + WS_WQKVB), NP, 3072, 2048}, S, E, wv); }
            PB_END(4);
            PB_BEGIN(8);
            { const Params p = load_params(); SEpiQkvB E{p.ws, p.out};
              skinny_gemm(lds, (const bf16_t*)(p.ws + WS_H) + (size_t)NP * 2048, 2048, (const bf16_t*)(p.ws + WS_WQKVB), 3072, 2048, E, wv); }
            PB_END(8);
            PB_BEGIN(128); GRID_BARRIER(); PB_END(128);
            PB_BEGIN(64);
            { const Params p = load_params(); attn_b_phase(p, lds, pb_acc, wv); }
            GRID_BARRIER();
            PB_END(64);
        }
        PB_BEGIN(4);
        {
            const Params p = load_params(); pg8::StaticOrder S; S.init(NP, 2048, gridDim.x, blockIdx.x);
            const float* mod = (const float*)(p.ws + WS_MOD);
            if (l == 0) { EpiRes<true> E{p.x_prompt, (bf16_t*)(p.ws + WS_Z), mod + 4096, nullptr, nullptr, nullptr};
                pg8::gemm_phase(lds, pg8::Gemm{(const bf16_t*)(p.ws + WS_H), (const bf16_t*)(p.ws + WS_WOA), NP, 2048, 2048}, S, E, wv); }
            else { EpiRes<false> E{nullptr, (bf16_t*)(p.ws + WS_Z), mod + (size_t)2 * 16 * 6144 + 4096, (const float*)(p.ws + WS_STATS), p.ln_g + 2048, p.ln_b + 2048};
                pg8::gemm_phase(lds, pg8::Gemm{(const bf16_t*)(p.ws + WS_H), (const bf16_t*)(p.ws + WS_WOB), NP, 2048, 2048}, S, E, wv); }
        }
        PB_END(4);
        PB_BEGIN(8);
        {
            const Params p = load_params(); const float* mod = (const float*)(p.ws + WS_MOD);
            SEpiRes E{l == 0 ? p.x_sample : nullptr, (bf16_t*)(p.ws + WS_Z) + (size_t)NP * 2048, mod + (size_t)(2 * l) * 16 * 6144 + 4096, (const float*)(p.ws + WS_STATS) + (size_t)NP * 2, p.ln_g + 2048, p.ln_b + 2048};
            skinny_gemm(lds, (const bf16_t*)(p.ws + WS_H) + (size_t)NP * 2048, 2048, (const bf16_t*)(p.ws + (l == 0 ? WS_WOA : WS_WOB)), 2048, 2048, E, wv);
        }
        PB_END(8);
        PB_BEGIN(128); GRID_BARRIER(); PB_END(128);
        PB_BEGIN(16);
        { const Params p = load_params(); const float* mod = (const float*)(p.ws + WS_MOD);
          ln_phase(p, p.ln_g + (2 * l) * 2048, p.ln_b + (2 * l) * 2048, mod + (size_t)(2 * l + 1) * 16 * 6144, wv); }
        GRID_BARRIER();
        PB_END(16);
        PB_BEGIN(4);
        {
            const Params p = load_params(); pg8::StaticOrder S; S.init(NP, 8192, gridDim.x, blockIdx.x);
            EpiUp E{(bf16_t*)(p.ws + WS_BIG)};
            pg8::gemm_phase(lds, pg8::Gemm{(const bf16_t*)(p.ws + WS_H), (const bf16_t*)(p.ws + WS_WUP) + (size_t)l * 2048 * 8192, NP, 8192, 2048}, S, E, wv);
        }
        PB_END(4);
        PB_BEGIN(8);
        {
            const Params p = load_params(); SEpiUp E{(bf16_t*)(p.ws + WS_BIG)};
            skinny_gemm(lds, (const bf16_t*)(p.ws + WS_H) + (size_t)NP * 2048, 2048, (const bf16_t*)(p.ws + WS_WUP) + (size_t)l * 2048 * 8192, 8192, 2048, E, wv);
        }
        PB_END(8);
        PB_BEGIN(128); GRID_BARRIER(); PB_END(128);
        PB_BEGIN(4);
        {
            const Params p = load_params(); pg8::StaticOrder S; S.init(NP, 2048, gridDim.x, blockIdx.x);
            const float* mod = (const float*)(p.ws + WS_MOD);
            EpiRes<false> E{nullptr, (bf16_t*)(p.ws + WS_Z), mod + (size_t)(2 * l + 1) * 16 * 6144 + 4096, (const float*)(p.ws + WS_STATS), p.ln_g + (2 * l) * 2048, p.ln_b + (2 * l) * 2048};
            pg8::gemm_phase(lds, pg8::Gemm{(const bf16_t*)(p.ws + WS_BIG), (const bf16_t*)(p.ws + WS_WDN) + (size_t)l * 2048 * 8192, NP, 2048, 8192}, S, E, wv);
        }
        PB_END(4);
        PB_BEGIN(8);
        {
            const Params p = load_params(); const float* mod = (const float*)(p.ws + WS_MOD);
            SEpiRes E{nullptr, (bf16_t*)(p.ws + WS_Z) + (size_t)NP * 2048, mod + (size_t)(2 * l + 1) * 16 * 6144 + 4096, (const float*)(p.ws + WS_STATS) + (size_t)NP * 2, p.ln_g + (2 * l) * 2048, p.ln_b + (2 * l) * 2048};
            skinny_gemm(lds, (const bf16_t*)(p.ws + WS_BIG) + (size_t)NP * 8192, 8192, (const bf16_t*)(p.ws + WS_WDN) + (size_t)l * 2048 * 8192, 2048, 8192, E, wv);
        }
        PB_END(8);
        PB_BEGIN(128); GRID_BARRIER(); PB_END(128);
        PB_BEGIN(16);
        { const Params p = load_params(); const float* mod = (const float*)(p.ws + WS_MOD);
          ln_phase(p, p.ln_g + (2 * l + 1) * 2048, p.ln_b + (2 * l + 1) * 2048, l == 0 ? mod + (size_t)2 * 16 * 6144 : nullptr, wv); }
        if (l == 0) GRID_BARRIER();
        PB_END(16);
    }
    if (PROBE_MASK & 256) { for (int i = 0; i < 16; ++i) GRID_BARRIER(); }
    if (PROBE_MASK) { const unsigned long long t1 = __builtin_amdgcn_s_memrealtime(); while (__builtin_amdgcn_s_memrealtime() - t1 < pb_acc) __builtin_amdgcn_s_sleep(8); }
}

extern "C" void kernel_launch(void* const* d_in, const int* in_sizes, int n_in, void* d_out, int out_size, void* d_ws, size_t ws_size, hipStream_t stream) {
    static int grid_blocks = 0;
    if (grid_blocks == 0) {
        if (ws_size < WS_END) { fprintf(stderr, "kernel_launch: workspace too small (%zu < %zu)\n", ws_size, (size_t)WS_END); grid_blocks = -1; return; }
        int dev = 0, cus = 0, per_cu = 0;
        (void)hipGetDevice(&dev);
        (void)hipDeviceGetAttribute(&cus, hipDeviceAttributeMultiprocessorCount, dev);
        if (hipFuncSetAttribute((const void*)mega_fwd, hipFuncAttributeMaxDynamicSharedMemorySize, LDS_BYTES) != hipSuccess) { fprintf(stderr, "kernel_launch: hipFuncSetAttribute failed\n"); grid_blocks = -1; return; }
        if (hipOccupancyMaxActiveBlocksPerMultiprocessor(&per_cu, (const void*)mega_fwd, 512, LDS_BYTES) != hipSuccess || per_cu < 1) { fprintf(stderr, "kernel_launch: occupancy query says %d blocks/CU\n", per_cu); per_cu = 1; }
        (void)hipGetLastError();
        grid_blocks = cus;
    }
    if (grid_blocks < 0) return;
    Params p{};
    p.x_prompt = (const float*)d_in[0]; p.x_sample = (const float*)d_in[1];
    p.cache_a_k = (const float*)d_in[2]; p.cache_a_v = (const float*)d_in[3]; p.cache_b_k = (const float*)d_in[4]; p.cache_b_v = (const float*)d_in[5];
    p.c_prompt = (const float*)d_in[6]; p.c_sample = (const float*)d_in[7];
    p.w_ada = (const float*)d_in[8]; p.b_ada = (const float*)d_in[9]; p.ln_g = (const float*)d_in[10]; p.ln_b = (const float*)d_in[11];
    p.w_qkv_a = (const float*)d_in[12]; p.w_o_a = (const float*)d_in[13]; p.rel_bias_a = (const float*)d_in[14];
    p.w_qkv_b = (const float*)d_in[15]; p.w_o_b = (const float*)d_in[16]; p.sink_b = (const float*)d_in[17];
    p.w_up = (const float*)d_in[18]; p.w_down = (const float*)d_in[19];
    p.out = (float*)d_out; p.ws = (unsigned char*)d_ws;
    if (hipMemsetAsync((char*)d_ws + WS_BAR, 0, 16384, stream) != hipSuccess) { fprintf(stderr, "kernel_launch: hipMemsetAsync of the barrier words failed\n"); return; }
    void* args[] = {&p};
    hipError_t e = hipLaunchCooperativeKernel((const void*)mega_fwd, dim3(grid_blocks), dim3(512), args, LDS_BYTES, stream);
    if (e != hipSuccess) fprintf(stderr, "cooperative launch failed: %s (grid %d)\n", hipGetErrorString(e), grid_blocks);
}
```

```cpp
#include <hip/hip_runtime.h>
#include <hip/hip_cooperative_groups.h>
#include <cstdio>
namespace cg = cooperative_groups;

#define LAS __attribute__((address_space(3)))
#ifndef PROBE_MASK
#define PROBE_MASK 0
#endif
#define PB_BEGIN(bit) do { if (PROBE_MASK & (bit)) pb_t0 = __builtin_amdgcn_s_memrealtime(); } while (0)
#define PB_END(bit)   do { if (PROBE_MASK & (bit)) pb_acc += __builtin_amdgcn_s_memrealtime() - pb_t0; } while (0)
typedef unsigned short bf16_t;
typedef short bf16x8 __attribute__((ext_vector_type(8)));
typedef short bf16x4 __attribute__((ext_vector_type(4)));
typedef float f32x4 __attribute__((ext_vector_type(4)));
typedef unsigned u32x4 __attribute__((ext_vector_type(4)));
typedef unsigned u32x2 __attribute__((ext_vector_type(2)));
typedef float f32x2 __attribute__((ext_vector_type(2)));

constexpr int DM = 2048;
constexpr int NP = 32768;
constexpr int NREAL = 32896;
constexpr int MP = 33024;
constexpr float ALPHA = 1.41421356237309515f;
constexpr float LOG2E = 1.44269504088896341f;

constexpr size_t WS_WQKVA = 0;
constexpr size_t WS_WOA   = WS_WQKVA + (size_t)6144 * 2048 * 2;
constexpr size_t WS_WQKVB = WS_WOA + (size_t)2048 * 2048 * 2;
constexpr size_t WS_WOB   = WS_WQKVB + (size_t)3072 * 2048 * 2;
constexpr size_t WS_WUP   = WS_WOB + (size_t)2048 * 2048 * 2;
constexpr size_t WS_WDN   = WS_WUP + (size_t)2 * 8192 * 2048 * 2;
constexpr size_t WS_BIG   = WS_WDN + (size_t)2 * 8192 * 2048 * 2;
constexpr size_t WS_H     = WS_BIG + (size_t)MP * 8192 * 2;
constexpr size_t WS_KEA   = WS_H + (size_t)MP * 2048 * 2;
constexpr size_t WS_VEA   = WS_KEA + (size_t)8 * 576 * 2048 * 2;
constexpr size_t WS_KEB   = WS_VEA + (size_t)8 * 576 * 2048 * 2;
constexpr size_t WS_VEB   = WS_KEB + (size_t)8 * 192 * 512 * 2;
constexpr size_t WS_MOD   = WS_VEB + (size_t)8 * 192 * 512 * 2;
constexpr size_t WS_ROPE  = WS_MOD + (size_t)4 * 16 * 6144 * 4;
constexpr size_t WS_STATS = WS_ROPE + (size_t)4112 * 16 * 4;
constexpr size_t WS_Z     = WS_STATS + (size_t)NREAL * 2 * 4;
constexpr size_t WS_BAR   = WS_Z + (size_t)NREAL * 2048 * 2;
constexpr size_t WS_END   = WS_BAR + 16384;

constexpr size_t O_Y    = 0;
constexpr size_t O_AKP  = (size_t)NREAL * 2048;
constexpr size_t O_AVP  = O_AKP + (size_t)8 * 512 * 2048;
constexpr size_t O_BKP  = O_AVP + (size_t)8 * 512 * 2048;
constexpr size_t O_BVP  = O_BKP + (size_t)8 * 128 * 512;
constexpr size_t O_AKS  = O_BVP + (size_t)8 * 128 * 512;
constexpr size_t O_AVS  = O_AKS + (size_t)128 * 2048;
constexpr size_t O_BKS  = O_AVS + (size_t)128 * 2048;
constexpr size_t O_BVS  = O_BKS + (size_t)128 * 512;

struct Params {
    const float* x_prompt; const float* x_sample;
    const float* cache_a_k; const float* cache_a_v; const float* cache_b_k; const float* cache_b_v;
    const float* c_prompt; const float* c_sample;
    const float* w_ada; const float* b_ada; const float* ln_g; const float* ln_b;
    const float* w_qkv_a; const float* w_o_a; const float* rel_bias_a;
    const float* w_qkv_b; const float* w_o_b; const float* sink_b;
    const float* w_up; const float* w_down;
    float* out; unsigned char* ws;
};

typedef const __attribute__((address_space(4))) struct Params* KParamPtr;
__device__ __forceinline__ Params load_params() {
#if defined(__HIP_DEVICE_COMPILE__)
    auto k = __builtin_amdgcn_kernarg_segment_ptr();
    asm volatile("" : "+s"(k));
    return *(KParamPtr)k;
#else
    return Params{};
#endif
}
__device__ __forceinline__ int opaque_tid(int wv) { unsigned z = 0u; asm volatile("" : "+v"(z));
    return (wv << 6) | (int)__builtin_amdgcn_mbcnt_hi(~0u, __builtin_amdgcn_mbcnt_lo(~0u, z)); }
__device__ __forceinline__ float shx(float v, int mask, int lane) { return __int_as_float(__builtin_amdgcn_ds_bpermute((lane ^ mask) << 2, __float_as_int(v))); }
template <int CTRL> __device__ __forceinline__ float dppf(float v) { return __int_as_float(__builtin_amdgcn_update_dpp(0, __float_as_int(v), CTRL, 0xf, 0xf, true)); }
__device__ __forceinline__ float xmax16(float v) { const auto r = __builtin_amdgcn_permlane16_swap(__float_as_uint(v), __float_as_uint(v), false, false); return fmaxf(__uint_as_float(r[0]), __uint_as_float(r[1])); }
__device__ __forceinline__ float xmax32(float v) { const auto r = __builtin_amdgcn_permlane32_swap(__float_as_uint(v), __float_as_uint(v), false, false); return fmaxf(__uint_as_float(r[0]), __uint_as_float(r[1])); }
__device__ __forceinline__ float xsum16(float v) { const auto r = __builtin_amdgcn_permlane16_swap(__float_as_uint(v), __float_as_uint(v), false, false); return __uint_as_float(r[0]) + __uint_as_float(r[1]); }
__device__ __forceinline__ float xsum32(float v) { const auto r = __builtin_amdgcn_permlane32_swap(__float_as_uint(v), __float_as_uint(v), false, false); return __uint_as_float(r[0]) + __uint_as_float(r[1]); }
__device__ __forceinline__ float xchg16(float v, bool odd_row) { const auto r = __builtin_amdgcn_permlane16_swap(__float_as_uint(v), __float_as_uint(v), false, false); return __uint_as_float(odd_row ? r[0] : r[1]); }
__device__ __forceinline__ float xchg32(float v, bool upper) { const auto r = __builtin_amdgcn_permlane32_swap(__float_as_uint(v), __float_as_uint(v), false, false); return __uint_as_float(upper ? r[0] : r[1]); }
__device__ __forceinline__ float wave_sum(float v) {
    v += dppf<0xB1>(v); v += dppf<0x4E>(v); v += dppf<0x141>(v); v += dppf<0x140>(v); v = xsum16(v); return xsum32(v); }
__device__ __forceinline__ float a_fma(float a, float b, float c) { float d; asm("v_fma_f32 %0, %1, %2, %3" : "=v"(d) : "v"(a), "s"(b), "v"(c)); return d; }
__device__ __forceinline__ float a_exp2(float a) { float d; asm("v_exp_f32 %0, %1" : "=v"(d) : "v"(a)); return d; }
__device__ __forceinline__ float a_add(float a, float b) { float d; asm("v_add_f32 %0, %1, %2" : "=v"(d) : "v"(a), "v"(b)); return d; }
__device__ __forceinline__ float a_sub(float a, float b) { float d; asm("v_sub_f32 %0, %1, %2" : "=v"(d) : "v"(a), "v"(b)); return d; }
__device__ __forceinline__ float bf_lo(unsigned w) { return __uint_as_float(w << 16); }
__device__ __forceinline__ float bf_hi(unsigned w) { return __uint_as_float(w & 0xffff0000u); }
__device__ __forceinline__ unsigned pk2(float lo, float hi) { unsigned r; asm("v_cvt_pk_bf16_f32 %0, %1, %2" : "=v"(r) : "v"(lo), "v"(hi)); return r; }

namespace pg8 {
constexpr int BM = 256, BK = 64, HALF = 128, HTB = HALF * BK * 2, STAGE_BYTES = 8 * HTB, NXCD = 8, WGM = 4;
__device__ __forceinline__ int lds_byte(int r, int c) { const int st = (r >> 4) * 2 + (c >> 5), rr = r & 15, cc = c & 31, ob = rr * 64 + cc * 2; return st * 1024 + (ob ^ (((ob >> 9) & 1) << 5)); }
__device__ __forceinline__ void stage_rc(int b, int& R, int& C) { const int st = b / 1024, sb = b % 1024, swz = sb ^ (((sb >> 9) & 1) << 5); R = (st >> 1) * 16 + swz / 64; C = (st & 1) * 32 + (swz % 64) / 2; }
__device__ __forceinline__ int perm32(int rho) { const int n = rho >> 4, i = rho & 15; return 8 * (i >> 2) + 4 * n + (i & 3); }
struct Unit { int pm, pn; };
struct Gemm { const bf16_t* A; const bf16_t* Bt; int M, N, K; };
struct StaticOrder {
    int nM, nN, nwg, G, c;
    __device__ void init(int M, int N, int G_, int c_) { nM = M / BM; nN = N / BM; nwg = nM * nN; G = G_; c = c_; }
    __device__ bool next(int i, Unit& u) const {
        const long L = (long)i * G + c; if (L >= nwg) return false;
        int wgid = (int)L; { const int q = nwg / NXCD, r = nwg % NXCD, xcd = wgid % NXCD, off = wgid / NXCD; wgid = (xcd < r ? xcd * (q + 1) : r * (q + 1) + (xcd - r) * q) + off; }
        const int nig = WGM * nN, gid = wgid / nig, fm = gid * WGM, gsz = (nM - fm) < WGM ? (nM - fm) : WGM;
        u.pm = fm + ((wgid % nig) % gsz); u.pn = (wgid % nig) / gsz; return true;
    }
};

template <class Epi>
__device__ __forceinline__ void gemm_phase(LAS unsigned char* lds, const Gemm g, const StaticOrder& S, const Epi& E, int wv) {
    const int tid = opaque_tid(wv), wid = __builtin_amdgcn_readfirstlane(tid >> 6), lane = tid & 63, wr = wid >> 2, wc = wid & 3, fr = lane & 15, fq = lane >> 4;
    const int K = g.K, nt = K / BK;
    unsigned voffA[2], voffB[2];
#pragma unroll
    for (int i = 0; i < 2; ++i) { int R, C; stage_rc(tid * 16 + i * 8192, R, C); const int Rb = Epi::PERM ? ((R & ~31) + perm32(R & 31)) : R;
        voffA[i] = (unsigned)(R * K + C) * 2u; voffB[i] = (unsigned)(Rb * K + C) * 2u; }
    const size_t kstep = (size_t)(BK * 2);
    const size_t hstep = (size_t)HALF * K * 2;
    const size_t tstep = 2 * hstep;
    const unsigned ldsw = (unsigned)wid * 1024u;
    const int aoff = lds_byte(wr * 64 + fr, fq * 8), boff = lds_byte(wc * 32 + fr, fq * 8);
#define PG8_SA(b, h) (((b) * 2 + (h)) * HTB)
#define PG8_SB(b, h) ((4 + (b) * 2 + (h)) * HTB)
#define PG8_STAGE(bufoff, gbase, voff) do { _Pragma("unroll") for (int _i = 0; _i < 2; ++_i) \
        __builtin_amdgcn_global_load_lds((const unsigned*)((const char*)(gbase) + (voff)[_i]), (LAS unsigned*)(lds + (bufoff) + ldsw + _i * 8192), 16, 0, 0); } while (0)
#define PG8_LDA(dst, b, h) do { _Pragma("unroll") for (int m = 0; m < 4; ++m) _Pragma("unroll") for (int k = 0; k < 2; ++k) dst[m][k] = *(const LAS bf16x8*)(lds + PG8_SA(b, h) + aoff + m * 2048 + k * 1024); } while (0)
#define PG8_LDB(dst, b, h) do { _Pragma("unroll") for (int n = 0; n < 2; ++n) _Pragma("unroll") for (int k = 0; k < 2; ++k) dst[n][k] = *(const LAS bf16x8*)(lds + PG8_SB(b, h) + boff + n * 2048 + k * 1024); } while (0)
#define PG8_MMA(ai, bj, At, Bt) do { __builtin_amdgcn_s_setprio(1); _Pragma("unroll") for (int m = 0; m < 4; ++m) _Pragma("unroll") for (int n = 0; n < 2; ++n) _Pragma("unroll") for (int k = 0; k < 2; ++k) \
        acc[ai][bj][m][n] = __builtin_amdgcn_mfma_f32_16x16x32_bf16(Bt[n][k], At[m][k], acc[ai][bj][m][n], 0, 0, 0); __builtin_amdgcn_s_setprio(0); } while (0)
#define PG8_WAIT_V(n) asm volatile("s_waitcnt vmcnt(" #n ")" ::: "memory")
#define PG8_WAIT_L(n) asm volatile("s_waitcnt lgkmcnt(" #n ")" ::: "memory")
#define PG8_BAR __builtin_amdgcn_s_barrier()
#define PG8_SCHED __builtin_amdgcn_sched_barrier(0)
    Unit cur, nxt; int ui = 0;
    if (!S.next(0, cur)) return;
    f32x4 acc[2][2][4][2];
#pragma unroll
    for (int a = 0; a < 2; ++a)
#pragma unroll
        for (int b = 0; b < 2; ++b)
#pragma unroll
            for (int m = 0; m < 4; ++m)
#pragma unroll
                for (int n = 0; n < 2; ++n) acc[a][b][m][n] = (f32x4){0.f, 0.f, 0.f, 0.f};
    bf16x8 At[4][2], B0[2][2], B1[2][2];
    const char* cA = (const char*)g.A + (size_t)cur.pm * tstep; const char* cB = (const char*)g.Bt + (size_t)cur.pn * tstep;
    PG8_STAGE(PG8_SB(0, 0), cB, voffB); PG8_STAGE(PG8_SA(0, 0), cA, voffA); PG8_STAGE(PG8_SB(0, 1), cB + hstep, voffB); PG8_STAGE(PG8_SA(0, 1), cA + hstep, voffA);
    if (wr == 1) PG8_BAR;
    PG8_WAIT_V(4); PG8_BAR;
    PG8_STAGE(PG8_SB(1, 0), cB + kstep, voffB); PG8_STAGE(PG8_SA(1, 0), cA + kstep, voffA); PG8_STAGE(PG8_SB(1, 1), cB + hstep + kstep, voffB);
    PG8_WAIT_V(6); PG8_BAR;
    for (;;) {
        const bool has_next = S.next(ui + 1, nxt);
        const char* nA = has_next ? (const char*)g.A + (size_t)nxt.pm * tstep : cA; const char* nB = has_next ? (const char*)g.Bt + (size_t)nxt.pn * tstep : cB;
        for (int t = 0; t < nt; t += 2) {
            const bool last = (t == nt - 2);
            const char* a1 = cA + (size_t)(t + 1) * kstep;
            const char* a2 = last ? nA : cA + (size_t)(t + 2) * kstep; const char* b2 = last ? nB : cB + (size_t)(t + 2) * kstep;
            const char* a3 = a2 + kstep; const char* b3 = b2 + kstep;
            PG8_LDB(B0, 0, 0); PG8_SCHED; PG8_LDA(At, 0, 0); PG8_STAGE(PG8_SA(1, 1), a1 + hstep, voffA);
            PG8_WAIT_L(8); PG8_BAR; PG8_WAIT_L(0); PG8_MMA(0, 0, At, B0); PG8_BAR; PG8_SCHED;
            PG8_LDB(B1, 0, 1); PG8_STAGE(PG8_SB(0, 0), b2, voffB);
            PG8_BAR; PG8_WAIT_L(0); PG8_MMA(0, 1, At, B1); PG8_BAR;
            PG8_LDA(At, 0, 1); PG8_STAGE(PG8_SA(0, 0), a2, voffA);
            PG8_BAR; PG8_WAIT_L(0); PG8_MMA(1, 0, At, B0); PG8_BAR; PG8_SCHED;
            PG8_STAGE(PG8_SB(0, 1), b2 + hstep, voffB);
            PG8_WAIT_V(6); PG8_BAR; PG8_MMA(1, 1, At, B1); PG8_BAR;
            PG8_LDB(B0, 1, 0); PG8_SCHED; PG8_LDA(At, 1, 0); PG8_STAGE(PG8_SA(0, 1), a2 + hstep, voffA);
            PG8_WAIT_L(8); PG8_BAR; PG8_WAIT_L(0); PG8_MMA(0, 0, At, B0); PG8_BAR; PG8_SCHED;
            PG8_LDB(B1, 1, 1); PG8_STAGE(PG8_SB(1, 0), b3, voffB);
            PG8_BAR; PG8_WAIT_L(0); PG8_MMA(0, 1, At, B1); PG8_BAR;
            PG8_LDA(At, 1, 1); PG8_STAGE(PG8_SA(1, 0), a3, voffA);
            PG8_BAR; PG8_WAIT_L(0); PG8_MMA(1, 0, At, B0); PG8_BAR; PG8_SCHED;
            PG8_STAGE(PG8_SB(1, 1), b3 + hstep, voffB);
            PG8_WAIT_V(6); PG8_BAR; PG8_MMA(1, 1, At, B1); PG8_BAR;
        }
        E(acc, cur, wr, wc, fr, fq);
        if (!has_next) break;
#pragma unroll
        for (int a = 0; a < 2; ++a)
#pragma unroll
            for (int b = 0; b < 2; ++b)
#pragma unroll
                for (int m = 0; m < 4; ++m)
#pragma unroll
                    for (int n = 0; n < 2; ++n) acc[a][b][m][n] = (f32x4){0.f, 0.f, 0.f, 0.f};
        cur = nxt; cA = nA; cB = nB; ++ui;
    }
    PG8_WAIT_V(0);
    if (wr == 0) PG8_BAR;
    PG8_BAR;
#undef PG8_SA
#undef PG8_SB
#undef PG8_STAGE
#undef PG8_LDA
#undef PG8_LDB
#undef PG8_MMA
#undef PG8_WAIT_V
#undef PG8_WAIT_L
#undef PG8_BAR
#undef PG8_SCHED
}
}
using pg8::Unit;

struct EpiQkvA {
    static constexpr bool PERM = true;
    unsigned char* ws; float* out;
    __device__ __forceinline__ void operator()(const f32x4 (&acc)[2][2][4][2], const Unit& u, int wr, int wc, int fr, int fq) const {
        const int which = u.pn >> 3, colt = (u.pn & 7) * 256;
        const int row0 = u.pm * 256 + wr * 64 + fr, col0 = colt + wc * 32 + 8 * fq;
        bf16_t* base = (bf16_t*)(ws + WS_BIG) + (size_t)which * MP * 2048;
        bf16_t* ext = (bf16_t*)(ws + (which == 1 ? WS_KEA : WS_VEA));
        float* oP = out + (which == 1 ? O_AKP : O_AVP);
        float* oS = out + (which == 1 ? O_AKS : O_AVS);
        constexpr bool prompt = true; const bool cache_tile = ((u.pm & 15) >= 14) && which > 0;
#pragma unroll
        for (int ai = 0; ai < 2; ++ai)
#pragma unroll
            for (int m = 0; m < 4; ++m) {
                const int row = row0 + ai * 128 + m * 16;
#pragma unroll
                for (int bj = 0; bj < 2; ++bj) {
                    const f32x4 v0 = acc[ai][bj][m][0], v1 = acc[ai][bj][m][1];
                    const int col = col0 + bj * 128;
                    u32x4 pk; pk[0] = pk2(v0[0], v0[1]); pk[1] = pk2(v0[2], v0[3]); pk[2] = pk2(v1[0], v1[1]); pk[3] = pk2(v1[2], v1[3]);
                    if (prompt || which == 0) *(u32x4*)(base + (size_t)row * 2048 + col) = pk;
                    if (cache_tile) { const int b = row >> 12, t = (row & 4095) - 3584; float* o = oP + ((size_t)(b * 512 + t)) * 2048 + col; *(f32x4*)o = v0; *(f32x4*)(o + 4) = v1; }
                    if (!prompt && which > 0 && row < NREAL) { const int sr = row - NP, b = sr >> 4, t = sr & 15;
                        *(u32x4*)(ext + ((size_t)(b * 576 + 512 + t)) * 2048 + col) = pk;
                        float* o = oS + (size_t)sr * 2048 + col; *(f32x4*)o = v0; *(f32x4*)(o + 4) = v1; }
                }
            }
    }
};

struct EpiQkvB {
    static constexpr bool PERM = true;
    unsigned char* ws; float* out;
    __device__ __forceinline__ void operator()(const f32x4 (&acc)[2][2][4][2], const Unit& u, int wr, int wc, int fr, int fq) const {
        const float* rope = (const float*)(ws + WS_ROPE);
        const int which = u.pn < 8 ? 0 : (u.pn < 10 ? 1 : 2);
        const int colt = which == 0 ? u.pn * 256 : (which == 1 ? (u.pn - 8) * 256 : (u.pn - 10) * 256);
        const int ld = which == 0 ? 2048 : 512;
        const int row0 = u.pm * 256 + wr * 64 + fr, col0 = colt + wc * 32 + 8 * fq;
        bf16_t* base = (bf16_t*)(ws + WS_BIG) + (which == 0 ? (size_t)0 : (which == 1 ? (size_t)MP * 2048 : (size_t)MP * 2048 + (size_t)MP * 512));
        bf16_t* ext = (bf16_t*)(ws + (which == 1 ? WS_KEB : WS_VEB));
        float* oP = out + (which == 1 ? O_BKP : O_BVP);
        float* oS = out + (which == 1 ? O_BKS : O_BVS);
        constexpr bool prompt = true; const bool last_tile = ((u.pm & 15) == 15) && which > 0;
        const bool do_rope = (which < 2) && ((wc & 1) == 0);
#pragma unroll
        for (int ai = 0; ai < 2; ++ai) {
            f32x4 rc[4][4];
            if (do_rope) {
#pragma unroll
                for (int m = 0; m < 4; ++m) { const int row = row0 + ai * 128 + m * 16; const float* rp = rope + (size_t)(row & 4095) * 16;
#pragma unroll
                    for (int q = 0; q < 4; ++q) rc[m][q] = *(const f32x4*)(rp + q * 4); } }
#pragma unroll
            for (int m = 0; m < 4; ++m) {
                const int row = row0 + ai * 128 + m * 16;
#pragma unroll
                for (int bj = 0; bj < 2; ++bj) {
                    f32x4 v0 = acc[ai][bj][m][0], v1 = acc[ai][bj][m][1];
                    if (do_rope) {
                        f32x4 p0, p1;
#pragma unroll
                        for (int j = 0; j < 4; ++j) { p0[j] = xchg16(v0[j], (fq & 1) != 0); p1[j] = xchg16(v1[j], (fq & 1) != 0); }
                        if (fq == 0) { v0 = v0 * rc[m][0] - p0 * rc[m][2]; v1 = v1 * rc[m][1] - p1 * rc[m][3]; }
                        else if (fq == 1) { v0 = v0 * rc[m][0] + p0 * rc[m][2]; v1 = v1 * rc[m][1] + p1 * rc[m][3]; }
                    }
                    const int col = col0 + bj * 128;
                    u32x4 pk; pk[0] = pk2(v0[0], v0[1]); pk[1] = pk2(v0[2], v0[3]); pk[2] = pk2(v1[0], v1[1]); pk[3] = pk2(v1[2], v1[3]);
                    *(u32x4*)(base + (size_t)row * ld + col) = pk;
                    if (last_tile && ai == 1) { const int b = row >> 12, t = (row & 4095) - 3968; float* o = oP + ((size_t)(b * 128 + t)) * 512 + col; *(f32x4*)o = v0; *(f32x4*)(o + 4) = v1; }
                }
            }
        }
    }
};

struct EpiUp {
    static constexpr bool PERM = true;
    bf16_t* U;
    __device__ __forceinline__ void operator()(const f32x4 (&acc)[2][2][4][2], const Unit& u, int wr, int wc, int fr, int fq) const {
        const int row0 = u.pm * 256 + wr * 64 + fr, col0 = u.pn * 256 + wc * 32 + 8 * fq;
#pragma unroll
        for (int ai = 0; ai < 2; ++ai)
#pragma unroll
            for (int m = 0; m < 4; ++m) {
                bf16_t* rowp = U + (size_t)(row0 + ai * 128 + m * 16) * 8192 + col0;
#pragma unroll
                for (int bj = 0; bj < 2; ++bj) {
                    f32x4 v0 = acc[ai][bj][m][0], v1 = acc[ai][bj][m][1];
#pragma unroll
                    for (int j = 0; j < 4; ++j) { const float a = fmaxf(v0[j], 0.f), b = fmaxf(v1[j], 0.f); v0[j] = a * a; v1[j] = b * b; }
                    u32x4 pk; pk[0] = pk2(v0[0], v0[1]); pk[1] = pk2(v0[2], v0[3]); pk[2] = pk2(v1[0], v1[1]); pk[3] = pk2(v1[2], v1[3]);
                    *(u32x4*)(rowp + bj * 128) = pk;
                }
            }
    }
};

template <bool HASX>
struct EpiRes {
    static constexpr bool PERM = true;
    const float* xin; bf16_t* Z; const float* gate  ; const float* stats; const float* lng; const float* lnb;
    __device__ __forceinline__ void operator()(const f32x4 (&acc)[2][2][4][2], const Unit& u, int wr, int wc, int fr, int fq) const {
        const int row0 = u.pm * 256 + wr * 64 + fr, col0 = u.pn * 256 + wc * 32 + 8 * fq;
        const float* gr = gate + (size_t)(u.pm >> 4) * 6144 + col0;
        f32x4 gv[2][2], gw[2][2], bw[2][2];
#pragma unroll
        for (int bj = 0; bj < 2; ++bj)
#pragma unroll
            for (int n = 0; n < 2; ++n) { gv[bj][n] = *(const f32x4*)(gr + bj * 128 + n * 4);
                if (!HASX) { gw[bj][n] = *(const f32x4*)(lng + col0 + bj * 128 + n * 4); bw[bj][n] = *(const f32x4*)(lnb + col0 + bj * 128 + n * 4); } }
#pragma unroll
        for (int ai = 0; ai < 2; ++ai) {
            u32x4 zz[4][2]; f32x2 st[4]; f32x4 xx[4][2][2];
#pragma unroll
            for (int m = 0; m < 4; ++m) { const int row = row0 + ai * 128 + m * 16;
                if (HASX) {
#pragma unroll
                    for (int bj = 0; bj < 2; ++bj) { const float* xr = xin + (size_t)row * 2048 + col0 + bj * 128; xx[m][bj][0] = *(const f32x4*)xr; xx[m][bj][1] = *(const f32x4*)(xr + 4); }
                } else { st[m] = *(const f32x2*)(stats + (size_t)row * 2);
#pragma unroll
                    for (int bj = 0; bj < 2; ++bj) zz[m][bj] = *(const u32x4*)(Z + (size_t)row * 2048 + col0 + bj * 128); } }
#pragma unroll
            for (int m = 0; m < 4; ++m) { const int row = row0 + ai * 128 + m * 16;
                bf16_t* zr = Z + (size_t)row * 2048 + col0;
#pragma unroll
                for (int bj = 0; bj < 2; ++bj) {
                    f32x4 x0, x1;
                    if (HASX) { x0 = xx[m][bj][0]; x1 = xx[m][bj][1]; }
                    else { const u32x4 q = zz[m][bj];
                        x0[0] = bf_lo(q[0]); x0[1] = bf_hi(q[0]); x0[2] = bf_lo(q[1]); x0[3] = bf_hi(q[1]); x1[0] = bf_lo(q[2]); x1[1] = bf_hi(q[2]); x1[2] = bf_lo(q[3]); x1[3] = bf_hi(q[3]);
                        x0 = (x0 - st[m][0]) * st[m][1] * gw[bj][0] + bw[bj][0]; x1 = (x1 - st[m][0]) * st[m][1] * gw[bj][1] + bw[bj][1]; }
                    const f32x4 z0 = x0 * ALPHA + gv[bj][0] * acc[ai][bj][m][0], z1 = x1 * ALPHA + gv[bj][1] * acc[ai][bj][m][1];
                    u32x4 pk; pk[0] = pk2(z0[0], z0[1]); pk[1] = pk2(z0[2], z0[3]); pk[2] = pk2(z1[0], z1[1]); pk[3] = pk2(z1[2], z1[3]);
                    *(u32x4*)(zr + bj * 128) = pk;
                }
            }
        }
    }
};

template <class SEpi>
__device__ __forceinline__ void skinny_gemm(LAS unsigned char* lds, const bf16_t* A, int lda, const bf16_t* Wt, int N, int K, const SEpi& E, int wv) {
    const int tid = opaque_tid(wv), wid = tid >> 6, lane = tid & 63, g = lane >> 4, l15 = lane & 15;
    const int kw = K >> 3;
    const bf16_t* ap = A + (size_t)l15 * lda + wid * kw + g * 8;
    LAS f32x4* red = (LAS f32x4*)lds;
    for (int tile = blockIdx.x; tile < (N >> 4); tile += gridDim.x) {
        const int n0 = tile * 16;
        const bf16_t* bp = Wt + (size_t)(n0 + l15) * K + wid * kw + g * 8;
        f32x4 acc[8];
#pragma unroll
        for (int rt = 0; rt < 8; ++rt) acc[rt] = (f32x4){0.f, 0.f, 0.f, 0.f};
        for (int k0 = 0; k0 < kw; k0 += 64) {
            bf16x8 b[2], a[2][8];
#pragma unroll
            for (int i = 0; i < 2; ++i) { b[i] = *(const bf16x8*)(bp + k0 + i * 32);
#pragma unroll
                for (int rt = 0; rt < 8; ++rt) a[i][rt] = *(const bf16x8*)(ap + (size_t)rt * 16 * lda + k0 + i * 32); }
            __builtin_amdgcn_sched_barrier(0);
#pragma unroll
            for (int i = 0; i < 2; ++i)
#pragma unroll
                for (int rt = 0; rt < 8; ++rt) acc[rt] = __builtin_amdgcn_mfma_f32_16x16x32_bf16(b[i], a[i][rt], acc[rt], 0, 0, 0);
            __builtin_amdgcn_sched_barrier(0);
        }
        __syncthreads();
#pragma unroll
        for (int rt = 0; rt < 8; ++rt) red[(wid * 8 + rt) * 64 + lane] = acc[rt];
        __syncthreads();
        f32x4 s = red[wid * 64 + lane];
#pragma unroll
        for (int wv = 1; wv < 8; ++wv) s += red[(wv * 8 + wid) * 64 + lane];
        E(s, wid * 16 + l15, n0, g);
    }
}
struct SEpiQkvA {
    unsigned char* ws; float* out;
    __device__ __forceinline__ void operator()(f32x4 v, int r, int n0, int g) const {
        const int which = n0 >> 11, col = (n0 & 2047) + g * 4;
        u32x2 pk; pk[0] = pk2(v[0], v[1]); pk[1] = pk2(v[2], v[3]);
        if (which == 0) { *(u32x2*)((bf16_t*)(ws + WS_BIG) + (size_t)(NP + r) * 2048 + col) = pk; return; }
        const int b = r >> 4, t = r & 15;
        *(u32x2*)((bf16_t*)(ws + (which == 1 ? WS_KEA : WS_VEA)) + ((size_t)(b * 576 + 512 + t)) * 2048 + col) = pk;
        *(f32x4*)(out + (which == 1 ? O_AKS : O_AVS) + (size_t)r * 2048 + col) = v;
    }
};
struct SEpiQkvB {
    unsigned char* ws; float* out;
    __device__ __forceinline__ void operator()(f32x4 v, int r, int n0, int g) const {
        const int which = n0 < 2048 ? 0 : (n0 < 2560 ? 1 : 2);
        if (which < 2 && (n0 & 63) == 0) {
            const float* rp = (const float*)(ws + WS_ROPE) + (size_t)(4096 + (r & 15)) * 16 + (g & 1) * 4;
            const f32x4 cs = *(const f32x4*)rp, sn = *(const f32x4*)(rp + 8);
            f32x4 pr;
#pragma unroll
            for (int j = 0; j < 4; ++j) pr[j] = xchg32(v[j], g >= 2);
            v = g < 2 ? v * cs - pr * sn : v * cs + pr * sn;
        }
        u32x2 pk; pk[0] = pk2(v[0], v[1]); pk[1] = pk2(v[2], v[3]);
        if (which == 0) { *(u32x2*)((bf16_t*)(ws + WS_BIG) + (size_t)(NP + r) * 2048 + n0 + g * 4) = pk; return; }
        const int col = n0 - (which == 1 ? 2048 : 2560) + g * 4, b = r >> 4, t = r & 15;
        *(u32x2*)((bf16_t*)(ws + (which == 1 ? WS_KEB : WS_VEB)) + ((size_t)(b * 192 + 128 + t)) * 512 + col) = pk;
        *(f32x4*)(out + (which == 1 ? O_BKS : O_BVS) + (size_t)r * 512 + col) = v;
    }
};
struct SEpiUp {
    bf16_t* U;
    __device__ __forceinline__ void operator()(f32x4 v, int r, int n0, int g) const {
#pragma unroll
        for (int j = 0; j < 4; ++j) { const float a = fmaxf(v[j], 0.f); v[j] = a * a; }
        u32x2 pk; pk[0] = pk2(v[0], v[1]); pk[1] = pk2(v[2], v[3]);
        *(u32x2*)(U + (size_t)(NP + r) * 8192 + n0 + g * 4) = pk;
    }
};
struct SEpiRes {
    const float* xin; bf16_t* Z; const float* gate; const float* stats; const float* lng; const float* lnb;
    __device__ __forceinline__ void operator()(f32x4 v, int r, int n0, int g) const {
        const int col = n0 + g * 4;
        f32x4 xv; const f32x4 gv = *(const f32x4*)(gate + (size_t)(8 + (r >> 4)) * 6144 + col);
        if (xin) xv = *(const f32x4*)(xin + (size_t)r * 2048 + col);
        else { const u32x2 zz = *(const u32x2*)(Z + (size_t)r * 2048 + col); const f32x2 st = *(const f32x2*)(stats + (size_t)r * 2);
            xv[0] = bf_lo(zz[0]); xv[1] = bf_hi(zz[0]); xv[2] = bf_lo(zz[1]); xv[3] = bf_hi(zz[1]);
            xv = (xv - st[0]) * st[1] * *(const f32x4*)(lng + col) + *(const f32x4*)(lnb + col); }
        const f32x4 z = xv * ALPHA + gv * v;
        u32x2 pk; pk[0] = pk2(z[0], z[1]); pk[1] = pk2(z[2], z[3]);
        *(u32x2*)(Z + (size_t)r * 2048 + col) = pk;
    }
};

__device__ __forceinline__ void ada_item(const Params& p, int item, LAS float* lds, int wv) {
    const int tid = opaque_tid(wv), wid = tid >> 6, lane = tid & 63;
    const int combo = item / 24, cb = item % 24, col0 = cb * 256;
    const float* W = p.w_ada + (size_t)combo * 2048 * 6144;
    __syncthreads();
    for (int i0 = 0; i0 < 64; i0 += 16) {
        float c[16];
#pragma unroll
        for (int q = 0; q < 16; ++q) { const int idx = tid + 512 * (i0 + q), r = idx >> 11, k = idx & 2047;
            c[q] = r < 8 ? p.c_prompt[r * 2048 + k] : p.c_sample[(r - 8) * 2048 + k]; }
#pragma unroll
        for (int q = 0; q < 16; ++q) { const int idx = tid + 512 * (i0 + q), r = idx >> 11, k = idx & 2047;
            lds[k * 16 + r] = c[q] / (1.f + __expf(-c[q])); }
    }
    __syncthreads();
    f32x4 acc[16];
#pragma unroll
    for (int r = 0; r < 16; ++r) acc[r] = (f32x4){0.f, 0.f, 0.f, 0.f};
    const float* wp = W + (size_t)(wid * 256) * 6144 + col0 + lane * 4;
    for (int kk = 0; kk < 256; kk += 16) {
        f32x4 w[16];
#pragma unroll
        for (int q = 0; q < 16; ++q) w[q] = *(const f32x4*)(wp + (size_t)(kk + q) * 6144);
        __builtin_amdgcn_sched_barrier(0);
#pragma unroll
        for (int q = 0; q < 16; ++q) {
            const LAS f32x4* sp = (const LAS f32x4*)(lds + (wid * 256 + kk + q) * 16);
#pragma unroll
            for (int r4 = 0; r4 < 4; ++r4) { const f32x4 s = sp[r4];
#pragma unroll
                for (int j = 0; j < 4; ++j) acc[r4 * 4 + j] += w[q] * s[j]; }
        }
    }
    __syncthreads();
#pragma unroll
    for (int r = 0; r < 16; ++r) *(LAS f32x4*)(lds + (wid * 16 + r) * 256 + lane * 4) = acc[r];
    __syncthreads();
    float* mod = (float*)(p.ws + WS_MOD);
#pragma unroll
    for (int i = 0; i < 8; ++i) { const int idx = tid + 512 * i, r = idx >> 8, c = idx & 255; float s = 0.f;
#pragma unroll
        for (int w = 0; w < 8; ++w) s += lds[(w * 16 + r) * 256 + c];
        mod[((size_t)combo * 16 + r) * 6144 + col0 + c] = s + p.b_ada[combo * 6144 + col0 + c]; }
}

struct TTile { const float* src; bf16_t* dst; int K, N; };
__device__ __forceinline__ TTile ttile_of(const Params& p, int it) {
    constexpr int T0 = 768, T1 = T0 + 256, T2 = T1 + 384, T3 = T2 + 256, T4 = T3 + 2048;
    const float* src; bf16_t* dst; int K, N, tl;
    if (it < T0)      { src = p.w_qkv_a; dst = (bf16_t*)(p.ws + WS_WQKVA); K = 2048; N = 6144; tl = it; }
    else if (it < T1) { src = p.w_o_a;   dst = (bf16_t*)(p.ws + WS_WOA);   K = 2048; N = 2048; tl = it - T0; }
    else if (it < T2) { src = p.w_qkv_b; dst = (bf16_t*)(p.ws + WS_WQKVB); K = 2048; N = 3072; tl = it - T1; }
    else if (it < T3) { src = p.w_o_b;   dst = (bf16_t*)(p.ws + WS_WOB);   K = 2048; N = 2048; tl = it - T2; }
    else if (it < T4) { const int l = (it - T3) >> 10; src = p.w_up + (size_t)l * 2048 * 8192; dst = (bf16_t*)(p.ws + WS_WUP) + (size_t)l * 2048 * 8192; K = 2048; N = 8192; tl = (it - T3) & 1023; }
    else              { const int l = (it - T4) >> 10; src = p.w_down + (size_t)l * 2048 * 8192; dst = (bf16_t*)(p.ws + WS_WDN) + (size_t)l * 2048 * 8192; K = 8192; N = 2048; tl = (it - T4) & 1023; }
    const int ntn = N >> 7, tk = tl / ntn, tn = tl % ntn;
    TTile r; r.src = src + (size_t)tk * 128 * N + tn * 128; r.dst = dst + (size_t)tn * 128 * K + tk * 128; r.K = K; r.N = N; return r;
}
__device__ __forceinline__ int my_ttile(int j) {
    constexpr int NT = 5760;
    const int nb = gridDim.x, blk = blockIdx.x;
    int idx;
    if (nb == 256) { if (blk >= 96) idx = j < 12 ? j * 160 + (blk - 96) : 1920 + (j - 12) * 256 + blk; else idx = 1920 + j * 256 + blk; }
    else idx = j * nb + blk;
    return idx < NT ? idx : -1;
}
__device__ __forceinline__ void transpose_stream(const Params& p, LAS unsigned* lds, int wv) {
    const int t = opaque_tid(wv), c4 = t & 31, rp = t >> 5;
    f32x4 a[4], b[4];
    int j = 0, it = my_ttile(0), itl = it;
    if (it < 0) return;
    TTile cur = ttile_of(p, it), ld = cur;
#define T_LOAD() do { _Pragma("unroll") for (int ps = 0; ps < 4; ++ps) { const int r = 2 * (rp + 16 * ps); \
        a[ps] = *(const f32x4*)(ld.src + (size_t)r * ld.N + c4 * 4); b[ps] = *(const f32x4*)(ld.src + (size_t)(r + 1) * ld.N + c4 * 4); } } while (0)
#define T_WRITE(buf) do { _Pragma("unroll") for (int ps = 0; ps < 4; ++ps) { const int kp = rp + 16 * ps; \
        _Pragma("unroll") for (int jj = 0; jj < 4; ++jj) { const int n = c4 * 4 + jj; lds[(buf) * 8192 + n * 64 + (kp ^ (((n >> 2) & 7) << 2))] = pk2(a[ps][jj], b[ps][jj]); } } } while (0)
    __syncthreads();
    T_LOAD(); T_WRITE(0);
    int jl = 1; itl = my_ttile(1); if (itl >= 0) { ld = ttile_of(p, itl); T_LOAD(); }
    int bsel = 0;
    for (;;) {
        __syncthreads();
        TTile nxt = ld; const int itn = itl;
        if (itl >= 0) { T_WRITE(bsel ^ 1); ++jl; itl = my_ttile(jl); if (itl >= 0) { ld = ttile_of(p, itl); T_LOAD(); } }
#pragma unroll
        for (int i = 0; i < 4; ++i) { const int n = (t >> 4) + 32 * i, ch = t & 15;
            const u32x4 v = *(const LAS u32x4*)(lds + bsel * 8192 + n * 64 + ((4 * ch) ^ (((n >> 2) & 7) << 2)));
            *(u32x4*)(cur.dst + (size_t)n * cur.K + ch * 8) = v; }
        if (itn < 0) break;
        cur = nxt; bsel ^= 1; ++j;
    }
#undef T_LOAD
#undef T_WRITE
}

__device__ __forceinline__ void phase0(const Params& p, LAS unsigned char* lds, int wv) {
    const int tid = opaque_tid(wv);
    for (int it = blockIdx.x; it < 96; it += gridDim.x) ada_item(p, it, (LAS float*)lds, wv);
    transpose_stream(p, (LAS unsigned*)lds, wv);
    const size_t gtid = (size_t)blockIdx.x * 512 + tid, gstride = (size_t)gridDim.x * 512;
    {
        bf16_t* KE = (bf16_t*)(p.ws + WS_KEA); bf16_t* VE = (bf16_t*)(p.ws + WS_VEA);
        for (size_t i0 = gtid; i0 < (size_t)8 * 576 * 512; i0 += 2 * gstride) {
            f32x4 a[2], c[2]; bool ok[2], ld[2];
#pragma unroll
            for (int q = 0; q < 2; ++q) { const size_t i = i0 + q * gstride; ok[q] = i < (size_t)8 * 576 * 512; const int c4 = (int)(i & 511); const int r = (int)((i >> 9) % 576), b = (int)((i >> 9) / 576);
                ld[q] = ok[q] && r < 512; if (ld[q]) { const size_t sidx = ((size_t)(b * 512 + r)) * 2048 + c4 * 4; a[q] = *(const f32x4*)(p.cache_a_k + sidx); c[q] = *(const f32x4*)(p.cache_a_v + sidx); } }
#pragma unroll
            for (int q = 0; q < 2; ++q) { const size_t i = i0 + q * gstride; if (ok[q]) { u32x2 k = {0u, 0u}, v = {0u, 0u};
                if (ld[q]) { k[0] = pk2(a[q][0], a[q][1]); k[1] = pk2(a[q][2], a[q][3]); v[0] = pk2(c[q][0], c[q][1]); v[1] = pk2(c[q][2], c[q][3]); }
                *(u32x2*)(KE + i * 4) = k; *(u32x2*)(VE + i * 4) = v; } }
        }
    }
    {
        bf16_t* KE = (bf16_t*)(p.ws + WS_KEB); bf16_t* VE = (bf16_t*)(p.ws + WS_VEB);
        for (size_t i = gtid; i < (size_t)8 * 192 * 128; i += gstride) { const int c4 = (int)(i & 127); const int r = (int)((i >> 7) % 192), b = (int)((i >> 7) / 192);
            u32x2 k = {0u, 0u}, v = {0u, 0u};
            if (r < 128) { const size_t s = ((size_t)(b * 128 + r)) * 512 + c4 * 4; const f32x4 a = *(const f32x4*)(p.cache_b_k + s), c = *(const f32x4*)(p.cache_b_v + s);
                k[0] = pk2(a[0], a[1]); k[1] = pk2(a[2], a[3]); v[0] = pk2(c[0], c[1]); v[1] = pk2(c[2], c[3]); }
            *(u32x2*)(KE + i * 4) = k; *(u32x2*)(VE + i * 4) = v; }
    }
    {
        float* rope = (float*)(p.ws + WS_ROPE);
        for (size_t i = gtid; i < (size_t)4112 * 8; i += gstride) { const int f = (int)(i & 7), pi = (int)(i >> 3); const int pos = pi < 4096 ? pi : 1024 + (pi - 4096);
            const double fr = f == 0 ? 1.0 : f == 1 ? 0.19392274474868576 : f == 2 ? 0.03760603093086393 : f == 3 ? 0.007292664737217109 : f == 4 ? 0.001414213562373095 : f == 5 ? 0.0002742481756762073 : f == 6 ? 5.318295896944988e-05 : 1.031338537721246e-05;
            double rev = (double)pos * fr * 0.15915494309189535; rev -= __builtin_rint(rev);
            const float rf = (float)rev;
            rope[(size_t)pi * 16 + f] = __builtin_amdgcn_cosf(rf); rope[(size_t)pi * 16 + 8 + f] = __builtin_amdgcn_sinf(rf); }
    }
}

__device__ __forceinline__ void modulate0(const Params& p, int wv) {
    const float* mod = (const float*)(p.ws + WS_MOD); bf16_t* H = (bf16_t*)(p.ws + WS_H);
    const size_t gtid = (size_t)blockIdx.x * 512 + opaque_tid(wv), gstride = (size_t)gridDim.x * 512, n = (size_t)NREAL * 512;
    for (size_t i0 = gtid; i0 < n; i0 += 4 * gstride) {
        f32x4 x[4], sh[4], sc[4];
#pragma unroll
        for (int q = 0; q < 4; ++q) { const size_t i = i0 + q * gstride; if (i < n) { const int row = (int)(i >> 9), c = (int)(i & 511) * 4;
            const float* xr = row < NP ? p.x_prompt + (size_t)row * 2048 : p.x_sample + (size_t)(row - NP) * 2048;
            const int r16 = row < NP ? (row >> 12) : 8 + ((row - NP) >> 4);
            x[q] = *(const f32x4*)(xr + c); sh[q] = *(const f32x4*)(mod + (size_t)r16 * 6144 + c); sc[q] = *(const f32x4*)(mod + (size_t)r16 * 6144 + 2048 + c); } }
#pragma unroll
        for (int q = 0; q < 4; ++q) { const size_t i = i0 + q * gstride; if (i < n) { const int row = (int)(i >> 9), c = (int)(i & 511) * 4;
            const f32x4 h = x[q] * (sc[q] + 1.f) + sh[q];
            u32x2 o; o[0] = pk2(h[0], h[1]); o[1] = pk2(h[2], h[3]);
            *(u32x2*)(H + (size_t)row * 2048 + c) = o; } }
    }
}

#define LN_UNPACK(v, raw) do { _Pragma("unroll") for (int i = 0; i < 4; ++i) { v[2 * i][0] = bf_lo(raw[i][0]); v[2 * i][1] = bf_hi(raw[i][0]); v[2 * i][2] = bf_lo(raw[i][1]); v[2 * i][3] = bf_hi(raw[i][1]); \
        v[2 * i + 1][0] = bf_lo(raw[i][2]); v[2 * i + 1][1] = bf_hi(raw[i][2]); v[2 * i + 1][2] = bf_lo(raw[i][3]); v[2 * i + 1][3] = bf_hi(raw[i][3]); } } while (0)
#define LN_STATS(v, mu, rstd) float mu, rstd; do { float s_ = 0.f; \
        _Pragma("unroll") for (int i = 0; i < 8; ++i) s_ += (v[i][0] + v[i][1]) + (v[i][2] + v[i][3]); \
        s_ = wave_sum(s_); \
        mu = s_ * (1.f / 2048.f); float q_ = 0.f; \
        _Pragma("unroll") for (int i = 0; i < 8; ++i) { v[i] = v[i] - mu; q_ += (v[i][0] * v[i][0] + v[i][1] * v[i][1]) + (v[i][2] * v[i][2] + v[i][3] * v[i][3]); } \
        q_ = wave_sum(q_); \
        rstd = __builtin_amdgcn_rsqf(q_ * (1.f / 2048.f) + 1e-5f); } while (0)
__device__ __forceinline__ void ln_rows_generic(const Params& p, const float* g, const float* bta, const float* mod_next, int row_begin, int row_end, int wv) {
    float* Y = p.out; bf16_t* H = (bf16_t*)(p.ws + WS_H); const bf16_t* Z = (const bf16_t*)(p.ws + WS_Z); float* ST = (float*)(p.ws + WS_STATS);
    const int tid = opaque_tid(wv), wid = tid >> 6, lane = tid & 63;
    for (int row = row_begin + blockIdx.x * 8 + wid; row < row_end; row += gridDim.x * 8) {
        u32x4 raw[4];
#pragma unroll
        for (int i = 0; i < 4; ++i) raw[i] = *(const u32x4*)(Z + (size_t)row * 2048 + i * 512 + lane * 8);
        f32x4 v[8]; LN_UNPACK(v, raw);
        LN_STATS(v, mu, rstd);
        const int r16 = row < NP ? (row >> 12) : 8 + ((row - NP) >> 4);
        if (mod_next && lane == 0) { f32x2 st; st[0] = mu; st[1] = rstd; *(f32x2*)(ST + (size_t)row * 2) = st; }
        f32x4 pg[8], pb[8], psh[8], psc[8];
#pragma unroll
        for (int i = 0; i < 8; ++i) { const int c = (i >> 1) * 512 + lane * 8 + (i & 1) * 4; pg[i] = *(const f32x4*)(g + c); pb[i] = *(const f32x4*)(bta + c);
            if (mod_next) { const float* mp = mod_next + (size_t)r16 * 6144 + c; psh[i] = *(const f32x4*)mp; psc[i] = *(const f32x4*)(mp + 2048); } }
#pragma unroll
        for (int i = 0; i < 4; ++i) { const int c = i * 512 + lane * 8;
            f32x4 y0 = v[2 * i] * rstd * pg[2 * i] + pb[2 * i], y1 = v[2 * i + 1] * rstd * pg[2 * i + 1] + pb[2 * i + 1];
            if (!mod_next) { *(f32x4*)(Y + (size_t)row * 2048 + c) = y0; *(f32x4*)(Y + (size_t)row * 2048 + c + 4) = y1; }
            else { y0 = y0 * (psc[2 * i] + 1.f) + psh[2 * i]; y1 = y1 * (psc[2 * i + 1] + 1.f) + psh[2 * i + 1];
                u32x4 o; o[0] = pk2(y0[0], y0[1]); o[1] = pk2(y0[2], y0[3]); o[2] = pk2(y1[0], y1[1]); o[3] = pk2(y1[2], y1[3]);
                *(u32x4*)(H + (size_t)row * 2048 + c) = o; } }
    }
}
template <bool MOD>
__device__ __forceinline__ void ln_rows_prompt(const Params& p, const float* g, const float* bta, const float* mod_next, int wv) {
    float* Y = p.out; bf16_t* H = (bf16_t*)(p.ws + WS_H); const bf16_t* Z = (const bf16_t*)(p.ws + WS_Z); float* ST = (float*)(p.ws + WS_STATS);
    const int tid = opaque_tid(wv), wid = tid >> 6, lane = tid & 63;
    const int rpw = NP / (gridDim.x * 8);
    const int row0 = (blockIdx.x * 8 + wid) * rpw, r16 = row0 >> 12, rend = row0 + rpw;
    f32x4 G[8], B[8];
#pragma unroll
    for (int i = 0; i < 8; ++i) { const int c = (i >> 1) * 512 + lane * 8 + (i & 1) * 4; G[i] = *(const f32x4*)(g + c); B[i] = *(const f32x4*)(bta + c);
        if (MOD) { const f32x4 sh = *(const f32x4*)(mod_next + (size_t)r16 * 6144 + c), sc = *(const f32x4*)(mod_next + (size_t)r16 * 6144 + 2048 + c);
            G[i] = G[i] * (sc + 1.f); B[i] = B[i] * (sc + 1.f) + sh; } }
    u32x4 ra[4], rb[4], rc[4];
#define LN_LOAD(raw, row) do { if ((row) < rend) { const bf16_t* _z = Z + (size_t)(row) * 2048 + lane * 8; _Pragma("unroll") for (int i = 0; i < 4; ++i) raw[i] = *(const u32x4*)(_z + i * 512); } } while (0)
#define LN_PROC(raw, row) do { if ((row) < rend) { f32x4 v[8]; LN_UNPACK(v, raw); LN_STATS(v, mu, rstd); \
        if (MOD && lane == 0) { f32x2 st; st[0] = mu; st[1] = rstd; *(f32x2*)(ST + (size_t)(row) * 2) = st; } \
        _Pragma("unroll") for (int i = 0; i < 4; ++i) { const f32x4 h0 = v[2 * i] * rstd * G[2 * i] + B[2 * i], h1 = v[2 * i + 1] * rstd * G[2 * i + 1] + B[2 * i + 1]; \
            if (!MOD) { float* _y = Y + (size_t)(row) * 2048 + i * 512 + lane * 8; *(f32x4*)_y = h0; *(f32x4*)(_y + 4) = h1; } \
            else { u32x4 o; o[0] = pk2(h0[0], h0[1]); o[1] = pk2(h0[2], h0[3]); o[2] = pk2(h1[0], h1[1]); o[3] = pk2(h1[2], h1[3]); *(u32x4*)(H + (size_t)(row) * 2048 + i * 512 + lane * 8) = o; } } } } while (0)
    LN_LOAD(ra, row0); LN_LOAD(rb, row0 + 1);
    for (int r = row0; r < rend; r += 3) {
        LN_LOAD(rc, r + 2);
        LN_PROC(ra, r);
        LN_LOAD(ra, r + 3);
        LN_PROC(rb, r + 1);
        LN_LOAD(rb, r + 4);
        LN_PROC(rc, r + 2);
    }
#undef LN_LOAD
#undef LN_PROC
}
__device__ __forceinline__ void ln_phase(const Params& p, const float* g, const float* bta, const float* mod_next, int wv) {
    const bool fast = (NP % (gridDim.x * 16) == 0) && (4096 % (NP / (gridDim.x * 8)) == 0);
    if (fast) { if (mod_next) ln_rows_prompt<true>(p, g, bta, mod_next, wv); else ln_rows_prompt<false>(p, g, bta, mod_next, wv); }
    ln_rows_generic(p, g, bta, mod_next, fast ? NP : 0, NREAL, wv);
}

template <int D, int KS, bool BIAS, bool MSUM = false>
__device__ __forceinline__ void attn_qk(const LAS unsigned char* Kl, const bf16x8 (&qf)[2][D / 32], float (&m)[2], float (&l)[2], bf16x8 (&pf)[2][2], float (&alpha)[2],
                                        float sc2, int jbase, int jhi, int qi, const LAS float* btab, int lane) {
    const int g = lane >> 4, l15 = lane & 15;
    f32x4 s[2][4];
    const LAS unsigned char* kp = Kl + l15 * KS + g * 16;
    bf16x8 kf[2][D / 32];
#pragma unroll
    for (int ks = 0; ks < D / 32; ++ks) kf[0][ks] = *(const LAS bf16x8*)(kp + ks * 64);
#pragma unroll
    for (int sub = 0; sub < 4; ++sub) { s[0][sub] = (f32x4){0.f, 0.f, 0.f, 0.f}; s[1][sub] = s[0][sub];
        if (sub + 1 < 4) {
#pragma unroll
            for (int ks = 0; ks < D / 32; ++ks) kf[(sub + 1) & 1][ks] = *(const LAS bf16x8*)(kp + (sub + 1) * 16 * KS + ks * 64);
        }
#pragma unroll
        for (int ks = 0; ks < D / 32; ++ks) {
            s[0][sub] = __builtin_amdgcn_mfma_f32_16x16x32_bf16(kf[sub & 1][ks], qf[0][ks], s[0][sub], 0, 0, 0);
            s[1][sub] = __builtin_amdgcn_mfma_f32_16x16x32_bf16(kf[sub & 1][ks], qf[1][ks], s[1][sub], 0, 0, 0); }
        __builtin_amdgcn_sched_barrier(0); }
    const bool far = BIAS && (jbase + 63 + 128 <= 512);
    const bool part = jbase + 64 > jhi;
    const float bfar = BIAS ? btab[0] : 0.f;
    const LAS float* brow = BIAS ? btab + (64 + jbase - qi + 4 * g) : btab;
    if (part) {
#pragma unroll
        for (int u = 0; u < 2; ++u)
#pragma unroll
            for (int sub = 0; sub < 4; ++sub)
#pragma unroll
                for (int j = 0; j < 4; ++j) if (jbase + sub * 16 + g * 4 + j >= jhi) s[u][sub][j] = -3e38f;
    }
#pragma unroll
    for (int u = 0; u < 2; ++u) {
        float mn, ls = 0.f;
        if (!BIAS || far) {
            float mx = -3e38f;
#pragma unroll
            for (int sub = 0; sub < 4; ++sub)
#pragma unroll
                for (int j = 0; j < 4; ++j) mx = fmaxf(mx, s[u][sub][j]);
            mx = xmax32(xmax16(mx));
            mn = fmaxf(m[u], __builtin_fmaf(mx, sc2, bfar)); alpha[u] = __builtin_amdgcn_exp2f(m[u] - mn); m[u] = mn;
            const float c = bfar - mn;
#pragma unroll
            for (int sub = 0; sub < 4; ++sub)
#pragma unroll
                for (int j = 0; j < 4; ++j) { const float pv = a_exp2(a_fma(s[u][sub][j], sc2, c)); s[u][sub][j] = pv; if (!MSUM) ls = a_add(ls, pv); }
        } else {
            float mx = -1e30f;
#pragma unroll
            for (int sub = 0; sub < 4; ++sub)
#pragma unroll
                for (int j = 0; j < 4; ++j) { float v = __builtin_fmaf(s[u][sub][j], sc2, brow[sub * 16 + 16 - 16 * u + j]);
                    s[u][sub][j] = v; mx = fmaxf(mx, v); }
            mx = xmax32(xmax16(mx));
            mn = fmaxf(m[u], mx); alpha[u] = __builtin_amdgcn_exp2f(m[u] - mn); m[u] = mn;
#pragma unroll
            for (int sub = 0; sub < 4; ++sub)
#pragma unroll
                for (int j = 0; j < 4; ++j) { const float pv = a_exp2(a_sub(s[u][sub][j], mn)); s[u][sub][j] = pv; if (!MSUM) ls = a_add(ls, pv); }
        }
        if (!MSUM) l[u] = l[u] * alpha[u] + ls;
#pragma unroll
        for (int t = 0; t < 2; ++t) { u32x4 w; w[0] = pk2(s[u][2 * t][0], s[u][2 * t][1]); w[1] = pk2(s[u][2 * t][2], s[u][2 * t][3]); w[2] = pk2(s[u][2 * t + 1][0], s[u][2 * t + 1][1]); w[3] = pk2(s[u][2 * t + 1][2], s[u][2 * t + 1][3]);
            pf[u][t] = __builtin_bit_cast(bf16x8, w); }
    }
}
template <int D, int VS, bool MSUM = false>
__device__ __forceinline__ void attn_pv(const LAS unsigned char* Vl, f32x4 (&o)[2][D / 16], const bf16x8 (&pf)[2][2], const float (&alpha)[2], int lane, f32x4* lm = nullptr) {
    const int g = lane >> 4, q4 = (lane >> 2) & 3, p4 = lane & 3;
    const LAS unsigned char* vb = Vl + (g * 4 + q4) * VS + p4 * 8;
    if (__builtin_amdgcn_ballot_w64(alpha[0] != 1.f || alpha[1] != 1.f) != 0ull) {
#pragma unroll
        for (int ds = 0; ds < D / 16; ++ds) { o[0][ds] = o[0][ds] * alpha[0]; o[1][ds] = o[1][ds] * alpha[1]; }
        if (MSUM) { lm[0] = lm[0] * alpha[0]; lm[1] = lm[1] * alpha[1]; }
    }
    if (MSUM) {
        const bf16x8 ones = {0x3F80, 0x3F80, 0x3F80, 0x3F80, 0x3F80, 0x3F80, 0x3F80, 0x3F80};
#pragma unroll
        for (int t = 0; t < 2; ++t) { lm[0] = __builtin_amdgcn_mfma_f32_16x16x32_bf16(ones, pf[0][t], lm[0], 0, 0, 0); lm[1] = __builtin_amdgcn_mfma_f32_16x16x32_bf16(ones, pf[1][t], lm[1], 0, 0, 0); }
    }
    bf16x8 vf[2][2];
#define PV_READ(buf, ds_) do { _Pragma("unroll") for (int t = 0; t < 2; ++t) { \
        const bf16x4 a1 = __builtin_amdgcn_ds_read_tr16_b64_v4i16((LAS bf16x4*)(vb + (t * 32) * VS + (ds_) * 32)); \
        const bf16x4 a2 = __builtin_amdgcn_ds_read_tr16_b64_v4i16((LAS bf16x4*)(vb + (t * 32 + 16) * VS + (ds_) * 32)); \
        vf[buf][t] = __builtin_shufflevector(a1, a2, 0, 1, 2, 3, 4, 5, 6, 7); } } while (0)
    PV_READ(0, 0);
#pragma unroll
    for (int ds = 0; ds < D / 16; ++ds) {
        if (ds + 1 < D / 16) PV_READ((ds + 1) & 1, ds + 1);
#pragma unroll
        for (int t = 0; t < 2; ++t) {
            o[0][ds] = __builtin_amdgcn_mfma_f32_16x16x32_bf16(vf[ds & 1][t], pf[0][t], o[0][ds], 0, 0, 0);
            o[1][ds] = __builtin_amdgcn_mfma_f32_16x16x32_bf16(vf[ds & 1][t], pf[1][t], o[1][ds], 0, 0, 0); }
        __builtin_amdgcn_sched_barrier(0);
    }
#undef PV_READ
}

struct AUnit { const bf16_t* kb; const bf16_t* vb; long qrow0; int hq, jt0, jhi, qvalid; };
__device__ __forceinline__ AUnit attn_a_unit(const Params& p, int u) {
    AUnit r; const bf16_t* Q = (const bf16_t*)(p.ws + WS_BIG); const bf16_t* Kg = Q + (size_t)MP * 2048; const bf16_t* Vg = Kg + (size_t)MP * 2048;
    if (u >= 1792 && u < 1824) { const int su = u - 1792, b = su >> 2; r.hq = su & 3; r.qrow0 = NP + b * 16; r.kb = (const bf16_t*)(p.ws + WS_KEA) + (size_t)b * 576 * 2048; r.vb = (const bf16_t*)(p.ws + WS_VEA) + (size_t)b * 576 * 2048; r.jt0 = 0; r.jhi = 528; r.qvalid = 16; return r; }
    int c, v;
    if (u < 1792) { v = u; c = 8 + (u >> 5); } else { v = u - 1824; c = 7 - (v >> 5); }
    const int b = (v >> 2) & 7; r.hq = v & 3; r.qrow0 = (long)b * 4096 + c * 64; r.kb = Kg + (r.qrow0 - 512) * 2048; r.vb = Vg + (r.qrow0 - 512) * 2048; r.jt0 = c < 8 ? 8 - c : 0; r.jhi = 576; r.qvalid = 64;
    return r;
}
__device__ __forceinline__ void attn_a_phase(const Params& p, LAS unsigned char* lds, int wv) {
    constexpr int KS = 1056, VS = 1056, NU = 2080;
    const int tid = opaque_tid(wv), wid = tid >> 6, lane = tid & 63, g = lane >> 4, l15 = lane & 15, hh = wid >> 1, rg = wid & 1;
    LAS unsigned char* Kl = lds; LAS unsigned char* Vl = lds + 64 * KS; LAS float* btab = (LAS float*)(lds + 64 * KS + 64 * VS);
    const bf16_t* Q = (const bf16_t*)(p.ws + WS_BIG);
    bf16_t* O = (bf16_t*)(p.ws + WS_H);
    const float sc2 = 0.08838834764831845f * LOG2E;
    const int skey = tid >> 6, sch = tid & 63;
    u32x4 kr[8], vr[8];
    int unit = blockIdx.x;
    if (unit >= NU) return;
    AUnit cu = attn_a_unit(p, unit);
    const unsigned voff = (unsigned)(skey * 2048 + sch * 8) * 2u;
    { const size_t ub = ((size_t)cu.jt0 * 64 * 2048 + cu.hq * 512) * 2;
#pragma unroll
      for (int i = 0; i < 8; ++i) { kr[i] = *(const u32x4*)((const char*)cu.kb + ub + (size_t)i * 32768 + voff); vr[i] = *(const u32x4*)((const char*)cu.vb + ub + (size_t)i * 32768 + voff); } }
    for (;;) {
        const int nunit = unit + gridDim.x; const bool has_next = nunit < NU;
        AUnit nu = cu; if (has_next) nu = attn_a_unit(p, nunit);
        const int h = cu.hq * 4 + hh;
        __syncthreads();
        int tid2 = tid; asm volatile("" : "+v"(tid2));
        float tb[6];
#pragma unroll
        for (int k = 0; k < 6; ++k) { int i = tid2 + 512 * k; i = i < 4 * 656 ? i : 4 * 656 - 1; const int h2 = i / 656, x = i - h2 * 656, r = x - 80; const int ti = r <= 384 ? 256 : 640 - r;
            tb[k] = p.rel_bias_a[(cu.hq * 4 + h2) * 257 + ti]; }
#pragma unroll
        for (int k = 0; k < 6; ++k) { const int i = tid2 + 512 * k;
            if (i < 4 * 656) { const int h2 = i / 656, x = i - h2 * 656; btab[h2 * 672 + x] = tb[k] * LOG2E; } }
        bf16x8 qf[2][4];
        { const int l15b = tid2 & 15, gb = (tid2 >> 4) & 3;
          const bf16_t* qp = Q + (size_t)(cu.qrow0 + rg * 32 + l15b) * 2048 + h * 128 + gb * 8;
#pragma unroll
          for (int u = 0; u < 2; ++u)
#pragma unroll
            for (int ks = 0; ks < 4; ++ks) qf[u][ks] = *(const bf16x8*)(qp + (size_t)u * 16 * 2048 + ks * 32); }
        f32x4 o[2][8];
#pragma unroll
        for (int u = 0; u < 2; ++u)
#pragma unroll
            for (int i = 0; i < 8; ++i) o[u][i] = (f32x4){0.f, 0.f, 0.f, 0.f};
        float m[2] = {-1e30f, -1e30f}, l[2] = {0.f, 0.f};
        for (int jt = cu.jt0; jt < 9; ++jt) {
            __syncthreads();
#pragma unroll
            for (int i = 0; i < 8; ++i) { *(LAS u32x4*)(Kl + (skey + 8 * i) * KS + sch * 16) = kr[i]; *(LAS u32x4*)(Vl + (skey + 8 * i) * VS + sch * 16) = vr[i]; }
            __syncthreads();
            const bool more = jt + 1 < 9;
            const size_t nub = ((size_t)(more ? jt + 1 : nu.jt0) * 64 * 2048 + (more ? cu.hq : nu.hq) * 512) * 2;
            const char* nkb = (const char*)(more ? cu.kb : nu.kb) + nub; const char* nvb = (const char*)(more ? cu.vb : nu.vb) + nub;
            if (more || has_next) {
#pragma unroll
                for (int i = 0; i < 8; ++i) kr[i] = *(const u32x4*)(nkb + (size_t)i * 32768 + voff);
            }
            bf16x8 pf[2][2]; float alpha[2];
            attn_qk<128, KS, true>(Kl + hh * 256, qf, m, l, pf, alpha, sc2, jt * 64, cu.jhi, rg * 32 + l15, btab + hh * 672, lane);
            __builtin_amdgcn_sched_barrier(0);
            if (more || has_next) {
#pragma unroll
                for (int i = 0; i < 8; ++i) vr[i] = *(const u32x4*)(nvb + (size_t)i * 32768 + voff);
            }
            __builtin_amdgcn_sched_barrier(0);
            attn_pv<128, VS>(Vl + hh * 256, o, pf, alpha, lane);
        }
#pragma unroll
        for (int u = 0; u < 2; ++u) {
            float lt = l[u]; lt = xsum32(xsum16(lt));
            const float inv = 1.f / lt;
            int tid3 = tid; asm volatile("" : "+v"(tid3)); const int l15c = tid3 & 15, gc = (tid3 >> 4) & 3;
            if (rg * 32 + u * 16 + l15c < cu.qvalid) { bf16_t* op = O + (size_t)(cu.qrow0 + rg * 32 + u * 16 + l15c) * 2048 + h * 128 + gc * 4;
#pragma unroll
                for (int ds = 0; ds < 8; ++ds) { u32x2 w; w[0] = pk2(o[u][ds][0] * inv, o[u][ds][1] * inv); w[1] = pk2(o[u][ds][2] * inv, o[u][ds][3] * inv); *(u32x2*)(op + ds * 16) = w; } }
        }
        if (!has_next) break;
        cu = nu; unit = nunit;
    }
}

struct BUnit { const bf16_t* kb; const bf16_t* vb; long qrow0; int kvh, jt0, jhi, qvalid; };
__device__ __forceinline__ BUnit attn_b_unit(const Params& p, int u) {
    BUnit r; const bf16_t* Q = (const bf16_t*)(p.ws + WS_BIG); const bf16_t* Kg = Q + (size_t)MP * 2048; const bf16_t* Vg = Kg + (size_t)MP * 512;
    if (u >= 3968 && u < 4032) { const int su = u - 3968, b = su >> 3; r.kvh = su & 7; r.qrow0 = NP + b * 16; r.kb = (const bf16_t*)(p.ws + WS_KEB) + (size_t)b * 192 * 512; r.vb = (const bf16_t*)(p.ws + WS_VEB) + (size_t)b * 192 * 512; r.jt0 = 0; r.jhi = 144; r.qvalid = 16; return r; }
    int c, v;
    if (u < 3968) { v = u; c = 2 + (u >> 6); } else { v = u - 4032; c = 1 - (v >> 6); }
    const int b = (v >> 3) & 7; r.kvh = v & 7; r.qrow0 = (long)b * 4096 + c * 64; r.kb = Kg + (r.qrow0 - 128) * 512; r.vb = Vg + (r.qrow0 - 128) * 512; r.jt0 = c < 2 ? 2 - c : 0; r.jhi = 192; r.qvalid = 64;
    return r;
}
__device__ __forceinline__ void attn_b_phase(const Params& p, LAS unsigned char* lds, unsigned long long& pb_acc, int wv) {
    unsigned long long pb_t0 = 0; (void)pb_t0;
    constexpr int KS = 160, VS = 160, NU = 4160;
    const int tid = opaque_tid(wv), wid = tid >> 6, lane = tid & 63, g = lane >> 4, l15 = lane & 15;
    LAS unsigned char* Kl = lds; LAS unsigned char* Vl = lds + 192 * KS;
    const bf16_t* Q = (const bf16_t*)(p.ws + WS_BIG);
    bf16_t* O = (bf16_t*)(p.ws + WS_H);
    const float sc2 = 0.125f * LOG2E;
    const int qloc = (wid & 1) * 32 + l15;
    u32x4 kr[3], vr[3];
    bf16x8 qf[2][2], qn[2][2]; float sink_c = 0.f, sink_n = 0.f;
    int unit = blockIdx.x;
    if (unit >= NU) return;
    BUnit cu = attn_b_unit(p, unit);
#define B_LOAD(u_, q_, sk_) do { _Pragma("unroll") for (int i = 0; i < 3; ++i) { const int ci = tid + 512 * i, key = ci >> 3, ch = ci & 7; \
            if (key >= (u_).jt0 * 64) { const size_t off = (size_t)key * 512 + (u_).kvh * 64 + ch * 8; kr[i] = *(const u32x4*)((u_).kb + off); vr[i] = *(const u32x4*)((u_).vb + off); } } \
        { const bf16_t* qp = Q + (size_t)((u_).qrow0 + qloc) * 2048 + ((u_).kvh * 4 + (wid >> 1)) * 64 + g * 8; \
          _Pragma("unroll") for (int u = 0; u < 2; ++u) { q_[u][0] = *(const bf16x8*)(qp + (size_t)u * 16 * 2048); q_[u][1] = *(const bf16x8*)(qp + (size_t)u * 16 * 2048 + 32); } } \
        sk_ = p.sink_b[(u_).kvh * 4 + (wid >> 1)]; } while (0)
    B_LOAD(cu, qf, sink_c);
    for (;;) {
        const int nunit = unit + gridDim.x; const bool has_next = nunit < NU;
        BUnit nu = cu; if (has_next) nu = attn_b_unit(p, nunit);
        PB_BEGIN(512);
        __syncthreads();
#pragma unroll
        for (int i = 0; i < 3; ++i) { const int ci = tid + 512 * i, key = ci >> 3, ch = ci & 7;
            if (key >= cu.jt0 * 64) { *(LAS u32x4*)(Kl + key * KS + ch * 16) = kr[i]; *(LAS u32x4*)(Vl + key * VS + ch * 16) = vr[i]; } }
        __syncthreads();
        PB_END(512);
        if (has_next) B_LOAD(nu, qn, sink_n);
        const int h = cu.kvh * 4 + (wid >> 1);
        const float sink2 = sink_c * LOG2E;
        f32x4 o[2][4];
#pragma unroll
        for (int u = 0; u < 2; ++u)
#pragma unroll
            for (int i = 0; i < 4; ++i) o[u][i] = (f32x4){0.f, 0.f, 0.f, 0.f};
        float m[2] = {sink2, sink2}, l[2] = {0.f, 0.f}; f32x4 lm[2]; lm[0] = (f32x4){1.f, 1.f, 1.f, 1.f}; lm[1] = lm[0];
        PB_BEGIN(1024);
        for (int jt = cu.jt0; jt < 3; ++jt) { bf16x8 pf[2][2]; float alpha[2];
            attn_qk<64, KS, false, true>(Kl + jt * 64 * KS, qf, m, l, pf, alpha, sc2, jt * 64, cu.jhi, qloc, nullptr, lane);
            attn_pv<64, VS, true>(Vl + jt * 64 * VS, o, pf, alpha, lane, lm); }
        PB_END(1024);
#pragma unroll
        for (int u = 0; u < 2; ++u) {
            const float lt = lm[u][0];
            const float inv = 1.f / lt;
            if (qloc + 16 * u < cu.qvalid) { bf16_t* op = O + (size_t)(cu.qrow0 + qloc + 16 * u) * 2048 + h * 64 + g * 4;
#pragma unroll
                for (int ds = 0; ds < 4; ++ds) { u32x2 w; w[0] = pk2(o[u][ds][0] * inv, o[u][ds][1] * inv); w[1] = pk2(o[u][ds][2] * inv, o[u][ds][3] * inv); *(u32x2*)(op + ds * 16) = w; } }
        }
        if (!has_next) break;
#pragma unroll
        for (int u = 0; u < 2; ++u) { qf[u][0] = qn[u][0]; qf[u][1] = qn[u][1]; }
        sink_c = sink_n;
        cu = nu; unit = nunit;
    }
#undef B_LOAD
}

#define XB_TMO      128
#define XB_XCNT(j)  (256  + 64 * (j))
#define XB_XSUB(j)  (1280 + 64 * (j))
#define XB_XGEN(j)  (2304 + 64 * (j))
#define XB_TOP      3328
#define XB_TOPGEN   3392
#define XCD_BAR_WORDS 3456
#define XB_SPIN_CAP (1u << 18)
__device__ __forceinline__ unsigned xb_ld(unsigned* p)              { return __hip_atomic_load(p, __ATOMIC_RELAXED, __HIP_MEMORY_SCOPE_AGENT); }
__device__ __forceinline__ unsigned xb_add(unsigned* p, unsigned v) { return __hip_atomic_fetch_add(p, v, __ATOMIC_RELAXED, __HIP_MEMORY_SCOPE_AGENT); }
__device__ __forceinline__ unsigned xb_xcc_id() { return (unsigned)__builtin_amdgcn_s_getreg((3 << 11) | 20) & 0xFu; }
#define XB_SPIN(cond, bar) do { unsigned _sp = 0; while (cond) { __builtin_amdgcn_s_sleep(1); \
    if ((++_sp & 255u) == 0u) { if (xb_ld(&(bar)[XB_TMO])) break; if (_sp > XB_SPIN_CAP) { atomicAdd(&(bar)[XB_TMO], 1u); break; } } } } while (0)
struct XcdBarrier { unsigned* bar; unsigned x; volatile LAS unsigned* st; };
__device__ __forceinline__ XcdBarrier xcd_barrier_post(unsigned* bar, volatile LAS unsigned* st) {
    XcdBarrier b; b.bar = bar; b.x = xb_xcc_id(); b.st = st;
    if (threadIdx.x == 0) (void)xb_add(&bar[XB_XCNT(b.x)], 1u);
    return b;
}
__device__ __forceinline__ void xcd_barrier_complete(unsigned* bar, unsigned x, unsigned& nloc, unsigned& nx) {
    const unsigned G = gridDim.x * gridDim.y * gridDim.z;
    unsigned sum, cnt, mine, sp = 0u;
    for (;;) {
        sum = 0u; cnt = 0u; mine = 0u;
#pragma unroll
        for (unsigned j = 0; j < 16; ++j) { const unsigned c = xb_ld(&bar[XB_XCNT(j)]); sum += c; cnt += (c > 0u) ? 1u : 0u; mine = (j == x) ? c : mine; }
        if (sum == G) break;
        __builtin_amdgcn_s_sleep(1);
        if ((++sp & 255u) == 0u) { if (xb_ld(&bar[XB_TMO])) break; if (sp > XB_SPIN_CAP) { atomicAdd(&bar[XB_TMO], 1u); break; } }
    }
    nloc = mine > 0u ? mine : 1u; nx = cnt > 0u ? cnt : 1u;
}
__device__ __forceinline__ void xcd_barrier(const XcdBarrier& b, bool leader) {
    asm volatile("s_waitcnt vmcnt(0)" ::: "memory");
    __syncthreads();
    if (leader) {
        unsigned* bar = b.bar;
        __builtin_amdgcn_s_waitcnt(0);
        unsigned nloc = b.st[0], nx = b.st[1];
        if (nloc == 0u) { xcd_barrier_complete(bar, b.x, nloc, nx); b.st[0] = nloc; b.st[1] = nx; }
        const unsigned old = xb_add(&bar[XB_XSUB(b.x)], 1u);
        const unsigned gen = old / nloc;
        if (old + 1u == (gen + 1u) * nloc) {
            __builtin_amdgcn_fence(__ATOMIC_RELEASE, "agent");
            asm volatile("s_waitcnt vmcnt(0)" ::: "memory");
            const unsigned og = xb_add(&bar[XB_TOP], 1u);
            const unsigned tg = og / nx;
            if (og + 1u == (tg + 1u) * nx) xb_add(&bar[XB_TOPGEN], 1u);
            else XB_SPIN(xb_ld(&bar[XB_TOPGEN]) == tg, bar);
            __builtin_amdgcn_fence(__ATOMIC_ACQUIRE, "agent");
            xb_add(&bar[XB_XGEN(b.x)], 1u);
            asm volatile("s_waitcnt vmcnt(0)" ::: "memory");
        } else {
            XB_SPIN(xb_ld(&bar[XB_XGEN(b.x)]) == gen, bar);
            __builtin_amdgcn_fence(__ATOMIC_ACQUIRE, "agent");
            asm volatile("s_waitcnt vmcnt(0)" ::: "memory");
        }
    }
    __syncthreads();
}

constexpr int LDS_BYTES = 147456;

__global__ void __launch_bounds__(512, 2) mega_fwd(Params p_unused) {
    extern __shared__ __attribute__((aligned(16))) unsigned char shm[];
    LAS unsigned char* lds = (LAS unsigned char*)shm;
    cg::grid_group grid = cg::this_grid();
    const int wv = __builtin_amdgcn_readfirstlane((int)(threadIdx.x >> 6));
    unsigned long long pb_t0 = 0, pb_acc = 0; (void)pb_t0; (void)pb_acc;
    volatile LAS unsigned* xb_st = (volatile LAS unsigned*)(lds + LDS_BYTES - 16);
    if (threadIdx.x == 0) { xb_st[0] = 0u; xb_st[1] = 0u; }
    __syncthreads();
    { const Params p = load_params(); (void)xcd_barrier_post((unsigned*)(p.ws + WS_BAR), xb_st); }
#define GRID_BARRIER() do { const Params pq = load_params(); XcdBarrier xb; xb.bar = (unsigned*)(pq.ws + WS_BAR); xb.x = xb_xcc_id(); \
        xb.st = (volatile LAS unsigned*)(lds + LDS_BYTES - 16); xcd_barrier(xb, opaque_tid(wv) == 0); } while (0)

    PB_BEGIN(1);
    if (gridDim.y > 1) grid.sync();
    { const Params p = load_params(); phase0(p, lds, wv); }
    GRID_BARRIER();
    PB_END(1);
    PB_BEGIN(2);
    { const Params p = load_params(); modulate0(p, wv); }
    GRID_BARRIER();
    PB_END(2);
    for (int l = 0; l < 2; ++l) {
        if (l == 0) {
            PB_BEGIN(4);
            { const Params p = load_params(); pg8::StaticOrder S; S.init(NP, 6144, gridDim.x, blockIdx.x);
              EpiQkvA E{p.ws, p.out};
              pg8::gemm_phase(lds, pg8::Gemm{(const bf16_t*)(p.ws + WS_H), (const bf16_t*)(p.ws + WS_WQKVA), NP, 6144, 2048}, S, E, wv); }
            PB_END(4);
            PB_BEGIN(8);
            { const Params p = load_params(); SEpiQkvA E{p.ws, p.out};
              skinny_gemm(lds, (const bf16_t*)(p.ws + WS_H) + (size_t)NP * 2048, 2048, (const bf16_t*)(p.ws + WS_WQKVA), 6144, 2048, E, wv); }
            PB_END(8);
            PB_BEGIN(128); GRID_BARRIER(); PB_END(128);
            PB_BEGIN(32);
            { const Params p = load_params(); attn_a_phase(p, lds, wv); }
            GRID_BARRIER();
            PB_END(32);
        } else {
            PB_BEGIN(4);
            { const Params p = load_params(); pg8::StaticOrder S; S.init(NP, 3072, gridDim.x, blockIdx.x);
              EpiQkvB E{p.ws, p.out};
              pg8::gemm_phase(lds, pg8::Gemm{(const bf16_t*)(p.ws + WS_H), (const bf16_t*)(p.ws + WS_WQKVB), NP, 3072, 2048}, S, E, wv); }
            PB_END(4);
            PB_BEGIN(8);
            { const Params p = load_params(); SEpiQkvB E{p.ws, p.out};
              skinny_gemm(lds, (const bf16_t*)(p.ws + WS_H) + (size_t)NP * 2048, 2048, (const bf16_t*)(p.ws + WS_WQKVB), 3072, 2048, E, wv); }
            PB_END(8);
            PB_BEGIN(128); GRID_BARRIER(); PB_END(128);
            PB_BEGIN(64);
            { const Params p = load_params(); attn_b_phase(p, lds, pb_acc, wv); }
            GRID_BARRIER();
            PB_END(64);
        }
        PB_BEGIN(4);
        {
            const Params p = load_params(); pg8::StaticOrder S; S.init(NP, 2048, gridDim.x, blockIdx.x);
            const float* mod = (const float*)(p.ws + WS_MOD);
            if (l == 0) { EpiRes<true> E{p.x_prompt, (bf16_t*)(p.ws + WS_Z), mod + 4096, nullptr, nullptr, nullptr};
                pg8::gemm_phase(lds, pg8::Gemm{(const bf16_t*)(p.ws + WS_H), (const bf16_t*)(p.ws + WS_WOA), NP, 2048, 2048}, S, E, wv); }
            else { EpiRes<false> E{nullptr, (bf16_t*)(p.ws + WS_Z), mod + (size_t)2 * 16 * 6144 + 4096, (const float*)(p.ws + WS_STATS), p.ln_g + 2048, p.ln_b + 2048};
                pg8::gemm_phase(lds, pg8::Gemm{(const bf16_t*)(p.ws + WS_H), (const bf16_t*)(p.ws + WS_WOB), NP, 2048, 2048}, S, E, wv); }
        }
        PB_END(4);
        PB_BEGIN(8);
        {
            const Params p = load_params(); const float* mod = (const float*)(p.ws + WS_MOD);
            SEpiRes E{l == 0 ? p.x_sample : nullptr, (bf16_t*)(p.ws + WS_Z) + (size_t)NP * 2048, mod + (size_t)(2 * l) * 16 * 6144 + 4096, (const float*)(p.ws + WS_STATS) + (size_t)NP * 2, p.ln_g + 2048, p.ln_b + 2048};
            skinny_gemm(lds, (const bf16_t*)(p.ws + WS_H) + (size_t)NP * 2048, 2048, (const bf16_t*)(p.ws + (l == 0 ? WS_WOA : WS_WOB)), 2048, 2048, E, wv);
        }
        PB_END(8);
        PB_BEGIN(128); GRID_BARRIER(); PB_END(128);
        PB_BEGIN(16);
        { const Params p = load_params(); const float* mod = (const float*)(p.ws + WS_MOD);
          ln_phase(p, p.ln_g + (2 * l) * 2048, p.ln_b + (2 * l) * 2048, mod + (size_t)(2 * l + 1) * 16 * 6144, wv); }
        GRID_BARRIER();
        PB_END(16);
        PB_BEGIN(4);
        {
            const Params p = load_params(); pg8::StaticOrder S; S.init(NP, 8192, gridDim.x, blockIdx.x);
            EpiUp E{(bf16_t*)(p.ws + WS_BIG)};
            pg8::gemm_phase(lds, pg8::Gemm{(const bf16_t*)(p.ws + WS_H), (const bf16_t*)(p.ws + WS_WUP) + (size_t)l * 2048 * 8192, NP, 8192, 2048}, S, E, wv);
        }
        PB_END(4);
        PB_BEGIN(8);
        {
            const Params p = load_params(); SEpiUp E{(bf16_t*)(p.ws + WS_BIG)};
            skinny_gemm(lds, (const bf16_t*)(p.ws + WS_H) + (size_t)NP * 2048, 2048, (const bf16_t*)(p.ws + WS_WUP) + (size_t)l * 2048 * 8192, 8192, 2048, E, wv);
        }
        PB_END(8);
        PB_BEGIN(128); GRID_BARRIER(); PB_END(128);
        PB_BEGIN(4);
        {
            const Params p = load_params(); pg8::StaticOrder S; S.init(NP, 2048, gridDim.x, blockIdx.x);
            const float* mod = (const float*)(p.ws + WS_MOD);
            EpiRes<false> E{nullptr, (bf16_t*)(p.ws + WS_Z), mod + (size_t)(2 * l + 1) * 16 * 6144 + 4096, (const float*)(p.ws + WS_STATS), p.ln_g + (2 * l) * 2048, p.ln_b + (2 * l) * 2048};
            pg8::gemm_phase(lds, pg8::Gemm{(const bf16_t*)(p.ws + WS_BIG), (const bf16_t*)(p.ws + WS_WDN) + (size_t)l * 2048 * 8192, NP, 2048, 8192}, S, E, wv);
        }
        PB_END(4);
        PB_BEGIN(8);
        {
            const Params p = load_params(); const float* mod = (const float*)(p.ws + WS_MOD);
            SEpiRes E{nullptr, (bf16_t*)(p.ws + WS_Z) + (size_t)NP * 2048, mod + (size_t)(2 * l + 1) * 16 * 6144 + 4096, (const float*)(p.ws + WS_STATS) + (size_t)NP * 2, p.ln_g + (2 * l) * 2048, p.ln_b + (2 * l) * 2048};
            skinny_gemm(lds, (const bf16_t*)(p.ws + WS_BIG) + (size_t)NP * 8192, 8192, (const bf16_t*)(p.ws + WS_WDN) + (size_t)l * 2048 * 8192, 2048, 8192, E, wv);
        }
        PB_END(8);
        PB_BEGIN(128); GRID_BARRIER(); PB_END(128);
        PB_BEGIN(16);
        { const Params p = load_params(); const float* mod = (const float*)(p.ws + WS_MOD);
          ln_phase(p, p.ln_g + (2 * l + 1) * 2048, p.ln_b + (2 * l + 1) * 2048, l == 0 ? mod + (size_t)2 * 16 * 6144 : nullptr, wv); }
        if (l == 0) GRID_BARRIER();
        PB_END(16);
    }
    if (PROBE_MASK & 256) { for (int i = 0; i < 16; ++i) GRID_BARRIER(); }
    if (PROBE_MASK) { const unsigned long long t1 = __builtin_amdgcn_s_memrealtime(); while (__builtin_amdgcn_s_memrealtime() - t1 < pb_acc) __builtin_amdgcn_s_sleep(8); }
}

extern "C" void kernel_launch(void* const* d_in, const int* in_sizes, int n_in, void* d_out, int out_size, void* d_ws, size_t ws_size, hipStream_t stream) {
    static int grid_blocks = 0;
    if (grid_blocks == 0) {
        if (ws_size < WS_END) { fprintf(stderr, "kernel_launch: workspace too small (%zu < %zu)\n", ws_size, (size_t)WS_END); grid_blocks = -1; return; }
        int dev = 0, cus = 0, per_cu = 0;
        (void)hipGetDevice(&dev);
        (void)hipDeviceGetAttribute(&cus, hipDeviceAttributeMultiprocessorCount, dev);
        if (hipFuncSetAttribute((const void*)mega_fwd, hipFuncAttributeMaxDynamicSharedMemorySize, LDS_BYTES) != hipSuccess) { fprintf(stderr, "kernel_launch: hipFuncSetAttribute failed\n"); grid_blocks = -1; return; }
        if (hipOccupancyMaxActiveBlocksPerMultiprocessor(&per_cu, (const void*)mega_fwd, 512, LDS_BYTES) != hipSuccess || per_cu < 1) { fprintf(stderr, "kernel_launch: occupancy query says %d blocks/CU\n", per_cu); per_cu = 1; }
        (void)hipGetLastError();
        grid_blocks = cus;
    }
    if (grid_blocks < 0) return;
    Params p{};
    p.x_prompt = (const float*)d_in[0]; p.x_sample = (const float*)d_in[1];
    p.cache_a_k = (const float*)d_in[2]; p.cache_a_v = (const float*)d_in[3]; p.cache_b_k = (const float*)d_in[4]; p.cache_b_v = (const float*)d_in[5];
    p.c_prompt = (const float*)d_in[6]; p.c_sample = (const float*)d_in[7];
    p.w_ada = (const float*)d_in[8]; p.b_ada = (const float*)d_in[9]; p.ln_g = (const float*)d_in[10]; p.ln_b = (const float*)d_in[11];
    p.w_qkv_a = (const float*)d_in[12]; p.w_o_a = (const float*)d_in[13]; p.rel_bias_a = (const float*)d_in[14];
    p.w_qkv_b = (const float*)d_in[15]; p.w_o_b = (const float*)d_in[16]; p.sink_b = (const float*)d_in[17];
    p.w_up = (const float*)d_in[18]; p.w_down = (const float*)d_in[19];
    p.out = (float*)d_out; p.ws = (unsigned char*)d_ws;
    if (hipMemsetAsync((char*)d_ws + WS_BAR, 0, 16384, stream) != hipSuccess) { fprintf(stderr, "kernel_launch: hipMemsetAsync of the barrier words failed\n"); return; }
    void* args[] = {&p};
    hipError_t e = hipLaunchCooperativeKernel((const void*)mega_fwd, dim3(grid_blocks), dim3(512), args, LDS_BYTES, stream);
    if (e != hipSuccess) fprintf(stderr, "cooperative launch failed: %s (grid %d)\n", hipGetErrorString(e), grid_blocks);
}
```
